# Optimizing an MI355X kernel written in HIP

```python
import math
import jax, jax.numpy as jnp
from jax import lax
import numpy as np

D_MODEL = 1024
BATCH = 8
SEQ = 2048
DEPTH = 2
DEC_BATCH = 128
DEC_SEQ = 4
PAST_LEN = 2048
PAGE_SIZE = 128

D_CONV = D_MODEL // 2
CONV_K = 31
N_HEADS = 8
HEAD_DIM = 64
N_KV = 2
HPG = N_HEADS // N_KV
KV_COLS = 2 * N_KV * HEAD_DIM
CMP_BLOCK = 32
CMP_STRIDE = 16
SEL_BLOCK = 64
N_SEL = 16
WINDOW = 512
D_FF = 4 * D_MODEL
ROPE_THETA = 10000.0
EPS = 1e-6
Q_BLOCK = 128
IN_COLS = 2 * D_CONV + N_HEADS * HEAD_DIM + 3 * KV_COLS + 3 * N_HEADS + 2 * D_MODEL

kernel_name = 'hybrid_conformer_conv_nsa_decoder_step'


def rms_norm(x, g):
    xf = x.astype(jnp.float32)
    y = xf * lax.rsqrt(jnp.mean(xf * xf, axis=-1, keepdims=True) + EPS)
    return (y * g.astype(jnp.float32)).astype(x.dtype)


def layer_norm(x, g, b):
    xf = x.astype(jnp.float32)
    mu = jnp.mean(xf, axis=-1, keepdims=True)
    var = jnp.mean(jnp.square(xf - mu), axis=-1, keepdims=True)
    y = (xf - mu) * lax.rsqrt(var + EPS)
    return (y * g.astype(jnp.float32) + b.astype(jnp.float32)).astype(x.dtype)


def rope(x, pos):
    half = HEAD_DIM // 2
    inv = jnp.power(ROPE_THETA, -jnp.arange(half, dtype=jnp.float32) / half)
    ang = pos.astype(jnp.float32)[:, None] * inv[None, :]
    cos = jnp.cos(ang)[:, None, :]
    sin = jnp.sin(ang)[:, None, :]
    xf = x.astype(jnp.float32)
    x1, x2 = xf[..., :half], xf[..., half:]
    return jnp.concatenate([x1 * cos - x2 * sin, x2 * cos + x1 * sin], axis=-1).astype(x.dtype)


def rope_kv(kv, pos):
    return jnp.stack([rope(kv[:, :, 0], pos), kv[:, :, 1]], axis=2)


def masked_softmax(s, mask):
    s = jnp.where(mask, s, -1e30)
    m = jnp.max(s, axis=-1, keepdims=True)
    p = jnp.where(mask, jnp.exp(s - m), 0.0)
    return p / jnp.maximum(jnp.sum(p, axis=-1, keepdims=True), 1e-30)


def causal_depthwise_conv(u_full, w, b):
    out = lax.conv_general_dilated(u_full, w[:, None, :], window_strides=(1,), padding='VALID',
                                   dimension_numbers=('NWC', 'WIO', 'NWC'), feature_group_count=D_CONV)
    return out + b


def compress(rows, pos_emb, w):
    t = rows.shape[1]
    n_cmp = (t - CMP_BLOCK) // CMP_STRIDE + 1
    idx = jnp.arange(n_cmp)[:, None] * CMP_STRIDE + jnp.arange(CMP_BLOCK)[None, :]
    blocks = rows[:, idx] + pos_emb[None, None, :, None, :]
    return jnp.einsum('bnlgd,lde->bnge', blocks, w)


def nsa_attention(q, kc_raw, vc_raw, ks, vs, kw, vw, gates, q0, cmp_pos, w_cmp):
    bsz, tq = q.shape[0], q.shape[1]
    t = kc_raw.shape[1]
    scale = HEAD_DIM ** -0.5
    n_cmp = (t - CMP_BLOCK) // CMP_STRIDE + 1
    n_sel = -(-t // SEL_BLOCK)
    k_sel = min(N_SEL, n_sel)
    cmp_end = jnp.arange(n_cmp) * CMP_STRIDE + CMP_BLOCK - 1
    kc = rope(compress(kc_raw, cmp_pos[0], w_cmp[0]), cmp_end)
    vc = compress(vc_raw, cmp_pos[1], w_cmp[1])
    pad = n_sel * SEL_BLOCK - t
    ks_b = jnp.pad(ks, ((0, 0), (0, pad), (0, 0), (0, 0))).reshape(bsz, n_sel, SEL_BLOCK, N_KV, HEAD_DIM).transpose(0, 3, 1, 2, 4)
    vs_b = jnp.pad(vs, ((0, 0), (0, pad), (0, 0), (0, 0))).reshape(bsz, n_sel, SEL_BLOCK, N_KV, HEAD_DIM).transpose(0, 3, 1, 2, 4)
    ci = jnp.arange(n_cmp)[:, None] * CMP_STRIDE
    sj = jnp.arange(n_sel)[None, :] * SEL_BLOCK
    overlap = ((ci < sj + SEL_BLOCK) & (ci + CMP_BLOCK > sj)).astype(jnp.float32)
    blk = jnp.arange(n_sel)
    bi = jnp.arange(bsz)[:, None, None, None]
    gi = jnp.arange(N_KV)[None, :, None, None]
    qb = Q_BLOCK if tq % Q_BLOCK == 0 else tq
    n_blk = tq // qb
    q_blocks = jnp.moveaxis(q.reshape(bsz, n_blk, qb, N_KV, HPG, HEAD_DIM), 1, 0)
    g_blocks = jnp.moveaxis(gates.reshape(bsz, n_blk, qb, 3, N_KV, HPG), 1, 0)

    def block_fn(args):
        i, qblk, gblk = args
        qp = q0 + i * qb + jnp.arange(qb)
        s_c = jnp.einsum('bqghd,bngd->bghqn', qblk, kc).astype(jnp.float32) * scale
        p_c = masked_softmax(s_c, cmp_end[None, :] <= qp[:, None])
        o_c = jnp.einsum('bghqn,bngd->bqghd', p_c.astype(vc.dtype), vc)
        imp = jnp.einsum('bghqn,nj->bgqj', p_c, overlap)
        cur = qp // SEL_BLOCK
        forced = (blk[None, :] == 0) | (blk[None, :] == cur[:, None]) | (blk[None, :] == cur[:, None] - 1)
        valid = blk[None, :] * SEL_BLOCK <= qp[:, None]
        imp = jnp.where(valid, jnp.where(forced, jnp.inf, imp), -jnp.inf)
        _, idx = lax.top_k(imp, k_sel)
        ksg = ks_b[bi, gi, idx]
        vsg = vs_b[bi, gi, idx]
        kpos = idx[..., None] * SEL_BLOCK + jnp.arange(SEL_BLOCK)
        mask_s = (kpos <= qp[None, None, :, None, None]).reshape(bsz, N_KV, 1, qb, k_sel * SEL_BLOCK)
        s_s = jnp.einsum('bqghd,bgqkld->bghqkl', qblk, ksg).astype(jnp.float32) * scale
        p_s = masked_softmax(s_s.reshape(bsz, N_KV, HPG, qb, k_sel * SEL_BLOCK), mask_s)
        p_s = p_s.reshape(bsz, N_KV, HPG, qb, k_sel, SEL_BLOCK).astype(vsg.dtype)
        o_s = jnp.einsum('bghqkl,bgqkld->bqghd', p_s, vsg)
        kwb = lax.dynamic_slice_in_dim(kw, i * qb, WINDOW + qb, axis=1)
        vwb = lax.dynamic_slice_in_dim(vw, i * qb, WINDOW + qb, axis=1)
        kpos_w = q0 - WINDOW + i * qb + jnp.arange(WINDOW + qb)
        mask_w = (kpos_w[None, :] <= qp[:, None]) & (kpos_w[None, :] > qp[:, None] - WINDOW) & (kpos_w[None, :] >= 0)
        s_w = jnp.einsum('bqghd,bkgd->bghqk', qblk, kwb).astype(jnp.float32) * scale
        p_w = masked_softmax(s_w, mask_w).astype(vwb.dtype)
        o_w = jnp.einsum('bghqk,bkgd->bqghd', p_w, vwb)
        return gblk[:, :, 0, :, :, None] * o_c + gblk[:, :, 1, :, :, None] * o_s + gblk[:, :, 2, :, :, None] * o_w

    out = lax.map(block_fn, (jnp.arange(n_blk), q_blocks, g_blocks))
    return jnp.moveaxis(out, 0, 1).reshape(bsz, tq, N_HEADS * HEAD_DIM)


def layer(x, past_ckv, past_skv, past_wkv, past_conv, q0, win_keep,
          norm_g, w_in, dw_w, dw_b, ln_g, ln_b, w_conv_out, cmp_pos, w_cmp, w_nsa_out, w_out, mlp_g, w_up, w_down):
    bsz, tq, _ = x.shape
    h = rms_norm(x, norm_g)
    proj = h @ w_in
    o0 = 2 * D_CONV
    o1 = o0 + N_HEADS * HEAD_DIM
    o2 = o1 + KV_COLS
    o3 = o2 + KV_COLS
    o4 = o3 + KV_COLS
    o5 = o4 + 3 * N_HEADS
    glu_in, q, ckv, skv, wkv, g_nsa, g_merge = jnp.split(proj, [o0, o1, o2, o3, o4, o5], axis=-1)
    u = glu_in[..., :D_CONV] * jax.nn.sigmoid(glu_in[..., D_CONV:])
    u_full = jnp.concatenate([past_conv, u], axis=1)
    c = layer_norm(causal_depthwise_conv(u_full, dw_w, dw_b), ln_g, ln_b)
    conv_out = jax.nn.silu(c) @ w_conv_out
    new_conv = u_full[:, -(CONV_K - 1):]
    pos = q0 + jnp.arange(tq)
    q = rope(q.reshape(bsz, tq, N_HEADS, HEAD_DIM), pos)
    ckv = ckv.reshape(bsz, tq, 2, N_KV, HEAD_DIM)
    skv = rope_kv(skv.reshape(bsz, tq, 2, N_KV, HEAD_DIM), pos)
    wkv = rope_kv(wkv.reshape(bsz, tq, 2, N_KV, HEAD_DIM), pos)
    ckv_all = jnp.concatenate([past_ckv, ckv], axis=1)
    skv_all = jnp.concatenate([past_skv, skv], axis=1)
    wkv_all = jnp.concatenate([past_wkv, wkv], axis=1)
    gates = jax.nn.sigmoid(g_nsa).reshape(bsz, tq, 3, N_KV, HPG)
    o = nsa_attention(q, ckv_all[:, :, 0], ckv_all[:, :, 1], skv_all[:, :, 0], skv_all[:, :, 1],
                      wkv_all[:, :, 0], wkv_all[:, :, 1], gates, q0, cmp_pos, w_cmp)
    nsa_out = o @ w_nsa_out
    gm = jax.nn.sigmoid(g_merge)
    merged = gm[..., :D_MODEL] * conv_out + gm[..., D_MODEL:] * nsa_out
    x = x + merged @ w_out
    h2 = rms_norm(x, mlp_g)
    x = x + jnp.square(jax.nn.relu(h2 @ w_up)) @ w_down
    return x, ckv, skv, wkv_all[:, -win_keep:], new_conv


def setup_inputs(seed: int = 0) -> dict:
    key = jax.random.key(seed)
    ks = jax.random.split(key, 24)
    n_pages = PAST_LEN // PAGE_SIZE
    n_pool = (DEC_BATCH * n_pages * 5) // 4
    win_buf = min(WINDOW, PAST_LEN)
    f32 = jnp.float32
    nrm = lambda k, shape, s: jax.random.normal(k, shape, f32) * s
    page_table = jax.random.permutation(ks[6], n_pool)[:DEC_BATCH * n_pages].reshape(DEC_BATCH, n_pages).astype(jnp.int32)
    return {
        'x_prompt': nrm(ks[0], (BATCH, SEQ, D_MODEL), 1.0),
        'x_sample': nrm(ks[1], (DEC_BATCH, DEC_SEQ, D_MODEL), 1.0),
        'cache_cmp_kv': nrm(ks[2], (DEPTH, n_pool, PAGE_SIZE, 2, N_KV, HEAD_DIM), 1.0),
        'cache_sel_kv': nrm(ks[3], (DEPTH, n_pool, PAGE_SIZE, 2, N_KV, HEAD_DIM), 1.0),
        'state_win_kv': nrm(ks[4], (DEPTH, DEC_BATCH, win_buf, 2, N_KV, HEAD_DIM), 1.0),
        'state_conv': nrm(ks[5], (DEPTH, DEC_BATCH, CONV_K - 1, D_CONV), 0.5),
        'page_table': page_table,
        'norm_mix_g': 1.0 + nrm(ks[7], (DEPTH, D_MODEL), 0.01),
        'w_in': nrm(ks[8], (DEPTH, D_MODEL, IN_COLS), D_MODEL ** -0.5),
        'conv_dw_w': nrm(ks[9], (DEPTH, CONV_K, D_CONV), CONV_K ** -0.5),
        'conv_dw_b': nrm(ks[10], (DEPTH, D_CONV), 0.01),
        'conv_ln_g': 1.0 + nrm(ks[11], (DEPTH, D_CONV), 0.01),
        'conv_ln_b': nrm(ks[12], (DEPTH, D_CONV), 0.01),
        'w_conv_out': nrm(ks[13], (DEPTH, D_CONV, D_MODEL), D_CONV ** -0.5),
        'cmp_pos': nrm(ks[14], (DEPTH, 2, CMP_BLOCK, HEAD_DIM), 0.1),
        'w_cmp': nrm(ks[15], (DEPTH, 2, CMP_BLOCK, HEAD_DIM, HEAD_DIM), (CMP_BLOCK * HEAD_DIM) ** -0.5),
        'w_nsa_out': nrm(ks[16], (DEPTH, N_HEADS * HEAD_DIM, D_MODEL), (N_HEADS * HEAD_DIM) ** -0.5),
        'w_out': nrm(ks[17], (DEPTH, D_MODEL, D_MODEL), D_MODEL ** -0.5),
        'norm_mlp_g': 1.0 + nrm(ks[18], (DEPTH, D_MODEL), 0.01),
        'w_up': nrm(ks[19], (DEPTH, D_MODEL, D_FF), D_MODEL ** -0.5),
        'w_down': nrm(ks[20], (DEPTH, D_FF, D_MODEL), 0.5 * D_FF ** -0.5),
        'norm_final_g': 1.0 + nrm(ks[21], (D_MODEL,), 0.01),
    }


def reference(x_prompt, x_sample, cache_cmp_kv, cache_sel_kv, state_win_kv, state_conv, page_table,
              norm_mix_g, w_in, conv_dw_w, conv_dw_b, conv_ln_g, conv_ln_b, w_conv_out, cmp_pos, w_cmp,
              w_nsa_out, w_out, norm_mlp_g, w_up, w_down, norm_final_g):
    dtype = x_prompt.dtype
    bp, tp = x_prompt.shape[0], x_prompt.shape[1]
    bs, ts = x_sample.shape[0], x_sample.shape[1]
    n_pages = page_table.shape[1]
    past_len = n_pages * PAGE_SIZE
    win_buf = state_win_kv.shape[2]
    xp, xs = x_prompt, x_sample
    ckp, cks, skp, sks, wkp, wks, cvp, cvs = [], [], [], [], [], [], [], []
    for l in range(DEPTH):
        weights = (norm_mix_g[l], w_in[l], conv_dw_w[l], conv_dw_b[l], conv_ln_g[l], conv_ln_b[l], w_conv_out[l],
                   cmp_pos[l], w_cmp[l], w_nsa_out[l], w_out[l], norm_mlp_g[l], w_up[l], w_down[l])
        empty = jnp.zeros((bp, 0, 2, N_KV, HEAD_DIM), dtype)
        xp, ck, sk, wk, cv = layer(xp, empty, empty, jnp.zeros((bp, WINDOW, 2, N_KV, HEAD_DIM), dtype),
                                   jnp.zeros((bp, CONV_K - 1, D_CONV), dtype), 0, min(WINDOW, tp), *weights)
        ckp.append(ck); skp.append(sk); wkp.append(wk); cvp.append(cv)
        past_ckv = cache_cmp_kv[l][page_table].reshape(bs, past_len, 2, N_KV, HEAD_DIM)
        past_skv = cache_sel_kv[l][page_table].reshape(bs, past_len, 2, N_KV, HEAD_DIM)
        past_wkv = jnp.pad(state_win_kv[l], ((0, 0), (WINDOW - win_buf, 0), (0, 0), (0, 0), (0, 0)))
        xs, ck, sk, wk, cv = layer(xs, past_ckv, past_skv, past_wkv, state_conv[l], past_len, win_buf, *weights)
        cks.append(ck); sks.append(sk); wks.append(wk); cvs.append(cv)
    y_prompt = rms_norm(xp, norm_final_g)
    y_sample = rms_norm(xs, norm_final_g)
    new_cmp_kv_prompt = jnp.stack(ckp)
    new_cmp_kv_sample = jnp.stack(cks)
    new_sel_kv_prompt = jnp.stack(skp)
    new_sel_kv_sample = jnp.stack(sks)
    new_win_kv_prompt = jnp.stack(wkp)
    new_win_kv_sample = jnp.stack(wks)
    new_conv_prompt = jnp.stack(cvp)
    new_conv_sample = jnp.stack(cvs)
    return (y_prompt, y_sample, new_cmp_kv_prompt, new_cmp_kv_sample, new_sel_kv_prompt, new_sel_kv_sample,
            new_win_kv_prompt, new_win_kv_sample, new_conv_prompt, new_conv_sample)
```

```cpp
#include <hip/hip_runtime.h>
#include <stdint.h>
#include <math.h>

#define DEV __device__ __forceinline__

namespace {
constexpr int D = 1024, BP = 8, TP = 2048, BS = 128, TS = 4, NPAGES = 16, NPOOL = 2560;
constexpr int DC = 512, CK = 31, DFF = 4096, INC = 4376;
constexpr int NP = BP * TP, NS = BS * TS, NT = NP + NS, NB = BP + BS, NCMP = 127;
constexpr float EPS = 1e-6f;
constexpr int O_Q = 1024, O_CKV = 1536, O_SKV = 1792, O_WKV = 2048, O_GN = 2304, O_GM = 2328;
constexpr size_t OUT_Y = 0;
constexpr size_t OUT_CMP_P = (size_t)NT * D;
constexpr size_t OUT_CMP_S = OUT_CMP_P + (size_t)2 * NP * 256;
constexpr size_t OUT_SEL_P = OUT_CMP_S + (size_t)2 * NS * 256;
constexpr size_t OUT_SEL_S = OUT_SEL_P + (size_t)2 * NP * 256;
constexpr size_t OUT_WIN_P = OUT_SEL_S + (size_t)2 * NS * 256;
constexpr size_t OUT_WIN_S = OUT_WIN_P + (size_t)2 * BP * 512 * 256;
constexpr size_t OUT_CONV_P = OUT_WIN_S + (size_t)2 * BS * 512 * 256;
constexpr size_t OUT_CONV_S = OUT_CONV_P + (size_t)2 * BP * 30 * 512;
constexpr size_t OUT_TOTAL = OUT_CONV_S + (size_t)2 * BS * 30 * 512;

struct P {
    const float *x_prompt, *x_sample, *cache_cmp, *cache_sel, *state_win, *state_conv;
    const int* page_table;
    const float *norm_mix_g, *w_in, *dw_w, *dw_b, *ln_g, *ln_b, *w_conv_out, *cmp_pos, *w_cmp, *w_nsa_out, *w_out, *norm_mlp_g, *w_up, *w_down, *norm_final_g;
    float* out;
    float *X, *H, *PROJ, *U, *Q, *CKV, *SKV, *WKV, *GN, *GM, *CACT, *KC, *VC, *O, *CONVOUT, *NSAOUT, *MERGED, *HID, *ROPE;
};

typedef float f32x16 __attribute__((ext_vector_type(16)));

DEV float sigmoidf_(float x) { return 1.0f / (1.0f + expf(-x)); }
DEV float wave_sum(float v) {
#pragma unroll
    for (int o = 32; o > 0; o >>= 1) v += __shfl_xor(v, o);
    return v;
}
DEV float wave_max(float v) {
#pragma unroll
    for (int o = 32; o > 0; o >>= 1) v = fmaxf(v, __shfl_xor(v, o));
    return v;
}
DEV const float* shfl_ptr(const float* p, int src) {
    unsigned long long v = (unsigned long long)p;
    unsigned lo = __shfl((unsigned)v, src), hi = __shfl((unsigned)(v >> 32), src);
    return (const float*)(((unsigned long long)hi << 32) | lo);
}

__global__ void k_rope_table(float* tab) {
    int idx = blockIdx.x * blockDim.x + threadIdx.x;
    if (idx >= 2052 * 32) return;
    int pos = idx >> 5, i = idx & 31;
    double inv = pow(10000.0, -(double)i / 32.0);
    double ang = (double)pos * inv;
    tab[idx * 2] = (float)cos(ang); tab[idx * 2 + 1] = (float)sin(ang);
}

__global__ void k_copy_x(P p) {
    size_t n4 = (size_t)NT * D / 4;
    for (size_t i = (size_t)blockIdx.x * blockDim.x + threadIdx.x; i < n4; i += (size_t)gridDim.x * blockDim.x) {
        size_t np4 = (size_t)NP * D / 4;
        float4 v = i < np4 ? ((const float4*)p.x_prompt)[i] : ((const float4*)p.x_sample)[i - np4];
        ((float4*)p.X)[i] = v;
    }
}

__global__ __launch_bounds__(256) void k_rmsnorm(const float* X, const float* g, float* Y) {
    __shared__ float red[4];
    int r = blockIdx.x, tid = threadIdx.x;
    float4 v = ((const float4*)(X + (size_t)r * D))[tid];
    float s = v.x * v.x + v.y * v.y + v.z * v.z + v.w * v.w;
    s = wave_sum(s);
    if ((tid & 63) == 0) red[tid >> 6] = s;
    __syncthreads();
    s = red[0] + red[1] + red[2] + red[3];
    float rs = 1.0f / sqrtf(s * (1.0f / D) + EPS);
    float4 gv = ((const float4*)g)[tid];
    float4 o; o.x = v.x * rs * gv.x; o.y = v.y * rs * gv.y; o.z = v.z * rs * gv.z; o.w = v.w * rs * gv.w;
    ((float4*)(Y + (size_t)r * D))[tid] = o;
}

template <int EPI>
__global__ __launch_bounds__(256) void k_gemm(const float* __restrict__ A, int lda, const float* __restrict__ B, int ldb, float* C, int ldc, int M, int N, int K) {
    __shared__ float As[128][33];
    __shared__ float Bs[32][132];
    const int tid = threadIdx.x, lane = tid & 63, w = tid >> 6, wm = w >> 1, wn = w & 1;
    const int tm = blockIdx.y, tn = blockIdx.x;
    f32x16 acc[2][2];
#pragma unroll
    for (int i = 0; i < 2; ++i)
#pragma unroll
        for (int j = 0; j < 2; ++j)
#pragma unroll
            for (int e = 0; e < 16; ++e) acc[i][j][e] = 0.f;
    for (int k0 = 0; k0 < K; k0 += 32) {
#pragma unroll
        for (int i = 0; i < 4; ++i) {
            int idx = tid + i * 256, r = idx >> 3, c = (idx & 7) * 4;
            float4 v = *(const float4*)(A + (size_t)(tm * 128 + r) * lda + k0 + c);
            As[r][c] = v.x; As[r][c + 1] = v.y; As[r][c + 2] = v.z; As[r][c + 3] = v.w;
        }
#pragma unroll
        for (int i = 0; i < 4; ++i) {
            int idx = tid + i * 256, r = idx >> 5, c = (idx & 31) * 4, col = tn * 128 + c;
            float4 v = make_float4(0.f, 0.f, 0.f, 0.f);
            if (col < N) v = *(const float4*)(B + (size_t)(k0 + r) * ldb + col);
            *(float4*)&Bs[r][c] = v;
        }
        __syncthreads();
#pragma unroll
        for (int kk = 0; kk < 32; kk += 2) {
            float a[2], b[2];
#pragma unroll
            for (int i = 0; i < 2; ++i) a[i] = As[wm * 64 + i * 32 + (lane & 31)][kk + (lane >> 5)];
#pragma unroll
            for (int j = 0; j < 2; ++j) b[j] = Bs[kk + (lane >> 5)][wn * 64 + j * 32 + (lane & 31)];
#pragma unroll
            for (int i = 0; i < 2; ++i)
#pragma unroll
                for (int j = 0; j < 2; ++j) acc[i][j] = __builtin_amdgcn_mfma_f32_32x32x2f32(a[i], b[j], acc[i][j], 0, 0, 0);
        }
        __syncthreads();
    }
#pragma unroll
    for (int i = 0; i < 2; ++i)
#pragma unroll
        for (int j = 0; j < 2; ++j) {
            int col = tn * 128 + wn * 64 + j * 32 + (lane & 31);
            if (col < N) {
#pragma unroll
                for (int e = 0; e < 16; ++e) {
                    int row = tm * 128 + wm * 64 + i * 32 + (e & 3) + 8 * (e >> 2) + 4 * (lane >> 5);
                    float v = acc[i][j][e];
                    float* cp = C + (size_t)row * ldc + col;
                    if (EPI == 1) v += *cp;
                    if (EPI == 2) { v = fmaxf(v, 0.f); v = v * v; }
                    *cp = v;
                }
            }
        }
}

__global__ __launch_bounds__(256) void k_split(P p, int l) {
    const int r = blockIdx.x, tid = threadIdx.x;
    const bool prompt = r < NP;
    const int b = prompt ? r / TP : (r - NP) / TS, t = prompt ? r % TP : (r - NP) % TS;
    const int pos = prompt ? t : TP + t;
    const float* pr = p.PROJ + (size_t)r * INC;
    const float* rope = p.ROPE + (size_t)pos * 64;
    for (int c = tid; c < DC; c += 256) {
        float u = pr[c] * sigmoidf_(pr[DC + c]);
        p.U[(size_t)r * DC + c] = u;
        if (prompt) { if (t >= TP - 30) p.out[OUT_CONV_P + ((size_t)(l * BP + b) * 30 + (t - (TP - 30))) * DC + c] = u; }
        else p.out[OUT_CONV_S + ((size_t)(l * BS + b) * 30 + 26 + t) * DC + c] = u;
    }
    if (!prompt && t == 0) {
        for (int i = tid; i < 26 * DC; i += 256)
            p.out[OUT_CONV_S + (size_t)(l * BS + b) * 30 * DC + i] = p.state_conv[(size_t)(l * BS + b) * 30 * DC + 4 * DC + i];
    }
    {
        int h = tid >> 5, d = tid & 31;
        float x1 = pr[O_Q + h * 64 + d], x2 = pr[O_Q + h * 64 + d + 32], c = rope[d * 2], s = rope[d * 2 + 1];
        p.Q[(size_t)r * 512 + h * 64 + d] = x1 * c - x2 * s;
        p.Q[(size_t)r * 512 + h * 64 + d + 32] = x2 * c + x1 * s;
    }
    {
        float v = pr[O_CKV + tid];
        p.CKV[(size_t)r * 256 + tid] = v;
        if (prompt) p.out[OUT_CMP_P + ((size_t)l * NP + r) * 256 + tid] = v;
        else p.out[OUT_CMP_S + ((size_t)l * NS + (r - NP)) * 256 + tid] = v;
    }
    for (int which = 0; which < 2; ++which) {
        const float* src = pr + (which == 0 ? O_SKV : O_WKV);
        float v;
        if (tid < 128) {
            int d = tid & 63, dd = d & 31;
            float c = rope[dd * 2], s = rope[dd * 2 + 1];
            float xa = src[tid], xb = src[d < 32 ? tid + 32 : tid - 32];
            v = d < 32 ? xa * c - xb * s : xa * c + xb * s;
        } else v = src[tid];
        if (which == 0) {
            p.SKV[(size_t)r * 256 + tid] = v;
            if (prompt) p.out[OUT_SEL_P + ((size_t)l * NP + r) * 256 + tid] = v;
            else p.out[OUT_SEL_S + ((size_t)l * NS + (r - NP)) * 256 + tid] = v;
        } else {
            p.WKV[(size_t)r * 256 + tid] = v;
            if (prompt) { if (t >= TP - 512) p.out[OUT_WIN_P + ((size_t)(l * BP + b) * 512 + (t - (TP - 512))) * 256 + tid] = v; }
            else p.out[OUT_WIN_S + ((size_t)(l * BS + b) * 512 + 508 + t) * 256 + tid] = v;
        }
    }
    if (tid < 24) p.GN[(size_t)r * 24 + tid] = sigmoidf_(pr[O_GN + tid]);
    for (int c = tid; c < 2048; c += 256) p.GM[(size_t)r * 2048 + c] = sigmoidf_(pr[O_GM + c]);
}

__global__ void k_copy_win(P p, int l) {
    size_t per = (size_t)508 * 256 / 4, n = (size_t)BS * per;
    for (size_t i = (size_t)blockIdx.x * blockDim.x + threadIdx.x; i < n; i += (size_t)gridDim.x * blockDim.x) {
        size_t b = i / per, o = i % per;
        const float4* src = (const float4*)(p.state_win + ((size_t)(l * BS + b) * 512 + 4) * 256);
        float4* dst = (float4*)(p.out + OUT_WIN_S + (size_t)(l * BS + b) * 512 * 256);
        dst[o] = src[o];
    }
}

__global__ __launch_bounds__(256) void k_conv(P p, int l) {
    __shared__ float red[8];
    const int r = blockIdx.x, tid = threadIdx.x;
    const bool prompt = r < NP;
    const int b = prompt ? r / TP : (r - NP) / TS, t = prompt ? r % TP : (r - NP) % TS;
    float acc[2];
#pragma unroll
    for (int cc = 0; cc < 2; ++cc) {
        int c = tid + cc * 256;
        float a = p.dw_b[l * DC + c];
        for (int k = 0; k < CK; ++k) {
            float v;
            if (prompt) { int tt = t + k - 30; v = tt >= 0 ? p.U[((size_t)b * TP + tt) * DC + c] : 0.f; }
            else { int j = t + k; v = j < 30 ? p.state_conv[((size_t)(l * BS + b) * 30 + j) * DC + c] : p.U[((size_t)NP + b * TS + (j - 30)) * DC + c]; }
            a += v * p.dw_w[((size_t)l * CK + k) * DC + c];
        }
        acc[cc] = a;
    }
    float s = wave_sum(acc[0] + acc[1]);
    if ((tid & 63) == 0) red[tid >> 6] = s;
    __syncthreads();
    float mean = (red[0] + red[1] + red[2] + red[3]) * (1.0f / DC);
    float d0 = acc[0] - mean, d1 = acc[1] - mean;
    float q = wave_sum(d0 * d0 + d1 * d1);
    if ((tid & 63) == 0) red[4 + (tid >> 6)] = q;
    __syncthreads();
    float var = (red[4] + red[5] + red[6] + red[7]) * (1.0f / DC);
    float rs = 1.0f / sqrtf(var + EPS);
#pragma unroll
    for (int cc = 0; cc < 2; ++cc) {
        int c = tid + cc * 256;
        float y = (acc[cc] - mean) * rs * p.ln_g[l * DC + c] + p.ln_b[l * DC + c];
        p.CACT[(size_t)r * DC + c] = y * sigmoidf_(y);
    }
}

__global__ __launch_bounds__(64) void k_compress(P p, int l) {
    __shared__ float R[144 * 64];
    const int e = threadIdx.x, blk = blockIdx.x;
    const int i = blk & 15, kv = (blk >> 4) & 1, g = (blk >> 5) & 1, bi = blk >> 6;
    const bool prompt = bi < BP;
    for (int row = 0; row < 144; ++row) {
        int pos = 128 * i + row; float v = 0.f;
        if (pos < 2048) {
            if (prompt) v = p.CKV[((size_t)bi * TP + pos) * 256 + kv * 128 + g * 64 + e];
            else { int b = bi - BP; int page = p.page_table[b * NPAGES + (pos >> 7)];
                   v = p.cache_cmp[(((size_t)l * NPOOL + page) * 128 + (pos & 127)) * 256 + kv * 128 + g * 64 + e]; }
        }
        R[row * 64 + e] = v;
    }
    __syncthreads();
    const float* W = p.w_cmp + (size_t)(l * 2 + kv) * 32 * 64 * 64;
    const float* PE = p.cmp_pos + (size_t)(l * 2 + kv) * 32 * 64;
    float acc[8], bias = 0.f;
#pragma unroll
    for (int j = 0; j < 8; ++j) acc[j] = 0.f;
    for (int ll = 0; ll < 16; ++ll)
        for (int d = 0; d < 64; ++d) {
            float w0 = W[(size_t)(ll * 64 + d) * 64 + e], w1 = W[(size_t)((16 + ll) * 64 + d) * 64 + e];
            bias += PE[ll * 64 + d] * w0 + PE[(16 + ll) * 64 + d] * w1;
#pragma unroll
            for (int j = 0; j < 8; ++j) acc[j] += R[((j) * 16 + ll) * 64 + d] * w0 + R[((j + 1) * 16 + ll) * 64 + d] * w1;
        }
#pragma unroll
    for (int j = 0; j < 8; ++j) {
        int n = 8 * i + j;
        float v = acc[j] + bias;
        if (kv == 0) {
            int cpos = 16 * n + 31; if (cpos > 2051) cpos = 2051;
            int dd = e & 31; float c = p.ROPE[(size_t)cpos * 64 + dd * 2], s = p.ROPE[(size_t)cpos * 64 + dd * 2 + 1];
            float other = __shfl_xor(v, 32);
            v = e < 32 ? v * c - other * s : v * c + other * s;
        }
        if (n < NCMP) (kv == 0 ? p.KC : p.VC)[((size_t)(bi * 2 + g) * NCMP + n) * 64 + e] = v;
    }
}

DEV const float* row_ptr(const P& p, int mode, int l, bool prompt, int b, int bi, int g, int qp, int blkj, int t, int ln, int kv, bool& ok) {
    if (mode == 0) {
        int n = t * 64 + ln; ok = n < NCMP && 16 * n + 31 <= qp; if (n > 126) n = 126;
        return (kv ? p.VC : p.KC) + ((size_t)(bi * 2 + g) * NCMP + n) * 64;
    }
    if (mode == 1) {
        int kpos = 64 * blkj + ln; ok = kpos <= qp;
        if (prompt) return p.SKV + ((size_t)b * TP + kpos) * 256 + kv * 128 + g * 64;
        if (blkj < 32) { int page = p.page_table[b * NPAGES + (kpos >> 7)];
                         return p.cache_sel + (((size_t)l * NPOOL + page) * 128 + (kpos & 127)) * 256 + kv * 128 + g * 64; }
        int ii = kpos - TP; if (ii > 3) ii = 3;
        return p.SKV + ((size_t)NP + b * TS + ii) * 256 + kv * 128 + g * 64;
    }
    int kpos = qp - 511 + 64 * t + ln; ok = kpos >= 0; if (kpos < 0) kpos = 0;
    if (prompt) return p.WKV + ((size_t)b * TP + kpos) * 256 + kv * 128 + g * 64;
    if (kpos < TP) return p.state_win + ((size_t)(l * BS + b) * 512 + (kpos - (TP - 512))) * 256 + kv * 128 + g * 64;
    return p.WKV + ((size_t)NP + b * TS + (kpos - TP)) * 256 + kv * 128 + g * 64;
}

__global__ __launch_bounds__(64) void k_attn(P p, int l) {
    __shared__ float Ks[64][65];
    __shared__ float qs[4][64];
    __shared__ float ps[4][64];
    __shared__ float pcs[128];
    __shared__ float sS[64][64];
    __shared__ int sel[16];
    const int lane = threadIdx.x;
    const int item = blockIdx.x, r = item >> 1, g = item & 1;
    const bool prompt = r < NP;
    const int b = prompt ? r / TP : (r - NP) / TS, tq = prompt ? r % TP : (r - NP) % TS;
    const int qp = prompt ? tq : TP + tq, bi = prompt ? b : BP + b;
#pragma unroll
    for (int hh = 0; hh < 4; ++hh) qs[hh][lane] = p.Q[(size_t)r * 512 + (g * 4 + hh) * 64 + lane];
    __syncthreads();
    float obr[3][4];
    for (int mode = 0; mode < 3; ++mode) {
        const int T = mode == 0 ? 2 : (mode == 1 ? 16 : 8);
        unsigned okm = 0;
        for (int t = 0; t < T; ++t) {
            bool ok; const int bj = mode == 1 ? sel[t] : 0;
            const float* kp = row_ptr(p, mode, l, prompt, b, bi, g, qp, bj, t, lane, 0, ok);
            if (ok) okm |= 1u << t;
            for (int i = 0; i < 64; ++i) { const float* rp = shfl_ptr(kp, i); Ks[i][lane] = rp[lane]; }
            __syncthreads();
            for (int hh = 0; hh < 4; ++hh) {
                float a = 0.f;
                for (int d = 0; d < 64; ++d) a += qs[hh][d] * Ks[lane][d];
                sS[t * 4 + hh][lane] = ok ? a * 0.125f : -1e30f;
            }
            __syncthreads();
        }
        for (int hh = 0; hh < 4; ++hh) {
            float m = -1e30f;
            for (int t = 0; t < T; ++t) m = fmaxf(m, sS[t * 4 + hh][lane]);
            m = wave_max(m);
            float sum = 0.f;
            for (int t = 0; t < T; ++t) { float pv = ((okm >> t) & 1u) ? expf(sS[t * 4 + hh][lane] - m) : 0.f; sS[t * 4 + hh][lane] = pv; sum += pv; }
            sum = wave_sum(sum);
            float inv = 1.0f / fmaxf(sum, 1e-30f);
            for (int t = 0; t < T; ++t) sS[t * 4 + hh][lane] *= inv;
        }
        float o[4] = {0.f, 0.f, 0.f, 0.f};
        for (int t = 0; t < T; ++t) {
            bool ok; const int bj = mode == 1 ? sel[t] : 0;
            const float* vp = row_ptr(p, mode, l, prompt, b, bi, g, qp, bj, t, lane, 1, ok);
            __syncthreads();
            for (int i = 0; i < 64; ++i) {
                const float* rp = shfl_ptr(vp, i); float v = rp[lane];
#pragma unroll
                for (int hh = 0; hh < 4; ++hh) o[hh] += sS[t * 4 + hh][i] * v;
            }
        }
#pragma unroll
        for (int hh = 0; hh < 4; ++hh) obr[mode][hh] = o[hh];
        if (mode == 0) {
            pcs[lane] = sS[0][lane] + sS[1][lane] + sS[2][lane] + sS[3][lane];
            pcs[64 + lane] = sS[4][lane] + sS[5][lane] + sS[6][lane] + sS[7][lane];
            __syncthreads();
            const int nsel = prompt ? 32 : 33, cur = qp >> 6;
            float imp = 0.f;
            for (int n = 4 * lane - 1; n <= 4 * lane + 3; ++n) if (n >= 0 && n < NCMP && lane < nsel) imp += pcs[n];
            const bool valid = lane < nsel && 64 * lane <= qp;
            const bool forced = lane == 0 || lane == cur || lane == cur - 1;
            imp = valid ? (forced ? INFINITY : imp) : -INFINITY;
            bool cand = lane < nsel;
            for (int k = 0; k < 16; ++k) {
                float m = wave_max(cand ? imp : -INFINITY);
                unsigned long long bal = __ballot(cand && imp == m);
                int j = __ffsll((long long)bal) - 1;
                if (lane == 0) sel[k] = j;
                if (lane == j) cand = false;
            }
        }
        __syncthreads();
    }
    const float* gn = p.GN + (size_t)r * 24;
#pragma unroll
    for (int hh = 0; hh < 4; ++hh) {
        int h = g * 4 + hh;
        p.O[(size_t)r * 512 + h * 64 + lane] = gn[h] * obr[0][hh] + gn[8 + h] * obr[1][hh] + gn[16 + h] * obr[2][hh];
    }
}

__global__ void k_merge(P p) {
    size_t n = (size_t)NT * D;
    for (size_t i = (size_t)blockIdx.x * blockDim.x + threadIdx.x; i < n; i += (size_t)gridDim.x * blockDim.x) {
        size_t r = i / D, c = i % D;
        p.MERGED[i] = p.GM[r * 2048 + c] * p.CONVOUT[i] + p.GM[r * 2048 + D + c] * p.NSAOUT[i];
    }
}

template <int EPI>
void gemm(hipStream_t st, const float* A, int lda, const float* B, int ldb, float* C, int ldc, int M, int N, int K) {
    dim3 grid((N + 127) / 128, M / 128);
    k_gemm<EPI><<<grid, 256, 0, st>>>(A, lda, B, ldb, C, ldc, M, N, K);
}
}

extern "C" void kernel_launch(void* const* d_in, const int* in_sizes, int n_in, void* d_out, int out_size, void* d_ws, size_t ws_size, hipStream_t stream) {
    (void)in_sizes; (void)n_in; (void)out_size; (void)ws_size;
    P p{};
    p.x_prompt = (const float*)d_in[0]; p.x_sample = (const float*)d_in[1]; p.cache_cmp = (const float*)d_in[2]; p.cache_sel = (const float*)d_in[3];
    p.state_win = (const float*)d_in[4]; p.state_conv = (const float*)d_in[5]; p.page_table = (const int*)d_in[6];
    p.norm_mix_g = (const float*)d_in[7]; p.w_in = (const float*)d_in[8]; p.dw_w = (const float*)d_in[9]; p.dw_b = (const float*)d_in[10];
    p.ln_g = (const float*)d_in[11]; p.ln_b = (const float*)d_in[12]; p.w_conv_out = (const float*)d_in[13]; p.cmp_pos = (const float*)d_in[14];
    p.w_cmp = (const float*)d_in[15]; p.w_nsa_out = (const float*)d_in[16]; p.w_out = (const float*)d_in[17]; p.norm_mlp_g = (const float*)d_in[18];
    p.w_up = (const float*)d_in[19]; p.w_down = (const float*)d_in[20]; p.norm_final_g = (const float*)d_in[21];
    p.out = (float*)d_out;
    float* ws = (float*)d_ws; size_t off = 0;
    auto take = [&](size_t n) { float* q = ws + off; off += (n + 63) & ~(size_t)63; return q; };
    p.X = take((size_t)NT * D); p.H = take((size_t)NT * D); p.PROJ = take((size_t)NT * INC); p.U = take((size_t)NT * DC); p.Q = take((size_t)NT * 512);
    p.CKV = take((size_t)NT * 256); p.SKV = take((size_t)NT * 256); p.WKV = take((size_t)NT * 256); p.GN = take((size_t)NT * 24); p.GM = take((size_t)NT * 2048);
    p.CACT = take((size_t)NT * DC); p.KC = take((size_t)NB * 2 * NCMP * 64); p.VC = take((size_t)NB * 2 * NCMP * 64); p.O = take((size_t)NT * 512);
    p.CONVOUT = take((size_t)NT * D); p.NSAOUT = take((size_t)NT * D); p.MERGED = take((size_t)NT * D); p.HID = take((size_t)NT * DFF); p.ROPE = take((size_t)2052 * 64);

    k_rope_table<<<(2052 * 32 + 255) / 256, 256, 0, stream>>>(p.ROPE);
    k_copy_x<<<2048, 256, 0, stream>>>(p);
    for (int l = 0; l < 2; ++l) {
        k_rmsnorm<<<NT, 256, 0, stream>>>(p.X, p.norm_mix_g + l * D, p.H);
        gemm<0>(stream, p.H, D, p.w_in + (size_t)l * D * INC, INC, p.PROJ, INC, NT, INC, D);
        k_split<<<NT, 256, 0, stream>>>(p, l);
        k_copy_win<<<2048, 256, 0, stream>>>(p, l);
        k_conv<<<NT, 256, 0, stream>>>(p, l);
        k_compress<<<NB * 2 * 2 * 16, 64, 0, stream>>>(p, l);
        k_attn<<<NT * 2, 64, 0, stream>>>(p, l);
        gemm<0>(stream, p.CACT, DC, p.w_conv_out + (size_t)l * DC * D, D, p.CONVOUT, D, NT, D, DC);
        gemm<0>(stream, p.O, 512, p.w_nsa_out + (size_t)l * 512 * D, D, p.NSAOUT, D, NT, D, 512);
        k_merge<<<4096, 256, 0, stream>>>(p);
        gemm<1>(stream, p.MERGED, D, p.w_out + (size_t)l * D * D, D, p.X, D, NT, D, D);
        k_rmsnorm<<<NT, 256, 0, stream>>>(p.X, p.norm_mlp_g + l * D, p.H);
        gemm<2>(stream, p.H, D, p.w_up + (size_t)l * D * DFF, DFF, p.HID, DFF, NT, DFF, D);
        gemm<1>(stream, p.HID, DFF, p.w_down + (size_t)l * DFF * D, D, p.X, D, NT, D, DFF);
    }
    k_rmsnorm<<<NT, 256, 0, stream>>>(p.X, p.norm_final_g, p.out + OUT_Y);
}
```

```cpp
#include <hip/hip_runtime.h>
#include <stdint.h>
#include <math.h>
#include <cstdio>

#define DEV __device__ __forceinline__
#define LAS __attribute__((address_space(3)))
#define GAS __attribute__((address_space(1)))

namespace cfg {
constexpr int D = 1024, BP = 8, TP = 2048, BS = 128, TS = 4, NPAGES = 16, NPOOL = 2560;
constexpr int DC = 512, CK = 31, DFF = 4096, INC = 4376, N1 = 4608;
constexpr int NP = BP * TP, NS = BS * TS, NT = NP + NS, NB = BP + BS, NCMP = 127;
constexpr float EPS = 1e-6f;
constexpr size_t OUT_Y = 0;
constexpr size_t OUT_CMP_P = (size_t)NT * D;
constexpr size_t OUT_CMP_S = OUT_CMP_P + (size_t)2 * NP * 256;
constexpr size_t OUT_SEL_P = OUT_CMP_S + (size_t)2 * NS * 256;
constexpr size_t OUT_SEL_S = OUT_SEL_P + (size_t)2 * NP * 256;
constexpr size_t OUT_WIN_P = OUT_SEL_S + (size_t)2 * NS * 256;
constexpr size_t OUT_WIN_S = OUT_WIN_P + (size_t)2 * BP * 512 * 256;
constexpr size_t OUT_CONV_P = OUT_WIN_S + (size_t)2 * BS * 512 * 256;
constexpr size_t OUT_CONV_S = OUT_CONV_P + (size_t)2 * BP * 30 * 512;
constexpr size_t OUT_TOTAL = OUT_CONV_S + (size_t)2 * BS * 30 * 512;
}
using namespace cfg;
constexpr size_t MiB = 1u << 20;
constexpr size_t WS_CTL = 0, CTL_ZERO_BYTES = 64 * 1024, CTL_BYTES = 8 * MiB;
constexpr int CW_BAR = 4096, CW_SS = 16384;
static_assert((size_t)(CW_SS + 5 * NT * 16) * 4 <= 8 * (size_t)(1u << 20), "ss region");
struct WsMap {
    size_t w1, wc, wn, wo, wup, wdn, wstride, wcmp, cbias, rope, X, XB, U, Q, CKV, SKV, WKV, GN, GM, CACT, KC, VC, KCB, VCB, O, T, HID, end;
};
constexpr size_t al256(size_t b) { return (b + 255) & ~(size_t)255; }
constexpr WsMap ws_map() {
    WsMap m{}; size_t o = CTL_BYTES;
    m.w1 = o; o += al256((size_t)N1 * D * 2); m.wc = o; o += al256((size_t)D * DC * 2); m.wn = o; o += al256((size_t)D * 512 * 2); m.wo = o; o += al256((size_t)D * D * 2);
    m.wup = o; o += al256((size_t)DFF * D * 2); m.wdn = o; o += al256((size_t)D * DFF * 2); m.wstride = o - m.w1; o += m.wstride;
    m.wcmp = o; o += al256((size_t)4 * 128 * 1024 * 2); m.cbias = o; o += al256(4 * 64 * 4); m.rope = o; o += al256((size_t)2052 * 64 * 4);
    m.X = o; o += al256((size_t)NT * D * 4); m.XB = o; o += al256((size_t)NT * D * 2); m.U = o; o += al256((size_t)NT * DC * 2); m.Q = o; o += al256((size_t)NT * 512 * 2);
    m.CKV = o; o += al256((size_t)NT * 256 * 2); m.SKV = o; o += al256((size_t)NT * 256 * 2); m.WKV = o; o += al256((size_t)NT * 256 * 2); m.GN = o; o += al256((size_t)NT * 24 * 4);
    m.GM = o; o += al256((size_t)NT * 2048 * 2); m.CACT = o; o += al256((size_t)NT * DC * 2); m.KC = o; o += al256((size_t)NB * 2 * NCMP * 64 * 4); m.VC = o; o += al256((size_t)NB * 2 * NCMP * 64 * 4); m.KCB = o; o += al256((size_t)NB * 2 * 128 * 64 * 2); m.VCB = o; o += al256((size_t)NB * 2 * 128 * 64 * 2);
    m.O = o; o += al256((size_t)NT * 512 * 2); m.T = o; o += al256((size_t)NT * D * 2); m.HID = o; o += al256((size_t)NT * DFF * 2); m.end = o; return m;
}
constexpr WsMap WM = ws_map();
namespace pg8 {
#define PG8_LAS __attribute__((address_space(3)))
typedef unsigned short bf16_t;
typedef short bf16x8 __attribute__((ext_vector_type(8)));
typedef float f32x4 __attribute__((ext_vector_type(4)));
typedef unsigned u32x4 __attribute__((ext_vector_type(4)));
constexpr int BM = 256, BK = 64, HALF = 128, HTB = HALF * BK * 2  , STAGE_BYTES = 8 * HTB, NXCD = 8, WGM = 8;

__host__ __device__ __forceinline__ int lds_byte(int r, int c) { const int st = (r >> 4) * 2 + (c >> 5), rr = r & 15, cc = c & 31, ob = rr * 64 + cc * 2; return st * 1024 + (ob ^ (((ob >> 9) & 1) << 5)); }
__host__ __device__ __forceinline__ void stage_rc(int b, int& R, int& C) { const int st = b / 1024, sb = b % 1024, swz = sb ^ (((sb >> 9) & 1) << 5); R = (st >> 1) * 16 + swz / 64; C = (st & 1) * 32 + (swz % 64) / 2; }
__host__ __device__ __forceinline__ int perm32(int rho) { const int n = rho >> 4, i = rho & 15; return 8 * (i >> 2) + 4 * n + (i & 3); }

struct Unit { int pm, pn; };
struct Gemm { const bf16_t* A; const bf16_t* Bt; int M, N, K; };

struct StaticOrder {
    int nM, nN, nwg, G, c;
    __host__ __device__ void init(int M, int N, int G_, int c_) { nM = M / BM; nN = N / BM; nwg = nM * nN; G = G_; c = c_; }
    __host__ __device__ bool next(int i, Unit& u) const {
        const long L = (long)i * G + c; if (L >= nwg) return false;
        int wgid = (int)L; { const int q = nwg / NXCD, r = nwg % NXCD, xcd = wgid % NXCD, off = wgid / NXCD; wgid = (xcd < r ? xcd * (q + 1) : r * (q + 1) + (xcd - r) * q) + off; }
        const int nig = WGM * nN, gid = wgid / nig, fm = gid * WGM, gsz = (nM - fm) < WGM ? (nM - fm) : WGM;
        u.pm = fm + ((wgid % nig) % gsz); u.pn = (wgid % nig) / gsz; return true;
    }
    __device__ __forceinline__ void a_ready(const Unit&) const {}
    __device__ __forceinline__ void done(const Unit&) const {}
};
typedef float f32x2_t __attribute__((ext_vector_type(2))); typedef __bf16 bf16x2_t __attribute__((ext_vector_type(2)));
__device__ __forceinline__ unsigned cvt_pk_bf16(float lo, float hi) { const f32x2_t v = {lo, hi}; const bf16x2_t b = __builtin_convertvector(v, bf16x2_t); return __builtin_bit_cast(unsigned, b); }
__device__ __forceinline__ float fsigmoid(float x) { return __builtin_amdgcn_rcpf(1.0f + __builtin_amdgcn_exp2f(-1.4426950408889634f * x)); }
__device__ __forceinline__ u32x4 pack8(f32x4 a, f32x4 b) { u32x4 w; w.x = cvt_pk_bf16(a[0], a[1]); w.y = cvt_pk_bf16(a[2], a[3]); w.z = cvt_pk_bf16(b[0], b[1]); w.w = cvt_pk_bf16(b[2], b[3]); return w; }
__device__ __forceinline__ void unpack8(u32x4 w, f32x4& a, f32x4& b) {
    a[0] = __uint_as_float(w.x << 16); a[1] = __uint_as_float(w.x & 0xffff0000u); a[2] = __uint_as_float(w.y << 16); a[3] = __uint_as_float(w.y & 0xffff0000u);
    b[0] = __uint_as_float(w.z << 16); b[1] = __uint_as_float(w.z & 0xffff0000u); b[2] = __uint_as_float(w.w << 16); b[3] = __uint_as_float(w.w & 0xffff0000u); }
__device__ __forceinline__ float row_rs(const float* ss, int row) {
    const f32x4 a = *(const f32x4*)(ss + (size_t)row * 16), b = *(const f32x4*)(ss + (size_t)row * 16 + 4), c = *(const f32x4*)(ss + (size_t)row * 16 + 8), d = *(const f32x4*)(ss + (size_t)row * 16 + 12);
    const float s = (((a[0] + a[1]) + (a[2] + a[3])) + ((b[0] + b[1]) + (b[2] + b[3]))) + (((c[0] + c[1]) + (c[2] + c[3])) + ((d[0] + d[1]) + (d[2] + d[3])));
    return 1.0f / sqrtf(s * (1.0f / D) + EPS); }

struct EpiProj {
    static constexpr bool PERM = true, AFTER_DRAIN = false;
    int layer; unsigned char* ws; float* out; PG8_LAS float* rsl;
    __device__ __forceinline__ void operator()(const f32x4 (&acc)[2][2][4][2], const Unit& u, int wr, int wc, int fr, int fq) const {
        const int pn = u.pn;
        const float* ss = (const float*)((const unsigned*)(ws + WS_CTL) + CW_SS) + (size_t)(2 * layer) * NT * 16;
        { const int t_ = (wr * 4 + wc) * 64 + fq * 16 + fr;
          if (t_ < BM) rsl[t_] = row_rs(ss, u.pm * BM + t_);
          asm volatile("s_waitcnt lgkmcnt(0)" ::: "memory"); __builtin_amdgcn_s_barrier(); asm volatile("" ::: "memory"); }
#define EP_ROW() const int row = u.pm * BM + ai * HALF + wr * 64 + m * 16 + fr; const float rs = rsl[ai * HALF + wr * 64 + m * 16 + fr]; const bool prompt = row < NP; \
                 const int b = prompt ? (row >> 11) : ((row - NP) >> 2), t = prompt ? (row & 2047) : ((row - NP) & 3), pos = prompt ? t : TP + t; (void)b; (void)pos;
#define EP_LOOP _Pragma("unroll") for (int ai = 0; ai < 2; ++ai) _Pragma("unroll") for (int m = 0; m < 4; ++m)
#define EP_FENCE() do { if (m == 3) asm volatile("" ::: "memory"); } while (0)
        if (pn < 4) {
            bf16_t* U = (bf16_t*)(ws + WM.U);
            EP_LOOP { EP_ROW();
                f32x4 uu[2];
#pragma unroll
                for (int n = 0; n < 2; ++n) { const f32x4 a = acc[ai][0][m][n] * rs, bb = acc[ai][1][m][n] * rs;
#pragma unroll
                    for (int i = 0; i < 4; ++i) uu[n][i] = a[i] * fsigmoid(bb[i]); }
                const int col = 128 * pn + 32 * wc + 8 * fq;
                *(u32x4*)(U + (size_t)row * DC + col) = pack8(uu[0], uu[1]);
                if (prompt) { if (t >= TP - 30) { float* o = out + OUT_CONV_P + ((size_t)(layer * BP + b) * 30 + (t - (TP - 30))) * DC + col; *(f32x4*)o = uu[0]; *(f32x4*)(o + 4) = uu[1]; } }
                else { float* o = out + OUT_CONV_S + ((size_t)(layer * BS + b) * 30 + 26 + t) * DC + col; *(f32x4*)o = uu[0]; *(f32x4*)(o + 4) = uu[1]; }
                EP_FENCE(); }
        } else if (pn < 6 || pn == 7 || pn == 8) {
            const bool isq = pn < 6; const int kv = wc >> 1, g = wc & 1, d0 = 8 * fq; const bool rot = isq || kv == 0;
            const float* rope = (const float*)(ws + WM.rope);
            EP_LOOP { EP_ROW();
                f32x4 o1[2], o2[2];
                const float* rp = rope + (size_t)pos * 64 + d0;
#pragma unroll
                for (int n = 0; n < 2; ++n) { const f32x4 x1 = acc[ai][0][m][n] * rs, x2 = acc[ai][1][m][n] * rs;
                    if (rot) { const f32x4 c = *(const f32x4*)(rp + 4 * n), s = *(const f32x4*)(rp + 32 + 4 * n); o1[n] = x1 * c - x2 * s; o2[n] = x2 * c + x1 * s; }
                    else { o1[n] = x1; o2[n] = x2; } }
                if (isq) { const int h = 4 * (pn - 4) + wc; bf16_t* qp = (bf16_t*)(ws + WM.Q) + (size_t)row * 512 + h * 64 + d0; const float c2 = 0.125f * 1.4426950408889634f;
                    *(u32x4*)qp = pack8(o1[0] * c2, o1[1] * c2); *(u32x4*)(qp + 32) = pack8(o2[0] * c2, o2[1] * c2); }
                else { const int col = kv * 128 + g * 64 + d0; bf16_t* kp = (bf16_t*)(ws + (pn == 7 ? WM.SKV : WM.WKV)) + (size_t)row * 256 + col;
                    *(u32x4*)kp = pack8(o1[0], o1[1]); *(u32x4*)(kp + 32) = pack8(o2[0], o2[1]);
                    float* o = nullptr;
                    if (pn == 7) o = prompt ? out + OUT_SEL_P + ((size_t)layer * NP + row) * 256 + col : out + OUT_SEL_S + ((size_t)layer * NS + (row - NP)) * 256 + col;
                    else if (prompt) { if (t >= TP - 512) o = out + OUT_WIN_P + ((size_t)(layer * BP + b) * 512 + (t - (TP - 512))) * 256 + col; }
                    else o = out + OUT_WIN_S + ((size_t)(layer * BS + b) * 512 + 508 + t) * 256 + col;
                    if (o) { __builtin_nontemporal_store(o1[0], (f32x4*)o); __builtin_nontemporal_store(o1[1], (f32x4*)(o + 4)); __builtin_nontemporal_store(o2[0], (f32x4*)(o + 32)); __builtin_nontemporal_store(o2[1], (f32x4*)(o + 36)); } }
                EP_FENCE(); }
        } else if (pn == 6) {
            bf16_t* CKV = (bf16_t*)(ws + WM.CKV);
            EP_LOOP { EP_ROW();
#pragma unroll
                for (int bj = 0; bj < 2; ++bj) { const int col = 128 * bj + 32 * wc + 8 * fq; const f32x4 v0 = acc[ai][bj][m][0] * rs, v1 = acc[ai][bj][m][1] * rs;
                    *(u32x4*)(CKV + (size_t)row * 256 + col) = pack8(v0, v1);
                    float* o = prompt ? out + OUT_CMP_P + ((size_t)layer * NP + row) * 256 + col : out + OUT_CMP_S + ((size_t)layer * NS + (row - NP)) * 256 + col;
                    __builtin_nontemporal_store(v0, (f32x4*)o); __builtin_nontemporal_store(v1, (f32x4*)(o + 4)); }
                EP_FENCE(); }
        } else if (pn < 17) {
            bf16_t* GM = (bf16_t*)(ws + WM.GM);
            EP_LOOP { EP_ROW();
#pragma unroll
                for (int bj = 0; bj < 2; ++bj) { const int col = (pn - 9) * 256 + 128 * bj + 32 * wc + 8 * fq; f32x4 v0 = acc[ai][bj][m][0] * rs, v1 = acc[ai][bj][m][1] * rs;
#pragma unroll
                    for (int i = 0; i < 4; ++i) { v0[i] = fsigmoid(v0[i]); v1[i] = fsigmoid(v1[i]); }
                    *(u32x4*)(GM + (size_t)row * 2048 + col) = pack8(v0, v1); }
                EP_FENCE(); }
        } else {
            float* GN = (float*)(ws + WM.GN);
            if (wc == 0 && fq < 3) {
                EP_LOOP { EP_ROW();
#pragma unroll
                    for (int n = 0; n < 2; ++n) { f32x4 v = acc[ai][0][m][n] * rs;
#pragma unroll
                        for (int i = 0; i < 4; ++i) v[i] = fsigmoid(v[i]);
                        *(f32x4*)(GN + (size_t)row * 24 + 8 * fq + 4 * n) = v; }
                    EP_FENCE(); }
            }
        }
#undef EP_ROW
#undef EP_LOOP
#undef EP_FENCE
    }
};
struct EpiRelu2 {
    static constexpr bool PERM = true, AFTER_DRAIN = false;
    const float* ss; bf16_t* H;
    __device__ __forceinline__ void operator()(const f32x4 (&acc)[2][2][4][2], const Unit& u, int wr, int wc, int fr, int fq) const {
#pragma unroll
        for (int ai = 0; ai < 2; ++ai)
#pragma unroll
            for (int m = 0; m < 4; ++m) {
                const int row = u.pm * BM + ai * HALF + wr * 64 + m * 16 + fr; const float rs = row_rs(ss, row);
#pragma unroll
                for (int bj = 0; bj < 2; ++bj) { const int col = u.pn * BM + 128 * bj + 32 * wc + 8 * fq; f32x4 v0 = acc[ai][bj][m][0] * rs, v1 = acc[ai][bj][m][1] * rs;
#pragma unroll
                    for (int i = 0; i < 4; ++i) { float a = fmaxf(v0[i], 0.f), c = fmaxf(v1[i], 0.f); v0[i] = a * a; v1[i] = c * c; }
                    *(u32x4*)(H + (size_t)row * DFF + col) = pack8(v0, v1); }
            }
    }
};
template <int MODE> struct EpiGate {
    static constexpr bool PERM = true, AFTER_DRAIN = false;
    const bf16_t* GM; bf16_t* T;
    __device__ __forceinline__ void operator()(const f32x4 (&acc)[2][2][4][2], const Unit& u, int wr, int wc, int fr, int fq) const {
#pragma unroll
        for (int ai = 0; ai < 2; ++ai)
#pragma unroll
            for (int m = 0; m < 4; ++m) {
                const int row = u.pm * BM + ai * HALF + wr * 64 + m * 16 + fr;
#pragma unroll
                for (int bj = 0; bj < 2; ++bj) { const int col = u.pn * BM + 128 * bj + 32 * wc + 8 * fq;
                    f32x4 g0, g1; unpack8(*(const u32x4*)(GM + (size_t)row * 2048 + MODE * 1024 + col), g0, g1);
                    f32x4 v0 = acc[ai][bj][m][0] * g0, v1 = acc[ai][bj][m][1] * g1;
                    if (MODE == 1) { f32x4 t0, t1; unpack8(*(const u32x4*)(T + (size_t)row * D + col), t0, t1); v0 += t0; v1 += t1; }
                    *(u32x4*)(T + (size_t)row * D + col) = pack8(v0, v1); }
            }
    }
};
struct EpiRes {
    static constexpr bool PERM = true, AFTER_DRAIN = false;
    float* X; bf16_t* XB; float* ssn; const float* Xs; bool wxb;
    __device__ __forceinline__ void operator()(const f32x4 (&acc)[2][2][4][2], const Unit& u, int wr, int wc, int fr, int fq) const {
#pragma unroll
        for (int ai = 0; ai < 2; ++ai)
#pragma unroll
            for (int m = 0; m < 4; ++m) {
                const int row = u.pm * BM + ai * HALF + wr * 64 + m * 16 + fr; float q = 0.f;
#pragma unroll
                for (int bj = 0; bj < 2; ++bj) { const int col = u.pn * BM + 128 * bj + 32 * wc + 8 * fq; float* xp = X + (size_t)row * D + col; const float* xs = Xs + (size_t)row * D + col;
                    const f32x4 x0 = *(const f32x4*)xs + acc[ai][bj][m][0], x1 = *(const f32x4*)(xs + 4) + acc[ai][bj][m][1];
                    *(f32x4*)xp = x0; *(f32x4*)(xp + 4) = x1; if (wxb) *(u32x4*)(XB + (size_t)row * D + col) = pack8(x0, x1);
                    q += (x0[0] * x0[0] + x0[1] * x0[1]) + (x0[2] * x0[2] + x0[3] * x0[3]) + (x1[0] * x1[0] + x1[1] * x1[1]) + (x1[2] * x1[2] + x1[3] * x1[3]); }
                q += __shfl_xor(q, 16); q += __shfl_xor(q, 32);
                if (fq == 0) ssn[(size_t)row * 16 + u.pn * 4 + wc] = q;
            }
    }
};
template <class Epi, class Sched, bool ALIGN_EPI = false, bool SP2 = false>
__device__ __forceinline__ void gemm_phase(PG8_LAS unsigned char* lds, const Gemm g, const Sched& S, const Epi& E, const int wave_id) {
    int tid_ = wave_id * 64 + (int)__builtin_amdgcn_mbcnt_hi(~0u, __builtin_amdgcn_mbcnt_lo(~0u, 0u)); asm volatile("" : "+v"(tid_));
    const int tid = tid_, wid = __builtin_amdgcn_readfirstlane(tid >> 6), lane = tid & 63, wr = wid >> 2, wc = wid & 3, fr = lane & 15, fq = lane >> 4;
    const int K = g.K, nt = K / BK;
    unsigned voffA[2], voffB[2];
#pragma unroll
    for (int i = 0; i < 2; ++i) { int R, C; stage_rc(tid * 16 + i * 8192, R, C); const int Rb = Epi::PERM ? ((R & ~31) + perm32(R & 31)) : R;
        voffA[i] = (unsigned)(R * K + C) * 2u; voffB[i] = (unsigned)(Rb * K + C) * 2u; }
    const size_t kstep = (size_t)(BK * 2);
    const size_t hstep = (size_t)HALF * K * 2;
    const size_t tstep = 2 * hstep;
    const unsigned ldsw = (unsigned)wid * 1024u;
    const int aoff = lds_byte(wr * 64 + fr, fq * 8), boff = lds_byte(wc * 32 + fr, fq * 8);
#define PG8_SA(b, h) (((b) * 2 + (h)) * HTB)
#define PG8_SB(b, h) ((4 + (b) * 2 + (h)) * HTB)
#define PG8_STAGE(bufoff, gbase, voff) do { _Pragma("unroll") for (int _i = 0; _i < 2; ++_i) \
        __builtin_amdgcn_global_load_lds((const unsigned*)((const char*)(gbase) + (voff)[_i]), (PG8_LAS unsigned*)(lds + (bufoff) + ldsw + _i * 8192), 16, 0, 0); } while (0)
#define PG8_LDA(dst, b, h) do { _Pragma("unroll") for (int m = 0; m < 4; ++m) _Pragma("unroll") for (int k = 0; k < 2; ++k) dst[m][k] = *(const PG8_LAS bf16x8*)(lds + PG8_SA(b, h) + aoff + m * 2048 + k * 1024); } while (0)
#define PG8_LDB(dst, b, h) do { _Pragma("unroll") for (int n = 0; n < 2; ++n) _Pragma("unroll") for (int k = 0; k < 2; ++k) dst[n][k] = *(const PG8_LAS bf16x8*)(lds + PG8_SB(b, h) + boff + n * 2048 + k * 1024); } while (0)
#define PG8_MMA(ai, bj, At, Bt) do { __builtin_amdgcn_s_setprio(1); _Pragma("unroll") for (int m = 0; m < 4; ++m) _Pragma("unroll") for (int n = 0; n < 2; ++n) _Pragma("unroll") for (int k = 0; k < 2; ++k) \
        acc[ai][bj][m][n] = __builtin_amdgcn_mfma_f32_16x16x32_bf16(Bt[n][k], At[m][k], acc[ai][bj][m][n], 0, 0, 0); __builtin_amdgcn_s_setprio(0); } while (0)
#define PG8_WAIT_V(n) asm volatile("s_waitcnt vmcnt(" #n ")" ::: "memory")
#define PG8_WAIT_L(n) asm volatile("s_waitcnt lgkmcnt(" #n ")" ::: "memory")
#define PG8_BAR __builtin_amdgcn_s_barrier()
#define PG8_SCHED __builtin_amdgcn_sched_barrier(0)
    Unit cur, nxt; int ui = 0;
    if (!S.next(0, cur)) return;
    f32x4 acc[2][2][4][2];
#pragma unroll
    for (int a = 0; a < 2; ++a)
#pragma unroll
        for (int b = 0; b < 2; ++b)
#pragma unroll
            for (int m = 0; m < 4; ++m)
#pragma unroll
                for (int n = 0; n < 2; ++n) acc[a][b][m][n] = (f32x4){0.f, 0.f, 0.f, 0.f};
    bf16x8 At[4][2], B0[2][2], B1[2][2];
    const char* cA = (const char*)g.A + (size_t)cur.pm * tstep; const char* cB = (const char*)g.Bt + (size_t)cur.pn * tstep;
    S.a_ready(cur);
    if constexpr (SP2) {
        PG8_STAGE(PG8_SB(0, 0), cB, voffB); PG8_STAGE(PG8_SB(0, 1), cB + hstep, voffB); PG8_STAGE(PG8_SA(0, 0), cA, voffA); PG8_STAGE(PG8_SA(0, 1), cA + hstep, voffA);
        if (wr == 1) PG8_BAR;
        PG8_WAIT_V(2); PG8_BAR;
        PG8_STAGE(PG8_SB(1, 0), cB + kstep, voffB); PG8_STAGE(PG8_SA(1, 0), cA + kstep, voffA); PG8_STAGE(PG8_SB(1, 1), cB + hstep + kstep, voffB);
        PG8_WAIT_V(6); PG8_BAR;
    } else {
        PG8_STAGE(PG8_SB(0, 0), cB, voffB); PG8_STAGE(PG8_SA(0, 0), cA, voffA); PG8_STAGE(PG8_SB(0, 1), cB + hstep, voffB); PG8_STAGE(PG8_SA(0, 1), cA + hstep, voffA);
        if (wr == 1) PG8_BAR;
        PG8_WAIT_V(4); PG8_BAR;
        PG8_STAGE(PG8_SB(1, 0), cB + kstep, voffB); PG8_STAGE(PG8_SA(1, 0), cA + kstep, voffA); PG8_STAGE(PG8_SB(1, 1), cB + hstep + kstep, voffB);
        PG8_WAIT_V(6); PG8_BAR;
    }
    for (;;) {
        const bool has_next = S.next(ui + 1, nxt);
        const char* nA = has_next ? (const char*)g.A + (size_t)nxt.pm * tstep : cA; const char* nB = has_next ? (const char*)g.Bt + (size_t)nxt.pn * tstep : cB;
        for (int t = 0; t < nt; t += 2) {
            const bool last = (t == nt - 2);
            const char* a1 = cA + (size_t)(t + 1) * kstep;
            const char* a2 = last ? nA : cA + (size_t)(t + 2) * kstep; const char* b2 = last ? nB : cB + (size_t)(t + 2) * kstep;
            const char* a3 = a2 + kstep; const char* b3 = b2 + kstep;
            if (last && has_next) S.a_ready(nxt);
            if constexpr (SP2) {
            PG8_LDB(B0, 0, 0); PG8_LDB(B1, 0, 1); PG8_SCHED; PG8_LDA(At, 0, 0); PG8_STAGE(PG8_SA(1, 1), a1 + hstep, voffA);
            PG8_WAIT_V(8); PG8_WAIT_L(0); PG8_BAR; PG8_MMA(0, 0, At, B0); PG8_MMA(0, 1, At, B1); PG8_BAR; PG8_SCHED;
            PG8_LDA(At, 0, 1); PG8_STAGE(PG8_SB(0, 0), b2, voffB); PG8_STAGE(PG8_SB(0, 1), b2 + hstep, voffB); PG8_STAGE(PG8_SA(0, 0), a2, voffA);
            PG8_WAIT_V(8); PG8_WAIT_L(0); PG8_BAR; PG8_MMA(1, 0, At, B0); PG8_MMA(1, 1, At, B1); PG8_BAR; PG8_SCHED;
            PG8_LDB(B0, 1, 0); PG8_LDB(B1, 1, 1); PG8_SCHED; PG8_LDA(At, 1, 0); PG8_STAGE(PG8_SA(0, 1), a2 + hstep, voffA);
            PG8_WAIT_V(8); PG8_WAIT_L(0); PG8_BAR; PG8_MMA(0, 0, At, B0); PG8_MMA(0, 1, At, B1); PG8_BAR; PG8_SCHED;
            PG8_LDA(At, 1, 1); PG8_STAGE(PG8_SB(1, 0), b3, voffB); PG8_STAGE(PG8_SB(1, 1), b3 + hstep, voffB); PG8_STAGE(PG8_SA(1, 0), a3, voffA);
            PG8_WAIT_V(8); PG8_WAIT_L(0); PG8_BAR; PG8_MMA(1, 0, At, B0); PG8_MMA(1, 1, At, B1); PG8_BAR; PG8_SCHED;
            } else {
            PG8_LDB(B0, 0, 0); PG8_SCHED; PG8_LDA(At, 0, 0); PG8_STAGE(PG8_SA(1, 1), a1 + hstep, voffA);
            PG8_WAIT_L(8); PG8_BAR; PG8_WAIT_L(0); PG8_MMA(0, 0, At, B0); PG8_BAR; PG8_SCHED;
            PG8_LDB(B1, 0, 1); PG8_STAGE(PG8_SB(0, 0), b2, voffB);
            PG8_BAR; PG8_WAIT_L(0); PG8_MMA(0, 1, At, B1); PG8_BAR;
            PG8_LDA(At, 0, 1); PG8_STAGE(PG8_SA(0, 0), a2, voffA);
            PG8_BAR; PG8_WAIT_L(0); PG8_MMA(1, 0, At, B0); PG8_BAR; PG8_SCHED;
            PG8_STAGE(PG8_SB(0, 1), b2 + hstep, voffB);
            PG8_WAIT_V(6); PG8_BAR; PG8_MMA(1, 1, At, B1); PG8_BAR;
            PG8_LDB(B0, 1, 0); PG8_SCHED; PG8_LDA(At, 1, 0); PG8_STAGE(PG8_SA(0, 1), a2 + hstep, voffA);
            PG8_WAIT_L(8); PG8_BAR; PG8_WAIT_L(0); PG8_MMA(0, 0, At, B0); PG8_BAR; PG8_SCHED;
            PG8_LDB(B1, 1, 1); PG8_STAGE(PG8_SB(1, 0), b3, voffB);
            PG8_BAR; PG8_WAIT_L(0); PG8_MMA(0, 1, At, B1); PG8_BAR;
            PG8_LDA(At, 1, 1); PG8_STAGE(PG8_SA(1, 0), a3, voffA);
            PG8_BAR; PG8_WAIT_L(0); PG8_MMA(1, 0, At, B0); PG8_BAR; PG8_SCHED;
            PG8_STAGE(PG8_SB(1, 1), b3 + hstep, voffB);
            PG8_WAIT_V(6); PG8_BAR; PG8_MMA(1, 1, At, B1); PG8_BAR;
            }
        }
        if constexpr (ALIGN_EPI) { if (wr == 0) PG8_BAR; }
        if constexpr (!Epi::AFTER_DRAIN) { E(acc, cur, wr, wc, fr, fq); S.done(cur); }
        if (!has_next) break;
#pragma unroll
        for (int a = 0; a < 2; ++a)
#pragma unroll
            for (int b = 0; b < 2; ++b)
#pragma unroll
                for (int m = 0; m < 4; ++m)
#pragma unroll
                    for (int n = 0; n < 2; ++n) acc[a][b][m][n] = (f32x4){0.f, 0.f, 0.f, 0.f};
        cur = nxt; cA = nA; cB = nB; ++ui;
        if constexpr (ALIGN_EPI) { if (wr == 1) PG8_BAR; }
    }
    PG8_WAIT_V(0);
    if constexpr (!ALIGN_EPI) { if (wr == 0) PG8_BAR; }
    PG8_BAR;
    if constexpr (Epi::AFTER_DRAIN) { E.fused(acc, cur, wr, wc, fr, fq, lds, wid, lane); S.done(cur); }
#undef PG8_SA
#undef PG8_SB
#undef PG8_STAGE
#undef PG8_LDA
#undef PG8_LDB
#undef PG8_MMA
#undef PG8_WAIT_V
#undef PG8_WAIT_L
#undef PG8_BAR
#undef PG8_SCHED
}
}
#define XB_TMO      128
#define XB_XCNT(j)  (256  + 64 * (j))
#define XB_XSUB(j)  (1280 + 64 * (j))
#define XB_XGEN(j)  (2304 + 64 * (j))
#define XB_TOP      3328
#define XB_TOPGEN   3392
#define XCD_BAR_WORDS 3456
#define XB_SPIN_CAP (1u << 22)

__device__ __forceinline__ unsigned xb_ld(unsigned* p)              { return __hip_atomic_load(p, __ATOMIC_RELAXED, __HIP_MEMORY_SCOPE_AGENT); }
__device__ __forceinline__ unsigned xb_add(unsigned* p, unsigned v) { return __hip_atomic_fetch_add(p, v, __ATOMIC_RELAXED, __HIP_MEMORY_SCOPE_AGENT); }
__device__ __forceinline__ unsigned xb_xcc_id() { return (unsigned)__builtin_amdgcn_s_getreg((3 << 11) | 20) & 0xFu; }
#define XB_SPIN(cond, bar) do { unsigned _sp = 0; while (cond) { __builtin_amdgcn_s_sleep(1); \
    if ((++_sp & 255u) == 0u) { if (xb_ld(&(bar)[XB_TMO])) break; if (_sp > XB_SPIN_CAP) { atomicAdd(&(bar)[XB_TMO], 1u); break; } } } } while (0)

struct XcdBarrier {
    unsigned* bar; unsigned x;
    volatile LAS unsigned* st;
    bool t0;
};

__device__ __forceinline__ XcdBarrier xcd_barrier_post(unsigned* bar, volatile LAS unsigned* st, bool t0) {
    XcdBarrier b; b.bar = bar; b.x = xb_xcc_id(); b.st = st; b.t0 = t0;
    if (t0) (void)xb_add(&bar[XB_XCNT(b.x)], 1u);
    return b;
}
__device__ __forceinline__ void xcd_barrier_complete(unsigned* bar, unsigned x, unsigned& nloc, unsigned& nx) {
    const unsigned G = gridDim.x * gridDim.y * gridDim.z;
    unsigned sum, cnt, mine, sp = 0u;
    for (;;) {
        sum = 0u; cnt = 0u; mine = 0u;
#pragma unroll
        for (unsigned j = 0; j < 16; ++j) { const unsigned c = xb_ld(&bar[XB_XCNT(j)]); sum += c; cnt += (c > 0u) ? 1u : 0u; mine = (j == x) ? c : mine; }
        if (sum == G) break;
        __builtin_amdgcn_s_sleep(1);
        if ((++sp & 255u) == 0u) { if (xb_ld(&bar[XB_TMO])) break; if (sp > XB_SPIN_CAP) { atomicAdd(&bar[XB_TMO], 1u); break; } }
    }
    nloc = mine > 0u ? mine : 1u; nx = cnt > 0u ? cnt : 1u;
}

__device__ __forceinline__ void xcd_barrier(const XcdBarrier& b) {
    asm volatile("s_waitcnt vmcnt(0)" ::: "memory");
    __syncthreads();
    if (b.t0) {
        unsigned* bar = b.bar;
        __builtin_amdgcn_s_waitcnt(0);
        unsigned nloc = b.st[0], nx = b.st[1];
        if (nloc == 0u) { xcd_barrier_complete(bar, b.x, nloc, nx); b.st[0] = nloc; b.st[1] = nx; }
        const unsigned old = xb_add(&bar[XB_XSUB(b.x)], 1u);
        const unsigned gen = old / nloc;
        if (old + 1u == (gen + 1u) * nloc) {
            __builtin_amdgcn_fence(__ATOMIC_RELEASE, "agent");
            asm volatile("s_waitcnt vmcnt(0)" ::: "memory");
            const unsigned og = xb_add(&bar[XB_TOP], 1u);
            const unsigned tg = og / nx;
            if (og + 1u == (tg + 1u) * nx) xb_add(&bar[XB_TOPGEN], 1u);
            else XB_SPIN(xb_ld(&bar[XB_TOPGEN]) == tg, bar);
            __builtin_amdgcn_fence(__ATOMIC_ACQUIRE, "agent");
            xb_add(&bar[XB_XGEN(b.x)], 1u);
            asm volatile("s_waitcnt vmcnt(0)" ::: "memory");
        } else {
            XB_SPIN(xb_ld(&bar[XB_XGEN(b.x)]) == gen, bar);
            __builtin_amdgcn_fence(__ATOMIC_ACQUIRE, "agent");
            asm volatile("s_waitcnt vmcnt(0)" ::: "memory");
        }
    }
    __syncthreads();
}
typedef unsigned short bf16;
typedef unsigned v4u __attribute__((ext_vector_type(4)));
typedef float f32x4 __attribute__((ext_vector_type(4)));
constexpr int NWAVES = 8, NTHREADS = 512;
constexpr int LDS_BYTES = 147456, RING_BYTES = 131072, LDSCTL_OFF = LDS_BYTES - 1024;
struct Args {
    const float *x_prompt, *x_sample, *cache_cmp, *cache_sel, *state_win, *state_conv; const int* page_table;
    const float *norm_mix_g, *w_in, *dw_w, *dw_b, *ln_g, *ln_b, *w_conv_out, *cmp_pos, *w_cmp, *w_nsa_out, *w_out, *norm_mlp_g, *w_up, *w_down, *norm_final_g;
    float* out; unsigned char* ws; int ph_lo, ph_hi;
};
struct Frame {
    LAS unsigned char* lds; int tid, lane, wave, G, bid;
    const __attribute__((address_space(4))) Args* a;
};
#define WSP(T, off) ((T*)(F.a->ws + (off)))
#define F_ctl   WSP(unsigned, WS_CTL)
#define F_ss    ((float*)(WSP(unsigned, WS_CTL) + CW_SS))
#define F_w1    WSP(bf16, WM.w1)
#define F_wc    WSP(bf16, WM.wc)
#define F_wn    WSP(bf16, WM.wn)
#define F_wo    WSP(bf16, WM.wo)
#define F_wup   WSP(bf16, WM.wup)
#define F_wdn   WSP(bf16, WM.wdn)
#define F_wstr  (WM.wstride / 2)
#define F_wcmp  WSP(bf16, WM.wcmp)
#define F_cbias WSP(float, WM.cbias)
#define F_rope  WSP(float, WM.rope)
#define F_X     WSP(float, WM.X)
#define F_XB    WSP(bf16, WM.XB)
#define F_U     WSP(bf16, WM.U)
#define F_Q     WSP(bf16, WM.Q)
#define F_CKV   WSP(bf16, WM.CKV)
#define F_SKV   WSP(bf16, WM.SKV)
#define F_WKV   WSP(bf16, WM.WKV)
#define F_GN    WSP(float, WM.GN)
#define F_GM    WSP(bf16, WM.GM)
#define F_CACT  WSP(bf16, WM.CACT)
#define F_KC    WSP(float, WM.KC)
#define F_VC    WSP(float, WM.VC)
#define F_KCB   WSP(bf16, WM.KCB)
#define F_VCB   WSP(bf16, WM.VCB)
#define F_O     WSP(bf16, WM.O)
#define F_T     WSP(bf16, WM.T)
#define F_HID   WSP(bf16, WM.HID)
DEV float bf2f(bf16 v) { return __uint_as_float((unsigned)v << 16); }
DEV unsigned f2bf(float f) { unsigned u = __builtin_bit_cast(unsigned, f); return (u + 0x7fffu + ((u >> 16) & 1u)) >> 16; }
DEV unsigned pk2(float lo, float hi) { return f2bf(lo) | (f2bf(hi) << 16); }
template <int CTRL> DEV float dpp_mov(float v) { return __int_as_float(__builtin_amdgcn_update_dpp(0, __float_as_int(v), CTRL, 0xf, 0xf, false)); }
DEV float wave_sum(float v) {
    { const auto r = __builtin_amdgcn_permlane32_swap(__float_as_uint(v), __float_as_uint(v), false, false); v = __uint_as_float(r[0]) + __uint_as_float(r[1]); }
    v += __shfl_xor(v, 16);
    v += dpp_mov<0x140>(v);
    v += dpp_mov<0x141>(v);
    v += dpp_mov<0x4E>(v);
    v += dpp_mov<0xB1>(v);
    return v;
}
DEV float wave_max(float v) {
#pragma unroll
    for (int o = 32; o > 0; o >>= 1) v = fmaxf(v, __shfl_xor(v, o));
    return v;
}
DEV float sigm(float x) { return 1.0f / (1.0f + expf(-x)); }

DEV void tr_item(const float* W, int K, int N, bf16* WT, int dst_row0, int src_col0, int cnt, const float* ksc, LAS float* scr, int k0, int lane) {
    const int kk8 = lane >> 3, c4 = (lane & 7) * 4;
    f32x4 v[8];
#pragma unroll
    for (int i = 0; i < 8; ++i) { v[i] = (f32x4){0.f, 0.f, 0.f, 0.f}; if (c4 < cnt) v[i] = *(const f32x4*)(W + (size_t)(k0 + 8 * i + kk8) * N + src_col0 + c4); }
#pragma unroll
    for (int i = 0; i < 8; ++i) { const int kk = 8 * i + kk8; f32x4 x = v[i]; if (ksc) x = x * ksc[k0 + kk];
        scr[kk * 33 + c4] = x[0]; scr[kk * 33 + c4 + 1] = x[1]; scr[kk * 33 + c4 + 2] = x[2]; scr[kk * 33 + c4 + 3] = x[3]; }
    asm volatile("s_waitcnt lgkmcnt(0)" ::: "memory");
    const int c8 = lane & 7;
#pragma unroll
    for (int j = 0; j < 4; ++j) { const int n = (lane >> 3) + 8 * j; const LAS float* s = scr + (8 * c8) * 33 + n;
        v4u o; o.x = pk2(s[0 * 33], s[1 * 33]); o.y = pk2(s[2 * 33], s[3 * 33]); o.z = pk2(s[4 * 33], s[5 * 33]); o.w = pk2(s[6 * 33], s[7 * 33]);
        *(v4u*)(WT + (size_t)(dst_row0 + n) * K + k0 + 8 * c8) = o; }
    asm volatile("s_waitcnt lgkmcnt(0)" ::: "memory");
}
DEV void w1_map(int ng, int& src, int& cnt) {
    const int t = ng >> 3, j0 = (ng & 7) * 32, bj = j0 >> 7, jj = j0 & 127; cnt = 32;
    if (t < 4) src = 128 * t + jj + 512 * bj;
    else if (t < 6) src = 1024 + (4 * (t - 4) + (jj >> 5)) * 64 + 32 * bj;
    else if (t == 6) src = 1536 + j0;
    else if (t < 9) { const int seg = jj >> 5; src = 1792 + 256 * (t - 7) + (seg >> 1) * 128 + (seg & 1) * 64 + 32 * bj; }
    else if (t < 17) src = 2328 + (t - 9) * 256 + j0;
    else { src = 2304; cnt = (j0 == 0) ? 24 : 0; }
}
DEV void p0_prologue(Frame& F) {
    LAS float* scr = (LAS float*)(F.lds + F.wave * 16384);
    const int gw = F.bid * NWAVES + F.wave, NGW = F.G * NWAVES, lane = F.lane;
    constexpr int I_W1 = 16 * 144, I_WC = 8 * 32, I_WO = 16 * 32, I_WUP = 16 * 128, I_WDN = 64 * 32, I_L = I_W1 + 2 * I_WC + I_WO + I_WUP + I_WDN, I_CMP = 256;
    for (int it = gw; it < 2 * I_L + I_CMP; it += NGW) {
        if (it >= 2 * I_L) {
            const int r = it - 2 * I_L, lk = r >> 6, lh = (r >> 5) & 1, q = r & 31, kb = q >> 1, nb = q & 1;
            tr_item(F.a->w_cmp + ((size_t)lk * 32 + 16 * lh) * 4096, 1024, 64, F_wcmp + (size_t)lk * 128 * 1024, lh * 64 + nb * 32, nb * 32, 32, nullptr, scr, kb * 64, lane);
            continue;
        }
        const int l = it / I_L; int r = it % I_L;
        if (r < I_W1) { const int kb = r / 144, ng = r % 144; int src, cnt; w1_map(ng, src, cnt);
            tr_item(F.a->w_in + (size_t)l * D * INC, D, INC, (F_w1 + l * F_wstr), ng * 32, src, cnt, F.a->norm_mix_g + l * D, scr, kb * 64, lane); continue; } r -= I_W1;
        if (r < I_WC) { tr_item(F.a->w_conv_out + (size_t)l * DC * D, DC, D, (F_wc + l * F_wstr), (r % 32) * 32, (r % 32) * 32, 32, nullptr, scr, (r / 32) * 64, lane); continue; } r -= I_WC;
        if (r < I_WC) { tr_item(F.a->w_nsa_out + (size_t)l * 512 * D, 512, D, (F_wn + l * F_wstr), (r % 32) * 32, (r % 32) * 32, 32, nullptr, scr, (r / 32) * 64, lane); continue; } r -= I_WC;
        if (r < I_WO) { tr_item(F.a->w_out + (size_t)l * D * D, D, D, (F_wo + l * F_wstr), (r % 32) * 32, (r % 32) * 32, 32, nullptr, scr, (r / 32) * 64, lane); continue; } r -= I_WO;
        if (r < I_WUP) { tr_item(F.a->w_up + (size_t)l * D * DFF, D, DFF, (F_wup + l * F_wstr), (r % 128) * 32, (r % 128) * 32, 32, F.a->norm_mlp_g + l * D, scr, (r / 128) * 64, lane); continue; } r -= I_WUP;
        tr_item(F.a->w_down + (size_t)l * DFF * D, DFF, D, (F_wdn + l * F_wstr), (r % 32) * 32, (r % 32) * 32, 32, nullptr, scr, (r / 32) * 64, lane);
    }
    __syncthreads();
    if (F.bid < 4) { const float* W = F.a->w_cmp + (size_t)F.bid * 32 * 4096; const float* PE = F.a->cmp_pos + (size_t)F.bid * 2048; LAS float* part = (LAS float*)F.lds;
        float a0 = 0.f, a1 = 0.f, a2 = 0.f, a3 = 0.f;
#pragma unroll 4
        for (int k = 256 * F.wave; k < 256 * F.wave + 256; k += 4) { a0 += PE[k] * W[(size_t)k * 64 + lane]; a1 += PE[k + 1] * W[(size_t)(k + 1) * 64 + lane]; a2 += PE[k + 2] * W[(size_t)(k + 2) * 64 + lane]; a3 += PE[k + 3] * W[(size_t)(k + 3) * 64 + lane]; }
        part[F.wave * 64 + lane] = (a0 + a1) + (a2 + a3);
        __syncthreads();
        if (F.wave == 0) { float s = 0.f;
#pragma unroll
            for (int w2 = 0; w2 < 8; ++w2) s += part[w2 * 64 + lane];
            F_cbias[F.bid * 64 + lane] = s; } }
    for (int idx = F.bid * NTHREADS + F.tid; idx < 2052 * 32; idx += F.G * NTHREADS) { const int pos = idx >> 5, i = idx & 31;
        const double ang = (double)pos * pow(10000.0, -(double)i / 32.0);
        F_rope[pos * 64 + i] = (float)cos(ang); F_rope[pos * 64 + 32 + i] = (float)sin(ang); }
    for (int r = (F.G > 4 ? gw - 4 * NWAVES : gw); r < NT && (F.G <= 4 || F.bid >= 4); r += (F.G > 4 ? NGW - 4 * NWAVES : NGW)) {
        const float* src = r < NP ? F.a->x_prompt + (size_t)r * D : F.a->x_sample + (size_t)(r - NP) * D; float q = 0.f;
#pragma unroll
        for (int j = 0; j < 4; ++j) { const f32x4 v = *(const f32x4*)(src + j * 256 + lane * 4);
            unsigned long long w = (unsigned long long)pk2(v[0], v[1]) | ((unsigned long long)pk2(v[2], v[3]) << 32); *(unsigned long long*)(F_XB + (size_t)r * D + j * 256 + lane * 4) = w;
            q += (v[0] * v[0] + v[1] * v[1]) + (v[2] * v[2] + v[3] * v[3]); }
        q = wave_sum(q); if (lane < 16) F_ss[(size_t)r * 16 + lane] = lane == 0 ? q : 0.f;
    }
    { const unsigned stride = (unsigned)F.G * NTHREADS;
      constexpr unsigned per2 = 26u * DC / 4u, n2 = 2u * BS * per2;
      for (unsigned i = (unsigned)F.bid * NTHREADS + (unsigned)F.tid; i < n2; i += stride) { const unsigned lb = i / per2, o = i - lb * per2;
          ((f32x4*)(F.a->out + OUT_CONV_S + (size_t)lb * 30 * DC))[o] = ((const f32x4*)(F.a->state_conv + ((size_t)lb * 30 + 4) * DC))[o]; } }
}

DEV void ph_conv_simple(Frame& F, int l) {
    LAS float* red = (LAS float*)F.lds;
    const int c = F.tid;
    for (int r = F.bid; r < NT; r += F.G) {
        const bool prompt = r < NP; const int b = prompt ? r / TP : (r - NP) / TS, t = prompt ? r % TP : (r - NP) % TS;
        float a = F.a->dw_b[l * DC + c];
        for (int k = 0; k < CK; ++k) { float v;
            if (prompt) { const int tt = t + k - 30; v = tt >= 0 ? bf2f(F_U[((size_t)b * TP + tt) * DC + c]) : 0.f; }
            else { const int j = t + k; v = j < 30 ? F.a->state_conv[((size_t)(l * BS + b) * 30 + j) * DC + c] : bf2f(F_U[((size_t)NP + b * TS + (j - 30)) * DC + c]); }
            a += v * F.a->dw_w[((size_t)l * CK + k) * DC + c]; }
        float s = wave_sum(a);
        __syncthreads();
        if (F.lane == 0) red[F.wave] = s;
        __syncthreads();
        float mean = 0.f;
#pragma unroll
        for (int w = 0; w < 8; ++w) mean += red[w];
        mean *= (1.0f / DC);
        const float d = a - mean; float q = wave_sum(d * d);
        if (F.lane == 0) red[8 + F.wave] = q;
        __syncthreads();
        float var = 0.f;
#pragma unroll
        for (int w = 0; w < 8; ++w) var += red[8 + w];
        var *= (1.0f / DC);
        const float y = d * (1.0f / sqrtf(var + EPS)) * F.a->ln_g[l * DC + c] + F.a->ln_b[l * DC + c];
        F_CACT[(size_t)r * DC + c] = (bf16)f2bf(y * sigm(y));
    }
}
DEV void ph_compress_simple(Frame& F, int l) {
    LAS float* R = (LAS float*)F.lds;
    const int e = F.lane, j = F.wave;
    for (int blk = F.bid; blk < NB * 2 * 2 * 16; blk += F.G) {
        const int i = blk & 15, kv = (blk >> 4) & 1, g = (blk >> 5) & 1, bi = blk >> 6; const bool prompt = bi < BP;
        __syncthreads();
        for (int row = j; row < 144; row += NWAVES) { const int pos = 128 * i + row; float v = 0.f;
            if (pos < 2048) { if (prompt) v = bf2f(F_CKV[((size_t)bi * TP + pos) * 256 + kv * 128 + g * 64 + e]);
                else { const int b = bi - BP, page = F.a->page_table[b * NPAGES + (pos >> 7)]; v = F.a->cache_cmp[(((size_t)l * NPOOL + page) * 128 + (pos & 127)) * 256 + kv * 128 + g * 64 + e]; } }
            R[row * 64 + e] = v; }
        __syncthreads();
        const float* W = F.a->w_cmp + (size_t)(l * 2 + kv) * 32 * 4096;
        float acc = F_cbias[(l * 2 + kv) * 64 + e];
        for (int ll = 0; ll < 16; ++ll)
            for (int d = 0; d < 64; ++d) acc += R[(j * 16 + ll) * 64 + d] * W[(size_t)(ll * 64 + d) * 64 + e] + R[((j + 1) * 16 + ll) * 64 + d] * W[(size_t)((16 + ll) * 64 + d) * 64 + e];
        const int n = 8 * i + j;
        if (kv == 0) { int cpos = 16 * n + 31; if (cpos > 2051) cpos = 2051; const int dd = e & 31; const float c = F_rope[cpos * 64 + dd], s = F_rope[cpos * 64 + 32 + dd];
            const float other = __shfl_xor(acc, 32); acc = e < 32 ? acc * c - other * s : acc * c + other * s; }
        if (n < NCMP) (kv == 0 ? F_KC : F_VC)[((size_t)(bi * 2 + g) * NCMP + n) * 64 + e] = acc;
        (kv == 0 ? F_KCB : F_VCB)[((size_t)(bi * 2 + g) * 128 + n) * 64 + e] = (bf16)(n < NCMP ? f2bf(acc) : 0u);
    }
}
struct RowSrc { const void* p; int isbf; };
DEV RowSrc row_src(const Frame& F, int mode, int l, bool prompt, int b, int bi, int g, int qp, int blkj, int t, int ln, int kv, bool& ok) {
    RowSrc r; r.isbf = 1;
    if (mode == 0) { int n = t * 64 + ln; ok = n < NCMP && 16 * n + 31 <= qp; if (n > 126) n = 126; r.p = (kv ? F_VCB : F_KCB) + ((size_t)(bi * 2 + g) * 128 + n) * 64; return r; }
    if (mode == 1) { const int kpos = 64 * blkj + ln; ok = kpos <= qp;
        if (prompt) { r.p = F_SKV + ((size_t)b * TP + kpos) * 256 + kv * 128 + g * 64; return r; }
        if (blkj < 32) { const int page = F.a->page_table[b * NPAGES + (kpos >> 7)]; r.isbf = 0; r.p = F.a->cache_sel + (((size_t)l * NPOOL + page) * 128 + (kpos & 127)) * 256 + kv * 128 + g * 64; return r; }
        int ii = kpos - TP; if (ii > 3) ii = 3; r.p = F_SKV + ((size_t)NP + b * TS + ii) * 256 + kv * 128 + g * 64; return r; }
    int kpos = qp - 511 + 64 * t + ln; ok = kpos >= 0; if (kpos < 0) kpos = 0;
    if (prompt) { r.p = F_WKV + ((size_t)b * TP + kpos) * 256 + kv * 128 + g * 64; return r; }
    if (kpos < TP) { r.isbf = 0; r.p = F.a->state_win + ((size_t)(l * BS + b) * 512 + (kpos - (TP - 512))) * 256 + kv * 128 + g * 64; return r; }
    r.p = F_WKV + ((size_t)NP + b * TS + (kpos - TP)) * 256 + kv * 128 + g * 64; return r;
}
DEV float row_elem(RowSrc s, int src_lane, int lane) {
    const unsigned long long v = (unsigned long long)s.p; const unsigned lo = __shfl((unsigned)v, src_lane), hi = __shfl((unsigned)(v >> 32), src_lane); const int isbf = __shfl(s.isbf, src_lane);
    const void* p = (const void*)(((unsigned long long)hi << 32) | lo);
    return isbf ? bf2f(((const bf16*)p)[lane]) : ((const float*)p)[lane];
}
DEV void ph_attn_simple(Frame& F, int l) {
    const int lane = F.lane, w = F.wave;
    if (w >= 4) return;
    LAS float* base = (LAS float*)(F.lds + w * 34816);
    LAS float* Ks = base;
    LAS float* qs = base + 64 * 65;
    LAS float* pcs = qs + 256;
    LAS float* sS = pcs + 128;
    LAS int* sel = (LAS int*)(sS + 4096);
    for (int item = F.bid * 4 + w; item < NT * 2; item += F.G * 4) {
        const int r = item >> 1, g = item & 1; const bool prompt = r < NP;
        const int b = prompt ? r / TP : (r - NP) / TS, tq = prompt ? r % TP : (r - NP) % TS, qp = prompt ? tq : TP + tq, bi = prompt ? b : BP + b;
#pragma unroll
        for (int hh = 0; hh < 4; ++hh) qs[hh * 64 + lane] = bf2f(F_Q[(size_t)r * 512 + (g * 4 + hh) * 64 + lane]);
        float ofin[4] = {0.f, 0.f, 0.f, 0.f}; const float* gn = F_GN + (size_t)r * 24;
        for (int mode = 0; mode < 3; ++mode) {
            const int T = mode == 0 ? 2 : (mode == 1 ? 16 : 8); unsigned okm = 0;
            for (int t = 0; t < T; ++t) {
                bool ok; const int bj = mode == 1 ? sel[t] : 0;
                const RowSrc kp = row_src(F, mode, l, prompt, b, bi, g, qp, bj, t, lane, 0, ok); if (ok) okm |= 1u << t;
                for (int i = 0; i < 64; ++i) Ks[i * 65 + lane] = row_elem(kp, i, lane);
                for (int hh = 0; hh < 4; ++hh) { float a = 0.f; for (int d = 0; d < 64; ++d) a += qs[hh * 64 + d] * Ks[lane * 65 + d]; sS[(t * 4 + hh) * 64 + lane] = ok ? a : -1e30f; }
            }
            for (int hh = 0; hh < 4; ++hh) {
                float m = -1e30f; for (int t = 0; t < T; ++t) m = fmaxf(m, sS[(t * 4 + hh) * 64 + lane]);
                m = wave_max(m); float sum = 0.f;
                for (int t = 0; t < T; ++t) { const float pv = ((okm >> t) & 1u) ? exp2f(sS[(t * 4 + hh) * 64 + lane] - m) : 0.f; sS[(t * 4 + hh) * 64 + lane] = pv; sum += pv; }
                sum = wave_sum(sum); const float inv = 1.0f / fmaxf(sum, 1e-30f);
                for (int t = 0; t < T; ++t) sS[(t * 4 + hh) * 64 + lane] *= inv;
            }
            float o[4] = {0.f, 0.f, 0.f, 0.f};
            for (int t = 0; t < T; ++t) {
                bool ok; const int bj = mode == 1 ? sel[t] : 0;
                const RowSrc vp = row_src(F, mode, l, prompt, b, bi, g, qp, bj, t, lane, 1, ok);
                for (int i = 0; i < 64; ++i) { const float v = row_elem(vp, i, lane);
#pragma unroll
                    for (int hh = 0; hh < 4; ++hh) o[hh] += sS[(t * 4 + hh) * 64 + i] * v; }
            }
#pragma unroll
            for (int hh = 0; hh < 4; ++hh) ofin[hh] += gn[mode * 8 + g * 4 + hh] * o[hh];
            if (mode == 0) {
                pcs[lane] = sS[lane] + sS[64 + lane] + sS[128 + lane] + sS[192 + lane];
                pcs[64 + lane] = sS[256 + lane] + sS[320 + lane] + sS[384 + lane] + sS[448 + lane];
                const int nsel = prompt ? 32 : 33, cur = qp >> 6; float imp = 0.f;
                for (int n = 4 * lane - 1; n <= 4 * lane + 3; ++n) if (n >= 0 && n < NCMP && lane < nsel) imp += pcs[n];
                const bool valid = lane < nsel && 64 * lane <= qp, forced = lane == 0 || lane == cur || lane == cur - 1;
                imp = valid ? (forced ? INFINITY : imp) : -INFINITY;
                bool cand = lane < nsel;
                for (int k = 0; k < 16; ++k) { const float m = wave_max(cand ? imp : -INFINITY); const unsigned long long bal = __ballot(cand && imp == m); const int jj = __ffsll((long long)bal) - 1;
                    if (lane == 0) sel[k] = jj; if (lane == jj) cand = false; }
            }
        }
#pragma unroll
        for (int hh = 0; hh < 4; ++hh) { const int h = g * 4 + hh; F_O[(size_t)r * 512 + h * 64 + lane] = (bf16)f2bf(ofin[hh]); }
    }
}
DEV void ph_dump(Frame& F, const bf16* A, int lda, const bf16* B, int ldb) {
    const int gw = F.bid * NWAVES + F.wave, NGW = F.G * NWAVES, lane = F.lane;
    for (int r = gw; r < NT; r += NGW) for (int c = lane; c < 512; c += 64) { F.a->out[OUT_Y + (size_t)r * D + c] = bf2f(A[(size_t)r * lda + c]); F.a->out[OUT_Y + (size_t)r * D + 512 + c] = bf2f(B[(size_t)r * ldb + c]); }
}
DEV void ph_final(Frame& F) {
    const int gw = F.bid * NWAVES + F.wave, NGW = F.G * NWAVES, lane = F.lane; const float* ss = F_ss + (size_t)4 * NT * 16;
    const bool poison = __hip_atomic_load(F_ctl + CW_BAR + XB_TMO, __ATOMIC_RELAXED, __HIP_MEMORY_SCOPE_AGENT) != 0u;
    for (int r = gw; r < NT; r += NGW) { const float rs = poison ? __builtin_nanf("") : pg8::row_rs(ss, r);
#pragma unroll
        for (int j = 0; j < 4; ++j) { const f32x4 v = *(const f32x4*)(F_X + (size_t)r * D + j * 256 + lane * 4), gv = *(const f32x4*)(F.a->norm_final_g + j * 256 + lane * 4);
            __builtin_nontemporal_store(v * rs * gv, (f32x4*)(F.a->out + OUT_Y + (size_t)r * D + j * 256 + lane * 4)); } }
}

DEV Frame launder(const Frame& F0) {
    Frame F; int z = 0; asm volatile("s_mov_b32 %0, 0" : "=s"(z));
    F.wave = F0.wave; F.lane = (int)__builtin_amdgcn_mbcnt_hi(~0u, __builtin_amdgcn_mbcnt_lo(~0u, 0u)) + z; F.tid = F.wave * 64 + F.lane; F.G = F0.G; F.bid = F0.bid; F.lds = F0.lds + z;
    F.a = (const __attribute__((address_space(4))) Args*)((const __attribute__((address_space(4))) char*)__builtin_amdgcn_kernarg_segment_ptr() + z);
    return F;
}
namespace mini {
typedef short bf16x8 __attribute__((ext_vector_type(8)));
template <int KS, int NS, class Epi>
DEV void gemm(const Frame& F, const bf16* A, const bf16* Bt, const int K, const Epi& epi) {
    static_assert(KS * NS == 8, "eight waves");
    constexpr int NC = 64 * NS;
    constexpr int NCG = (NS == 1) ? 16 : 16;
    LAS float* part = (LAS float*)F.lds;
    const int lane = F.lane, w = F.wave, kq = w % KS, nq = w / KS, m = lane & 15, kg = lane >> 4;
    for (int slab = F.bid; slab < 16 * NCG; slab += F.G) {
        const int mi = slab / NCG, ni = slab % NCG, row0 = NP + 32 * mi, col0 = NC * ni;
        f32x4 acc[2][4];
#pragma unroll
        for (int rt = 0; rt < 2; ++rt)
#pragma unroll
            for (int ct = 0; ct < 4; ++ct) acc[rt][ct] = (f32x4){0.f, 0.f, 0.f, 0.f};
        const int klen = K / KS, kbeg = kq * klen;
        const bf16* ap = A + (size_t)(row0 + m) * K + kbeg + 8 * kg; const bf16* bp = Bt + (size_t)(col0 + 64 * nq + m) * K + kbeg + 8 * kg;
#pragma unroll 4
        for (int k = 0; k < klen; k += 32) {
            bf16x8 a[2], b[4];
#pragma unroll
            for (int rt = 0; rt < 2; ++rt) a[rt] = *(const bf16x8*)(ap + (size_t)(16 * rt) * K + k);
#pragma unroll
            for (int ct = 0; ct < 4; ++ct) b[ct] = *(const bf16x8*)(bp + (size_t)(16 * ct) * K + k);
#pragma unroll
            for (int rt = 0; rt < 2; ++rt)
#pragma unroll
                for (int ct = 0; ct < 4; ++ct) acc[rt][ct] = __builtin_amdgcn_mfma_f32_16x16x32_bf16(a[rt], b[ct], acc[rt][ct], 0, 0, 0);
        }
        __syncthreads();
#pragma unroll
        for (int rt = 0; rt < 2; ++rt)
#pragma unroll
            for (int ct = 0; ct < 4; ++ct)
#pragma unroll
                for (int rg = 0; rg < 4; ++rg) part[(size_t)(kq * 32 + 16 * rt + 4 * kg + rg) * NC + 64 * nq + 16 * ct + m] = acc[rt][ct][rg];
        __syncthreads();
        for (int o = F.tid; o < 32 * NC / 4; o += NTHREADS) { const int row = o / (NC / 4), c4 = (o % (NC / 4)) * 4; f32x4 v = *(const LAS f32x4*)(part + (size_t)row * NC + c4);
#pragma unroll
            for (int q = 1; q < KS; ++q) v += *(const LAS f32x4*)(part + (size_t)(q * 32 + row) * NC + c4);
            epi(row0 + row, col0 + c4, v, o); }
    }
}
DEV unsigned long long pack4(f32x4 v) { return (unsigned long long)pg8::cvt_pk_bf16(v[0], v[1]) | ((unsigned long long)pg8::cvt_pk_bf16(v[2], v[3]) << 32); }
DEV f32x4 unpack4(unsigned long long w) { f32x4 v; v[0] = __uint_as_float((unsigned)w << 16); v[1] = __uint_as_float((unsigned)w & 0xffff0000u); v[2] = __uint_as_float((unsigned)(w >> 32) << 16); v[3] = __uint_as_float((unsigned)(w >> 32) & 0xffff0000u); return v; }
template <int MODE> struct EpiGate { const bf16* GM; bf16* T;
    DEV void operator()(int row, int col, f32x4 v, int) const { const f32x4 g = unpack4(*(const unsigned long long*)(GM + (size_t)row * 2048 + MODE * 1024 + col)); f32x4 o = v * g;
        if (MODE == 1) o += unpack4(*(const unsigned long long*)(T + (size_t)row * D + col));
        *(unsigned long long*)(T + (size_t)row * D + col) = pack4(o); } };
struct EpiRes { float* X; bf16* XB; float* ssn; const float* Xs; bool wxb;
    DEV void operator()(int row, int col, f32x4 v, int) const { float* xp = X + (size_t)row * D + col; const f32x4 x = *(const f32x4*)(Xs + (size_t)row * D + col) + v; *(f32x4*)xp = x; if (wxb) *(unsigned long long*)(XB + (size_t)row * D + col) = pack4(x);
        float q = (x[0] * x[0] + x[1] * x[1]) + (x[2] * x[2] + x[3] * x[3]);
        q += __shfl_xor(q, 1); q += __shfl_xor(q, 2); q += __shfl_xor(q, 4); q += __shfl_xor(q, 8);
        if ((col & 63) == 0) ssn[(size_t)row * 16 + (col >> 6)] = q; } };
struct EpiRelu2 { const float* ss; bf16* H;
    DEV void operator()(int row, int col, f32x4 v, int) const { const float rs = pg8::row_rs(ss, row); f32x4 o;
#pragma unroll
        for (int i = 0; i < 4; ++i) { const float a = fmaxf(v[i] * rs, 0.f); o[i] = a * a; }
        *(unsigned long long*)(H + (size_t)row * DFF + col) = pack4(o); } };
}
DEV int queue_next(const Frame& F, unsigned* ctr) {
    LAS int* slot = (LAS int*)(F.lds + LDSCTL_OFF + 128);
    __syncthreads();
    if (F.tid == 0) *slot = (int)__hip_atomic_fetch_add(ctr, 1u, __ATOMIC_RELAXED, __HIP_MEMORY_SCOPE_AGENT);
    __syncthreads();
    return *slot;
}
DEV void ph_conv(const Frame& F, const int l) {
    typedef unsigned u32x4v __attribute__((ext_vector_type(4)));
    LAS bf16* us = (LAS bf16*)F.lds;
    LAS float* os = (LAS float*)(F.lds + 63488);
    const int c = F.tid, lane = F.lane, wv = F.wave;
    float w[CK];
#pragma unroll
    for (int k = 0; k < CK; ++k) w[k] = F.a->dw_w[((size_t)l * CK + k) * DC + c];
    const float bias = F.a->dw_b[l * DC + c];
    const f32x4 g0 = *(const f32x4*)(F.a->ln_g + l * DC + lane * 8), g1 = *(const f32x4*)(F.a->ln_g + l * DC + lane * 8 + 4), b0v = *(const f32x4*)(F.a->ln_b + l * DC + lane * 8), b1v = *(const f32x4*)(F.a->ln_b + l * DC + lane * 8 + 4);
    unsigned* qctr = F_ctl + 8192 + (l * 2 + 1) * 64;
    for (int item = queue_next(F, qctr); item < NP / 32 + BS / 2; item = queue_next(F, qctr)) {
        const bool prompt = item < NP / 32;
        const int r0 = prompt ? item * 32 : NP + (item - NP / 32) * 8, ntok = prompt ? 32 : 8;
        __syncthreads();
        if (prompt) {
            const int b = r0 >> 11, t0 = r0 & 2047;
            u32x4v stg[8];
#pragma unroll
            for (int q = 0; q < 8; ++q) { const int i = F.tid + q * NTHREADS, row = i >> 6, ch = i & 63, tt = t0 - 30 + row; stg[q] = (u32x4v){0u, 0u, 0u, 0u};
                if (i < 62 * 64 && tt >= 0) stg[q] = *(const u32x4v*)(F_U + ((size_t)b * TP + tt) * DC + ch * 8); }
#pragma unroll
            for (int q = 0; q < 8; ++q) { const int i = F.tid + q * NTHREADS, row = i >> 6, ch = i & 63; if (i < 62 * 64) *(LAS u32x4v*)(us + row * 512 + ch * 8) = stg[q]; }
            __syncthreads();
#pragma unroll 1
            for (int tc = 0; tc < 4; ++tc) {
                float a8[8];
#pragma unroll
                for (int t = 0; t < 8; ++t) a8[t] = bias;
#pragma unroll
                for (int i = 0; i < 38; ++i) { const float x = bf2f(us[(8 * tc + i) * 512 + c]);
#pragma unroll
                    for (int t = 0; t < 8; ++t) if (i - t >= 0 && i - t <= 30) a8[t] += x * w[i - t]; }
#pragma unroll
                for (int t = 0; t < 8; ++t) os[(8 * tc + t) * 512 + c] = a8[t];
            }
        } else {
            const int b0 = (r0 - NP) >> 2;
#pragma unroll 1
            for (int bb = 0; bb < 2; ++bb) { const int b = b0 + bb; float x[34];
#pragma unroll
                for (int j = 0; j < 30; ++j) x[j] = F.a->state_conv[((size_t)(l * BS + b) * 30 + j) * DC + c];
#pragma unroll
                for (int j = 0; j < 4; ++j) x[30 + j] = bf2f(F_U[((size_t)NP + b * TS + j) * DC + c]);
#pragma unroll
                for (int t = 0; t < 4; ++t) { float o = bias;
#pragma unroll
                    for (int k = 0; k < CK; ++k) o += x[t + k] * w[k];
                    os[(4 * bb + t) * 512 + c] = o; } }
        }
        __syncthreads();
        for (int t = wv; t < ntok; t += NWAVES) {
            const f32x4 v0 = *(const LAS f32x4*)(os + t * 512 + lane * 8), v1 = *(const LAS f32x4*)(os + t * 512 + lane * 8 + 4);
            const float mean = wave_sum((v0[0] + v0[1]) + (v0[2] + v0[3]) + (v1[0] + v1[1]) + (v1[2] + v1[3])) * (1.0f / DC);
            const f32x4 d0 = v0 - mean, d1 = v1 - mean;
            const float var = wave_sum((d0[0] * d0[0] + d0[1] * d0[1]) + (d0[2] * d0[2] + d0[3] * d0[3]) + (d1[0] * d1[0] + d1[1] * d1[1]) + (d1[2] * d1[2] + d1[3] * d1[3])) * (1.0f / DC);
            const float rs = 1.0f / sqrtf(var + EPS);
            f32x4 y0 = d0 * rs * g0 + b0v, y1 = d1 * rs * g1 + b1v;
#pragma unroll
            for (int i = 0; i < 4; ++i) { y0[i] = y0[i] * pg8::fsigmoid(y0[i]); y1[i] = y1[i] * pg8::fsigmoid(y1[i]); }
            *(u32x4v*)(F_CACT + (size_t)(r0 + t) * DC + lane * 8) = pg8::pack8(y0, y1); }
    }
}
DEV void ph_compress(const Frame& F, const int l) {
    typedef short bf16x8 __attribute__((ext_vector_type(8)));
    typedef unsigned u32x4v __attribute__((ext_vector_type(4)));
    constexpr int BROW = 272, BBUF = 128 * BROW;
    LAS unsigned char* bs = F.lds;
    LAS float* p1s = (LAS float*)(F.lds + 2 * BBUF);
    const int tid = F.tid, lane = F.lane, wv = F.wave, m = lane & 15, kg = lane >> 4;
    const int chunk = 16 * wv + m;
    unsigned* qctr = F_ctl + 8192 + (l * 2 + 0) * 64;
    for (int it = queue_next(F, qctr); it < NB * 4; it = queue_next(F, qctr)) {
        const int item = it < BS * 4 ? it + BP * 4 : it - BS * 4;
        const int kv = item & 1, g = (item >> 1) & 1, bi = item >> 2; const bool prompt = bi < BP;
        const bf16* Wt = F_wcmp + (size_t)(l * 2 + kv) * 128 * 1024;
        f32x4 acc[8];
#pragma unroll
        for (int q = 0; q < 8; ++q) acc[q] = (f32x4){0.f, 0.f, 0.f, 0.f};
        u32x4v ra[3][4][2];
        const bf16* pa = nullptr; const float* sa = nullptr;
        if (prompt) pa = F_CKV + ((size_t)bi * TP + 16 * chunk) * 256 + kv * 128 + g * 64 + 8 * kg;
        else { const int b = bi - BP, page = F.a->page_table[b * NPAGES + (chunk >> 3)]; sa = F.a->cache_cmp + (((size_t)l * NPOOL + page) * 128 + 16 * (chunk & 7)) * 256 + kv * 128 + g * 64 + 8 * kg; }
        auto load_a = [&](int st, int ks) {
#pragma unroll
            for (int q = 0; q < 4; ++q) { const int ll = 2 * ks + (q >> 1), d0 = (q & 1) * 32;
                if (prompt) ra[st][q][0] = *(const u32x4v*)(pa + (size_t)ll * 256 + d0);
                else { ra[st][q][0] = __builtin_nontemporal_load((const u32x4v*)(sa + (size_t)ll * 256 + d0)); ra[st][q][1] = __builtin_nontemporal_load((const u32x4v*)(sa + (size_t)ll * 256 + d0 + 4)); } }
        };
        auto frag_a = [&](int st, int q) -> bf16x8 {
            u32x4v x = ra[st][q][0];
            if (!prompt) { const u32x4v a = ra[st][q][0], b2 = ra[st][q][1];
                x.x = pg8::cvt_pk_bf16(__uint_as_float(a.x), __uint_as_float(a.y)); x.y = pg8::cvt_pk_bf16(__uint_as_float(a.z), __uint_as_float(a.w));
                x.z = pg8::cvt_pk_bf16(__uint_as_float(b2.x), __uint_as_float(b2.y)); x.w = pg8::cvt_pk_bf16(__uint_as_float(b2.z), __uint_as_float(b2.w)); }
            return __builtin_bit_cast(bf16x8, x);
        };
        u32x4v rb[4];
        auto load_b = [&](int ks) {
#pragma unroll
            for (int i = 0; i < 4; ++i) { const int q = tid + i * NTHREADS, e = q >> 4, ch = q & 15; rb[i] = *(const u32x4v*)(Wt + (size_t)e * 1024 + ks * 128 + ch * 8); }
        };
        auto store_b = [&](int buf) {
#pragma unroll
            for (int i = 0; i < 4; ++i) { const int q = tid + i * NTHREADS, e = q >> 4, ch = q & 15; *(LAS u32x4v*)(bs + buf * BBUF + e * BROW + ch * 16) = rb[i]; }
        };
        __syncthreads();
        load_b(0); load_a(0, 0); load_a(1, 1); load_a(2, 2); store_b(0);
        __syncthreads();
#pragma unroll
        for (int ks = 0; ks < 8; ++ks) { const int st = ks % 3;
            if (ks + 1 < 8) load_b(ks + 1);
            const LAS unsigned char* bb = bs + (ks & 1) * BBUF;
            bf16x8 af[4];
#pragma unroll
            for (int q = 0; q < 4; ++q) af[q] = frag_a(st, q);
            if (ks + 3 < 8) load_a(st, ks + 3);
#pragma unroll
            for (int q = 0; q < 4; ++q)
#pragma unroll
                for (int nt = 0; nt < 8; ++nt) { const bf16x8 bf = *(const LAS bf16x8*)(bb + (16 * nt + m) * BROW + (q * 32 + 8 * kg) * 2);
                    acc[nt] = __builtin_amdgcn_mfma_f32_16x16x32_bf16(af[q], bf, acc[nt], 0, 0, 0); }
            if (ks + 1 < 8) store_b((ks + 1) & 1);
            __syncthreads();
        }
#pragma unroll
        for (int rg = 0; rg < 4; ++rg)
#pragma unroll
            for (int nt = 0; nt < 4; ++nt) p1s[(size_t)(16 * wv + 4 * kg + rg) * 64 + 16 * nt + m] = acc[4 + nt][rg];
        __syncthreads();
        bf16* dst = (kv == 0 ? F_KCB : F_VCB) + (size_t)(bi * 2 + g) * 128 * 64;
#pragma unroll
        for (int rg = 0; rg < 4; ++rg) { const int nn = 16 * wv + 4 * kg + rg; float v[4];
#pragma unroll
            for (int nt = 0; nt < 4; ++nt) v[nt] = acc[nt][rg] + (nn < NCMP ? p1s[(size_t)(nn + 1) * 64 + 16 * nt + m] : 0.f) + F_cbias[(l * 2 + kv) * 64 + 16 * nt + m];
            if (kv == 0) { const int pos = 16 * nn + 31 < 2052 ? 16 * nn + 31 : 2051;
#pragma unroll
                for (int nt = 0; nt < 2; ++nt) { const float cs = F_rope[(size_t)pos * 64 + 16 * nt + m], sn = F_rope[(size_t)pos * 64 + 32 + 16 * nt + m]; const float x1 = v[nt], x2 = v[nt + 2]; v[nt] = x1 * cs - x2 * sn; v[nt + 2] = x2 * cs + x1 * sn; } }
#pragma unroll
            for (int nt = 0; nt < 4; ++nt) dst[(size_t)nn * 64 + 16 * nt + m] = (bf16)(nn < NCMP ? f2bf(v[nt]) : 0u); }
    }
}
namespace att {
typedef short bf16x8 __attribute__((ext_vector_type(8)));
typedef short s16x4 __attribute__((ext_vector_type(4)));
typedef float f32x16 __attribute__((ext_vector_type(16)));
typedef unsigned u32x4 __attribute__((ext_vector_type(4)));
typedef unsigned u32x2 __attribute__((ext_vector_type(2)));
constexpr int KROW = 144, KBUF = 64 * KROW, VBUF = 8192, TBUF = KBUF + VBUF;
constexpr int L_BUF0 = 0, L_BUF1 = TBUF, L_IMP = 2 * TBUF, L_SELM = L_IMP + 8 * 32 * 33 * 4, L_TMP = L_SELM + 64 * 4, L_LIST = L_TMP + 8 * 64 * 4, L_TBASE = L_LIST + 64 * 4, L_END = L_TBASE + 64 * 4,
              L_RAW0 = L_END, L_RAW1 = L_RAW0 + 32768, L_RAW2 = L_IMP, L_NEW = L_RAW1 + 32768, L_END2 = L_NEW + 2048;
constexpr float NEG = -1e30f;
constexpr float C2 = 0.125f * 1.4426950408889634f;
DEV int crow(int r, int hi) { return (r & 3) + 8 * (r >> 2) + 4 * hi; }
DEV unsigned cvtpk(float lo, float hi) { return pg8::cvt_pk_bf16(lo, hi); }
DEV float xhalf(float v) { return __shfl_xor(v, 32); }
DEV float from_hi(float v) { const auto r = __builtin_amdgcn_permlane32_swap(__float_as_uint(v), __float_as_uint(v), false, false); return __uint_as_float(r[1]); }
DEV int xmax_i(int v) { const auto r = __builtin_amdgcn_permlane32_swap((unsigned)v, (unsigned)v, false, false); return max((int)r[0], (int)r[1]); }
DEV float xsum_f(float v) { const auto r = __builtin_amdgcn_permlane32_swap(__float_as_uint(v), __float_as_uint(v), false, false); return __uint_as_float(r[0]) + __uint_as_float(r[1]); }

struct Unit { int samp, b, g, qt; };
struct TileRegs { u32x4 k0, k1, v0, v1; int isf32; };

DEV void tile_load(TileRegs& R, const Frame& F, int l, const Unit& u, int type, int idx, int key, int chunk, int rowbase = -1) {
    R.isf32 = 0; const u32x4 z = {0u, 0u, 0u, 0u}; R.k0 = z; R.k1 = z; R.v0 = z; R.v1 = z;
    const int bi = u.samp ? BP + u.b : u.b;
    if (type == 0) {
        const bf16* kp = F_KCB + ((size_t)(bi * 2 + u.g) * 128 + 64 * idx + key) * 64 + chunk * 8; const bf16* vp = F_VCB + ((size_t)(bi * 2 + u.g) * 128 + 64 * idx + key) * 64 + chunk * 8;
        R.k0 = *(const u32x4*)kp; R.v0 = *(const u32x4*)vp; return;
    }
    if (!u.samp) {
        const bf16* p = (type == 1 ? F_SKV : F_WKV) + ((size_t)u.b * TP + 64 * idx + key) * 256 + u.g * 64 + chunk * 8;
        R.k0 = *(const u32x4*)p; R.v0 = *(const u32x4*)(p + 128); return;
    }
    if (idx == 32) {
        if (key < TS) { const bf16* p = (type == 1 ? F_SKV : F_WKV) + ((size_t)NP + u.b * TS + key) * 256 + u.g * 64 + chunk * 8; R.k0 = *(const u32x4*)p; R.v0 = *(const u32x4*)(p + 128); }
        return;
    }
    const float* p;
    if (type == 1) { int rb = rowbase; if (rb < 0) { const int page = F.a->page_table[u.b * NPAGES + (idx >> 1)]; rb = (l * NPOOL + page) * 128 + (idx & 1) * 64; }
        p = F.a->cache_sel + ((size_t)rb + key) * 256 + u.g * 64 + chunk * 8; }
    else p = F.a->state_win + ((size_t)(l * BS + u.b) * 512 + 64 * (idx - 24) + key) * 256 + u.g * 64 + chunk * 8;
    R.isf32 = 1; R.k0 = *(const u32x4*)p; R.k1 = *(const u32x4*)(p + 4); R.v0 = *(const u32x4*)(p + 128); R.v1 = *(const u32x4*)(p + 132);
}
DEV u32x4 f8_to_bf8(u32x4 a, u32x4 b) { u32x4 o; o.x = cvtpk(__uint_as_float(a.x), __uint_as_float(a.y)); o.y = cvtpk(__uint_as_float(a.z), __uint_as_float(a.w)); o.z = cvtpk(__uint_as_float(b.x), __uint_as_float(b.y)); o.w = cvtpk(__uint_as_float(b.z), __uint_as_float(b.w)); return o; }
DEV void tile_store(const TileRegs& R, LAS unsigned char* buf, int key, int chunk) {
    u32x4 k = R.k0, v = R.v0;
    if (R.isf32) { k = f8_to_bf8(R.k0, R.k1); v = f8_to_bf8(R.v0, R.v1); }
    *(LAS u32x4*)(buf + key * KROW + chunk * 16) = k;
    *(LAS u32x4*)(buf + KBUF + (chunk >> 2) * 4096 + key * 64 + (chunk & 3) * 16) = v;
}
DEV void qk_tile(f32x16 (&s)[2], const LAS unsigned char* kb, const bf16x8 (&qf)[4], float cinit, int r32, int hi) {
#pragma unroll
    for (int kvh = 0; kvh < 2; ++kvh) {
        f32x16 a;
#pragma unroll
        for (int r = 0; r < 16; ++r) a[r] = cinit;
#pragma unroll
        for (int st = 0; st < 4; ++st) { const bf16x8 kf = *(const LAS bf16x8*)(kb + (32 * kvh + r32) * KROW + (16 * st + 8 * hi) * 2); a = __builtin_amdgcn_mfma_f32_32x32x16_bf16(kf, qf[st], a, 0, 0, 0); }
        s[kvh] = a;
    }
}
typedef short v4i16_t __attribute__((ext_vector_type(4)));
DEV s16x4 vtr(const LAS unsigned char* p) { return __builtin_bit_cast(s16x4, __builtin_amdgcn_ds_read_tr16_b64_v4i16((LAS v4i16_t*)p)); }
DEV void pv_tile(f32x16 (&o)[2], const LAS unsigned char* vb, const bf16x8 (&pf)[4], int lane) {
    const int g16 = lane >> 4, i = lane & 15, q_ = i >> 2, p_ = i & 3, hi = g16 >> 1, dsub = 16 * (g16 & 1);
    const LAS unsigned char* base = vb + (4 * hi + q_) * 64 + (dsub + 4 * p_) * 2;
#pragma unroll
    for (int dh = 0; dh < 2; ++dh)
#pragma unroll
        for (int st = 0; st < 4; ++st) { const s16x4 lo = vtr(base + dh * 4096 + (16 * st) * 64), hh = vtr(base + dh * 4096 + (16 * st + 8) * 64);
            const bf16x8 vf = {lo[0], lo[1], lo[2], lo[3], hh[0], hh[1], hh[2], hh[3]};
            o[dh] = __builtin_amdgcn_mfma_f32_32x32x16_bf16(vf, pf[st], o[dh], 0, 0, 0); }
}
DEV void pack_p(bf16x8 (&pf)[4], const f32x16 (&p)[2]) {
#pragma unroll
    for (int st = 0; st < 4; ++st) { const f32x16& x = p[st >> 1]; const int r0 = 8 * (st & 1);
        const u32x4 w = {cvtpk(x[r0], x[r0 + 1]), cvtpk(x[r0 + 2], x[r0 + 3]), cvtpk(x[r0 + 4], x[r0 + 5]), cvtpk(x[r0 + 6], x[r0 + 7])};
        pf[st] = __builtin_bit_cast(bf16x8, w); }
}
DEV void edge_mask(f32x16 (&s)[2], int mode, int qoff, int hi) {
    const int qs = qoff - 4 * hi;
#pragma unroll
    for (int kvh = 0; kvh < 2; ++kvh)
#pragma unroll
        for (int r = 0; r < 16; ++r) { const int c = 32 * kvh + (r & 3) + 8 * (r >> 2); const bool keep = mode == 1 ? (c <= qs) : (c > qs); if (!keep) s[kvh][r] = NEG; }
}

DEV void kfrags_row(bf16x8 (&kf)[8], const LAS unsigned char* kb, int r32, int hi) {
#pragma unroll
    for (int st = 0; st < 4; ++st)
#pragma unroll
        for (int kvh = 0; kvh < 2; ++kvh) kf[2 * st + kvh] = *(const LAS bf16x8*)(kb + (32 * kvh + r32) * KROW + 32 * st + 16 * hi);
}
DEV void qk_regs(f32x16 (&s)[2], const bf16x8 (&kf)[8], const bf16x8 (&qf)[4], float cinit);
DEV void v_frags(bf16x8 (&vf)[8], const LAS unsigned char* vb, int lane);
DEV void pv_regs(f32x16 (&o)[2], const bf16x8 (&vf)[8], const bf16x8 (&pf)[4]);
DEV void glds16(const void* gsrc, unsigned lds_dst) { unsigned keep;
    asm volatile("s_mov_b32 %0, m0\n\ts_mov_b32 m0, %2\n\ts_nop 0\n\tglobal_load_lds_dwordx4 %1, off\n\ts_mov_b32 m0, %0" : "=&s"(keep) : "v"(gsrc), "s"(lds_dst) : "memory"); }
DEV void glds16s(unsigned voff, const void* sbase, unsigned lds_dst) { unsigned keep;
    asm volatile("s_mov_b32 %0, m0\n\ts_mov_b32 m0, %3\n\ts_nop 0\n\tglobal_load_lds_dwordx4 %1, %2\n\ts_mov_b32 m0, %0" : "=&s"(keep) : "v"(voff), "s"(sbase), "s"(lds_dst) : "memory"); }
static_assert(L_END2 <= LDSCTL_OFF, "sample-unit LDS");
DEV void attn_unit(const Frame& F, const int l, const Unit u) {
    const int tid = F.tid, lane = F.lane, w = F.wave, hh = w & 3, ph = w >> 2, r32 = lane & 31, hi = lane >> 5;
    const int key = tid >> 3, chunk = tid & 7;
    LAS unsigned char* lds = F.lds;
    LAS float* impW = (LAS float*)(lds + L_IMP); LAS unsigned* selm = (LAS unsigned*)(lds + L_SELM); LAS float* tmpv = (LAS float*)(lds + L_TMP); LAS int* tlist = (LAS int*)(lds + L_LIST);
    const int samp = u.samp, qt = u.qt, h = u.g * 4 + hh;
    const int qoff = 32 * ph + r32;
    const int qi = samp ? (r32 < TS ? r32 : TS - 1) : qoff;
    const int qrow = samp ? NP + u.b * TS + qi : u.b * TP + 64 * qt + qi;
    const int qp = samp ? TP + qi : 64 * qt + qi;
    const int qo = samp ? qi : qoff;
    const bool active = !(samp && ph == 1);
    const bool qvalid = samp ? (ph == 0 && r32 < TS) : true;
    bf16x8 qf[4];
#pragma unroll
    for (int st = 0; st < 4; ++st) qf[st] = *(const bf16x8*)(F_Q + (size_t)qrow * 512 + h * 64 + 16 * st + 8 * hi);
    const float* gn = F_GN + (size_t)qrow * 24;
    const float g_c = gn[h], g_s = gn[8 + h], g_w = gn[16 + h];
    f32x16 out[2];
#pragma unroll
    for (int r = 0; r < 16; ++r) { out[0][r] = 0.f; out[1][r] = 0.f; }
    TileRegs R, R2;
    tile_load(R, F, l, u, 0, 0, key, chunk); tile_load(R2, F, l, u, 0, 1, key, chunk);
    if (tid >= 128 && tid < 144) ((LAS int*)(lds + L_TBASE))[48 + tid - 128] = F.a->page_table[u.b * NPAGES + tid - 128];
    if (tid >= 64 && tid < 128) { const int t2 = tid - 64, ty = t2 >> 5, k4 = (t2 >> 3) & 3, ch = t2 & 7;
        const bf16* p = (ty == 0 ? F_SKV : F_WKV) + ((size_t)NP + u.b * TS + k4) * 256 + u.g * 64 + ch * 8;
        *(LAS u32x4*)(lds + L_NEW + ty * 1024 + k4 * 128 + ch * 16) = *(const u32x4*)p;
        *(LAS u32x4*)(lds + L_NEW + ty * 1024 + 512 + k4 * 128 + ch * 16) = *(const u32x4*)(p + 128); }
    tile_store(R, lds + L_BUF0, key, chunk); tile_store(R2, lds + L_BUF1, key, chunk);
    __syncthreads();
    if (active) {
        f32x16 s0[2], s1[2];
        { bf16x8 kfc[8]; kfrags_row(kfc, lds + L_BUF0, r32, hi); qk_regs(s0, kfc, qf, 0.f); kfrags_row(kfc, lds + L_BUF1, r32, hi); qk_regs(s1, kfc, qf, 0.f); }
        int nlim = qp >= 31 ? ((qp - 31) >> 4) : -1; if (nlim > NCMP - 1) nlim = NCMP - 1;
        const int nl = nlim - 4 * hi;
        float m = NEG;
#pragma unroll
        for (int kvh = 0; kvh < 2; ++kvh)
#pragma unroll
            for (int r = 0; r < 16; ++r) { const int c = 32 * kvh + (r & 3) + 8 * (r >> 2); if (c > nl) s0[kvh][r] = NEG; if (c + 64 > nl) s1[kvh][r] = NEG; m = fmaxf(m, fmaxf(s0[kvh][r], s1[kvh][r])); }
        m = fmaxf(m, xhalf(m));
        float sum = 0.f;
#pragma unroll
        for (int kvh = 0; kvh < 2; ++kvh)
#pragma unroll
            for (int r = 0; r < 16; ++r) { const int c = 32 * kvh + (r & 3) + 8 * (r >> 2);
                const float p0 = c <= nl ? __builtin_amdgcn_exp2f(s0[kvh][r] - m) : 0.f, p1 = c + 64 <= nl ? __builtin_amdgcn_exp2f(s1[kvh][r] - m) : 0.f;
                s0[kvh][r] = p0; s1[kvh][r] = p1; sum += p0 + p1; }
        sum += xhalf(sum);
        const float inv = sum > 0.f ? 1.0f / sum : 0.f;
#pragma unroll
        for (int kvh = 0; kvh < 2; ++kvh)
#pragma unroll
            for (int r = 0; r < 16; ++r) { s0[kvh][r] *= inv; s1[kvh][r] *= inv; }
        {
            LAS float* mine = impW + (size_t)(w * 32 + r32) * 33;
            float carry = 0.f;
#pragma unroll
            for (int t = 0; t < 2; ++t)
#pragma unroll
                for (int kvh = 0; kvh < 2; ++kvh)
#pragma unroll
                    for (int q4 = 0; q4 < 4; ++q4) {
                        const f32x16& x = t == 0 ? s0[kvh] : s1[kvh];
                        const float last = x[4 * q4 + 3], s4 = (x[4 * q4] + x[4 * q4 + 1]) + (x[4 * q4 + 2] + last);
                        const float os4 = from_hi(s4), olast = from_hi(last);
                        const int ge = 16 * t + 8 * kvh + 2 * q4;
                        if (hi == 0) { mine[ge] = carry + s4; mine[ge + 1] = os4 + last; }
                        carry = olast;
                    }
            if (hi == 0) mine[32] = carry;
        }
        f32x16 oc[2];
#pragma unroll
        for (int r = 0; r < 16; ++r) { oc[0][r] = 0.f; oc[1][r] = 0.f; }
        bf16x8 pf[4];
        { bf16x8 vfc[8]; v_frags(vfc, lds + L_BUF0 + KBUF, lane); pack_p(pf, s0); pv_regs(oc, vfc, pf); v_frags(vfc, lds + L_BUF1 + KBUF, lane); pack_p(pf, s1); pv_regs(oc, vfc, pf); }
#pragma unroll
        for (int r = 0; r < 16; ++r) { out[0][r] += g_c * oc[0][r]; out[1][r] += g_c * oc[1][r]; }
    }
    __syncthreads();
    {
        const int j = lane & 31, sub = lane >> 5;
#pragma unroll 2
        for (int it = 0; it < 4; ++it) {
            const int pidx = 8 * w + 2 * it + sub, php = pidx >> 5, qq = pidx & 31;
            const int qpp = samp ? TP + pidx : 64 * qt + pidx;
            float v = 0.f;
            if (!(samp && php == 1)) {
#pragma unroll
                for (int x = 0; x < 4; ++x) v += impW[(size_t)((php * 4 + x) * 32 + qq) * 33 + j];
            }
            const int cur = qpp >> 6; const bool valid = 64 * j <= qpp, forced = j == 0 || j == cur || j == cur - 1;
            v = valid ? (forced ? INFINITY : v) : -INFINITY;
            tmpv[w * 64 + lane] = v;
            int rank = 0;
            { f32x4 q8[8];
#pragma unroll
              for (int k8 = 0; k8 < 8; ++k8) q8[k8] = *(const LAS f32x4*)(tmpv + w * 64 + sub * 32 + 4 * k8);
#pragma unroll
              for (int i2 = 0; i2 < 32; ++i2) { const float vi = q8[i2 >> 2][i2 & 3]; rank += (vi > v || (vi == v && i2 < j)) ? 1 : 0; } }
            const unsigned long long bal = __ballot(rank < (samp ? 15 : 16));
            unsigned mk = sub ? (unsigned)(bal >> 32) : (unsigned)bal;
            if (samp && pidx >= TS) mk = 0u;
            if (j == 0) selm[pidx] = mk;
        }
    }
    __syncthreads();
    unsigned um = selm[lane];
#pragma unroll
    for (int o = 32; o > 0; o >>= 1) um |= __shfl_xor(um, o);
    um = __builtin_amdgcn_readfirstlane(um);
    if (!samp) um &= (qt >= 31 ? 0xffffffffu : ((1u << (qt + 1)) - 1u));
    const unsigned mysel = selm[samp ? qi : qoff];
    LAS int* tbase = (LAS int*)(lds + L_TBASE);
    LAS unsigned char* newkv = lds + L_NEW;
    const int nsel = __builtin_popcount(um), nt = nsel + 10;
    if (tid < 32) { if ((um >> tid) & 1u) { const int pos = __builtin_popcount(um & ((1u << tid) - 1u)); tlist[pos] = (1 << 8) | tid; tbase[pos] = (l * NPOOL + tbase[48 + (tid >> 1)]) * 128 + (tid & 1) * 64; } }
    else if (tid < 42) { const int k = tid - 32;
        if (k == 0) { tlist[nsel] = (1 << 8) | 32; tbase[nsel] = -1; }
        else { const int idx = 33 - k; tlist[nsel + k] = (2 << 8) | idx; tbase[nsel + k] = idx == 32 ? -1 : (l * BS + u.b) * 512 + 64 * (idx - 24); } }
    __syncthreads();
    float m_run = 0.f, l_run = 0.f; f32x16 ot[2];
#pragma unroll
    for (int r = 0; r < 16; ++r) { ot[0][r] = 0.f; ot[1][r] = 0.f; }
    int cur_type = 1;
    const int pw = w & 3, kl = lane >> 3, pch = lane & 7;
    const int roff = pw * 8192 + (kl >> 2) * 1024 + (kl & 3) * 256 + pch * 32;
    const unsigned pvo = (unsigned)((lane >> 4) * 256 + (lane & 15) * 4) * 4u;
    auto lent = [&](int j, int& e, int& rb) { const int jj = j < 63 ? j : 63; e = __builtin_amdgcn_readfirstlane(tlist[jj]); rb = __builtin_amdgcn_readfirstlane(tbase[jj]); };
    auto dma_tile = [&](int e, int rb, LAS unsigned char* raw) {
        if (rb < 0) return;
        const int ty = e >> 8;
        const float* base = (ty == 1 ? F.a->cache_sel : F.a->state_win) + ((size_t)(rb + 16 * pw)) * 256 + u.g * 64;
        const unsigned dst = (unsigned)__builtin_amdgcn_readfirstlane((int)((unsigned)(__UINTPTR_TYPE__)raw + (unsigned)pw * 8192u));
#pragma unroll
        for (int q = 0; q < 8; ++q) glds16s(pvo, base + (q & 3) * 4 * 256 + (q >> 2) * 128, dst + 1024u * q);
    };
    struct Staged { u32x4 ka, va, kb, vb; };
    auto fetch = [&](int e, const LAS unsigned char* raw, Staged& S) {
        if ((e & 255) == 32) { const u32x4 z = {0u, 0u, 0u, 0u}; S.ka = z; S.va = z; S.kb = z; S.vb = z;
            if (pw == 0 && kl < TS) { const LAS unsigned char* np = newkv + ((e >> 8) == 1 ? 0 : 1024) + kl * 128 + pch * 16; S.ka = *(const LAS u32x4*)np; S.va = *(const LAS u32x4*)(np + 512); } }
        else { const LAS unsigned char* rp = raw + roff;
            const u32x4 a0 = *(const LAS u32x4*)rp, a1 = *(const LAS u32x4*)(rp + 16), b0 = *(const LAS u32x4*)(rp + 2048), b1 = *(const LAS u32x4*)(rp + 2064);
            const u32x4 c0 = *(const LAS u32x4*)(rp + 4096), c1 = *(const LAS u32x4*)(rp + 4112), d0 = *(const LAS u32x4*)(rp + 6144), d1 = *(const LAS u32x4*)(rp + 6160);
            S.ka = f8_to_bf8(a0, a1); S.kb = f8_to_bf8(b0, b1); S.va = f8_to_bf8(c0, c1); S.vb = f8_to_bf8(d0, d1); }
    };
    auto put = [&](LAS unsigned char* buf, const Staged& S) {
        const int k0 = 16 * pw + kl, k1 = k0 + 8;
        *(LAS u32x4*)(buf + k0 * KROW + pch * 16) = S.ka; *(LAS u32x4*)(buf + k1 * KROW + pch * 16) = S.kb;
        *(LAS u32x4*)(buf + KBUF + (pch >> 2) * 4096 + k0 * 64 + (pch & 3) * 16) = S.va; *(LAS u32x4*)(buf + KBUF + (pch >> 2) * 4096 + k1 * 64 + (pch & 3) * 16) = S.vb; };
    static_assert(8 * 32 * 33 * 4 >= 32768, "third raw slot overlays the importance table (dead after the block selection)");
    auto rawslot = [&](int k3) -> LAS unsigned char* { return lds + (k3 == 0 ? L_RAW0 : (k3 == 1 ? L_RAW1 : L_RAW2)); };
#define SAMP_WAIT(N) do { const int n_ = (N); if (n_ == 2) asm volatile("s_waitcnt vmcnt(16)" ::: "memory"); else if (n_ == 1) asm volatile("s_waitcnt vmcnt(8)" ::: "memory"); else asm volatile("s_waitcnt vmcnt(0)" ::: "memory"); } while (0)
    int e0, b0, e1, b1, e2, b2, e3, b3;
    lent(0, e0, b0); lent(1, e1, b1); lent(2, e2, b2); lent(3, e3, b3);
    if (ph == 1) {
        dma_tile(e0, b0, rawslot(0)); if (nt > 1) dma_tile(e1, b1, rawslot(1)); if (nt > 2) dma_tile(e2, b2, rawslot(2));
        SAMP_WAIT((nt > 1 && b1 >= 0 ? 1 : 0) + (nt > 2 && b2 >= 0 ? 1 : 0));
        Staged S; fetch(e0, rawslot(0), S); put(lds + L_BUF0, S);
        asm volatile("s_waitcnt lgkmcnt(0)" ::: "memory");
    }
    __syncthreads();
    int s1 = 1;
#pragma unroll 1
    for (int i = 0; i < nt; ++i) {
        const int e = e0, type = e >> 8, idx = e & 255;
        const int j4 = i + 4 < 63 ? i + 4 : 63; const int e4v = tlist[j4], b4v = tbase[j4];
        if (ph == 1) {
            const int s0 = s1 == 0 ? 2 : s1 - 1;
            if (i + 3 < nt) dma_tile(e3, b3, rawslot(s0));
            if (i + 1 < nt) {
                SAMP_WAIT((i + 2 < nt && b2 >= 0 ? 1 : 0) + (i + 3 < nt && b3 >= 0 ? 1 : 0));
                Staged S; fetch(e1, rawslot(s1), S);
                put(lds + ((i & 1) ? L_BUF0 : L_BUF1), S);
                asm volatile("s_waitcnt lgkmcnt(0)" ::: "memory"); }
            s1 = s1 == 2 ? 0 : s1 + 1;
        }
        if (active) {
            if (type != cur_type) {
                const float lt = xsum_f(l_run), sc = g_s / lt;
#pragma unroll
                for (int r = 0; r < 16; ++r) { out[0][r] += sc * ot[0][r]; out[1][r] += sc * ot[1][r]; ot[0][r] = 0.f; ot[1][r] = 0.f; }
                m_run = 0.f; l_run = 0.f; cur_type = type;
            }
            const LAS unsigned char* buf = lds + ((i & 1) ? L_BUF1 : L_BUF0);
            bf16x8 kf[8], vf[8];
            kfrags_row(kf, buf, r32, hi); asm volatile("" ::: "memory");
            v_frags(vf, buf + KBUF, lane); asm volatile("" ::: "memory");
            f32x16 s[2];
            float cinit = -m_run; int mode = 0;
            if (type == 1) { if (!(((mysel >> (idx & 31)) & 1u) || idx == 32)) cinit = NEG; mode = idx == 32 ? 1 : 0; }
            else mode = idx == 32 ? 1 : (idx == 24 ? 2 : 0);
            qk_regs(s, kf, qf, cinit);
            if (mode) { int qo_ = qo; asm volatile("" : "+v"(qo_)); edge_mask(s, mode, qo_, hi); }
            int ti = max(__float_as_int(s[0][0]), __float_as_int(s[1][0]));
#pragma unroll
            for (int r = 1; r < 16; ++r) ti = max(ti, max(__float_as_int(s[0][r]), __float_as_int(s[1][r])));
            ti = xmax_i(ti);
            const float tm = __int_as_float(ti);
            if (__any(ti > 0)) {
                const float dl = fmaxf(tm, 0.f), alpha = __builtin_amdgcn_exp2f(-dl);
                m_run += dl; l_run *= alpha;
#pragma unroll
                for (int r = 0; r < 16; ++r) { s[0][r] -= dl; s[1][r] -= dl; ot[0][r] *= alpha; ot[1][r] *= alpha; }
            }
#pragma unroll
            for (int r = 0; r < 16; ++r) { s[0][r] = __builtin_amdgcn_exp2f(s[0][r]); s[1][r] = __builtin_amdgcn_exp2f(s[1][r]); }
            { typedef float f32x2_ __attribute__((ext_vector_type(2)));
              f32x2_ r2 = {0.f, 0.f};
#pragma unroll
              for (int r = 0; r < 16; r += 2) { r2 += (f32x2_){s[0][r], s[0][r + 1]}; r2 += (f32x2_){s[1][r], s[1][r + 1]}; }
              l_run += r2[0] + r2[1]; }
            bf16x8 pf[4]; pack_p(pf, s); pv_regs(ot, vf, pf);
        }
        e0 = e1; b0 = b1; e1 = e2; b1 = b2; e2 = e3; b2 = b3; e3 = __builtin_amdgcn_readfirstlane(e4v); b3 = __builtin_amdgcn_readfirstlane(b4v);
        __syncthreads();
    }
#undef SAMP_WAIT
    if (active) {
        const float lt = xsum_f(l_run), sc = g_w / lt;
#pragma unroll
        for (int r = 0; r < 16; ++r) { out[0][r] += sc * ot[0][r]; out[1][r] += sc * ot[1][r]; }
        if (qvalid) {
            int qrow_ = qrow; asm volatile("" : "+v"(qrow_));
            bf16* op = F_O + (size_t)qrow_ * 512 + h * 64;
#pragma unroll
            for (int dh = 0; dh < 2; ++dh)
#pragma unroll
                for (int q4 = 0; q4 < 4; ++q4) { const u32x2 wv = {cvtpk(out[dh][4 * q4], out[dh][4 * q4 + 1]), cvtpk(out[dh][4 * q4 + 2], out[dh][4 * q4 + 3])};
                    *(u32x2*)(op + 32 * dh + 8 * q4 + 4 * hi) = wv; }
        }
    }
}
constexpr int P_SLOT = 16384, P_IMP = 3 * P_SLOT, P_SELM = P_IMP + 8 * 32 * 33 * 4, P_TMP = P_SELM + 64 * 4, P_LIST = P_TMP + 8 * 64 * 4, P_END = P_LIST + 64 * 4;
DEV void kfrags(bf16x8 (&kf)[8], const LAS unsigned char* kslot, int r32, int hi) {
#pragma unroll
    for (int st = 0; st < 4; ++st)
#pragma unroll
        for (int kvh = 0; kvh < 2; ++kvh) kf[2 * st + kvh] = *(const LAS bf16x8*)(kslot + (2 * st + hi) * 1024 + (32 * kvh + r32) * 16);
}
DEV void qk_regs(f32x16 (&s)[2], const bf16x8 (&kf)[8], const bf16x8 (&qf)[4], float cinit) {
    f32x16 cv, a0, a1;
#pragma unroll
    for (int r = 0; r < 16; ++r) cv[r] = cinit;
    a0 = __builtin_amdgcn_mfma_f32_32x32x16_bf16(kf[0], qf[0], cv, 0, 0, 0); a1 = __builtin_amdgcn_mfma_f32_32x32x16_bf16(kf[1], qf[0], cv, 0, 0, 0);
#pragma unroll
    for (int st = 1; st < 4; ++st) { a0 = __builtin_amdgcn_mfma_f32_32x32x16_bf16(kf[2 * st], qf[st], a0, 0, 0, 0); a1 = __builtin_amdgcn_mfma_f32_32x32x16_bf16(kf[2 * st + 1], qf[st], a1, 0, 0, 0); }
    s[0] = a0; s[1] = a1;
}
DEV void v_frags(bf16x8 (&vf)[8], const LAS unsigned char* vb, int lane) {
    const int g16 = lane >> 4, i = lane & 15, q_ = i >> 2, p_ = i & 3, hi = g16 >> 1, dsub = 16 * (g16 & 1);
    const LAS unsigned char* base = vb + (4 * hi + q_) * 64 + (dsub + 4 * p_) * 2;
#pragma unroll
    for (int dh = 0; dh < 2; ++dh)
#pragma unroll
        for (int st = 0; st < 4; ++st) { const s16x4 lo = vtr(base + dh * 4096 + (16 * st) * 64), hh = vtr(base + dh * 4096 + (16 * st + 8) * 64);
            vf[4 * dh + st] = (bf16x8){lo[0], lo[1], lo[2], lo[3], hh[0], hh[1], hh[2], hh[3]}; }
}
DEV void pv_regs(f32x16 (&o)[2], const bf16x8 (&vf)[8], const bf16x8 (&pf)[4]) {
#pragma unroll
    for (int st = 0; st < 4; ++st)
#pragma unroll
        for (int dh = 0; dh < 2; ++dh) o[dh] = __builtin_amdgcn_mfma_f32_32x32x16_bf16(vf[4 * dh + st], pf[st], o[dh], 0, 0, 0);
}
DEV void dma_k(const Frame& F, const Unit& u, int e, LAS unsigned char* kslot, int w, int lane) {
    const int type = e >> 8, idx = e & 255; const bf16* src;
    if (type == 0) src = F_KCB + ((size_t)(u.b * 2 + u.g) * 128 + 64 * idx + lane) * 64 + w * 8;
    else src = (type == 1 ? F_SKV : F_WKV) + ((size_t)u.b * TP + 64 * idx + lane) * 256 + u.g * 64 + w * 8;
    glds16(src, (unsigned)__builtin_amdgcn_readfirstlane((int)((unsigned)(__UINTPTR_TYPE__)kslot + (unsigned)w * 1024u)));
}
DEV void dma_v(const Frame& F, const Unit& u, int e, LAS unsigned char* vslot, int w, int lane) {
    const int type = e >> 8, idx = e & 255, row = 16 * (w & 3) + (lane >> 2), col = (w >> 2) * 32 + (lane & 3) * 8; const bf16* src;
    if (type == 0) src = F_VCB + ((size_t)(u.b * 2 + u.g) * 128 + 64 * idx + row) * 64 + col;
    else src = (type == 1 ? F_SKV : F_WKV) + ((size_t)u.b * TP + 64 * idx + row) * 256 + 128 + u.g * 64 + col;
    glds16(src, (unsigned)__builtin_amdgcn_readfirstlane((int)((unsigned)(__UINTPTR_TYPE__)vslot + (unsigned)w * 1024u)));
}
#define ATT_WAIT_BAR(N) do { asm volatile("s_waitcnt vmcnt(" #N ") lgkmcnt(0)" ::: "memory"); __builtin_amdgcn_s_barrier(); asm volatile("" ::: "memory"); } while (0)
DEV void attn_unit_p(const Frame& F, const int l, const Unit u) {
    const int tid = F.tid, lane = F.lane, w = F.wave, hh = w & 3, ph = w >> 2, r32 = lane & 31, hi = lane >> 5;
    LAS unsigned char* lds = F.lds;
    LAS float* impW = (LAS float*)(lds + P_IMP); LAS unsigned* selm = (LAS unsigned*)(lds + P_SELM); LAS float* tmpv = (LAS float*)(lds + P_TMP); LAS int* tlist = (LAS int*)(lds + P_LIST);
    const int qt = u.qt, h = u.g * 4 + hh, qoff = 32 * ph + r32, qrow = u.b * TP + 64 * qt + qoff, qp = 64 * qt + qoff;
    dma_k(F, u, 0, lds, w, lane); dma_v(F, u, 0, lds + 8192, w, lane); dma_k(F, u, 1, lds + P_SLOT, w, lane); dma_v(F, u, 1, lds + P_SLOT + 8192, w, lane);
    bf16x8 qf[4];
#pragma unroll
    for (int st = 0; st < 4; ++st) qf[st] = *(const bf16x8*)(F_Q + (size_t)qrow * 512 + h * 64 + 16 * st + 8 * hi);
    const float* gn = F_GN + (size_t)qrow * 24;
    const float g_c = gn[h], g_s = gn[8 + h], g_w = gn[16 + h];
    f32x16 out[2];
#pragma unroll
    for (int r = 0; r < 16; ++r) { out[0][r] = 0.f; out[1][r] = 0.f; }
    ATT_WAIT_BAR(0);
    {
        f32x16 s0[2], s1[2]; bf16x8 kf[8];
        kfrags(kf, lds, r32, hi); qk_regs(s0, kf, qf, 0.f); kfrags(kf, lds + P_SLOT, r32, hi); qk_regs(s1, kf, qf, 0.f);
        int nlim = qp >= 31 ? ((qp - 31) >> 4) : -1; if (nlim > NCMP - 1) nlim = NCMP - 1;
        const int nl = nlim - 4 * hi;
        float m = NEG;
#pragma unroll
        for (int kvh = 0; kvh < 2; ++kvh)
#pragma unroll
            for (int r = 0; r < 16; ++r) { const int c = 32 * kvh + (r & 3) + 8 * (r >> 2); if (c > nl) s0[kvh][r] = NEG; if (c + 64 > nl) s1[kvh][r] = NEG; m = fmaxf(m, fmaxf(s0[kvh][r], s1[kvh][r])); }
        m = fmaxf(m, xhalf(m));
        float sum = 0.f;
#pragma unroll
        for (int kvh = 0; kvh < 2; ++kvh)
#pragma unroll
            for (int r = 0; r < 16; ++r) { const int c = 32 * kvh + (r & 3) + 8 * (r >> 2);
                const float p0 = c <= nl ? __builtin_amdgcn_exp2f(s0[kvh][r] - m) : 0.f, p1 = c + 64 <= nl ? __builtin_amdgcn_exp2f(s1[kvh][r] - m) : 0.f;
                s0[kvh][r] = p0; s1[kvh][r] = p1; sum += p0 + p1; }
        sum += xhalf(sum);
        const float inv = sum > 0.f ? 1.0f / sum : 0.f;
#pragma unroll
        for (int kvh = 0; kvh < 2; ++kvh)
#pragma unroll
            for (int r = 0; r < 16; ++r) { s0[kvh][r] *= inv; s1[kvh][r] *= inv; }
        {
            LAS float* mine = impW + (size_t)(w * 32 + r32) * 33;
            float carry = 0.f;
#pragma unroll
            for (int t = 0; t < 2; ++t)
#pragma unroll
                for (int kvh = 0; kvh < 2; ++kvh)
#pragma unroll
                    for (int q4 = 0; q4 < 4; ++q4) {
                        const f32x16& x = t == 0 ? s0[kvh] : s1[kvh];
                        const float last = x[4 * q4 + 3], s4 = (x[4 * q4] + x[4 * q4 + 1]) + (x[4 * q4 + 2] + last);
                        const float os4 = from_hi(s4), olast = from_hi(last);
                        const int ge = 16 * t + 8 * kvh + 2 * q4;
                        if (hi == 0) { mine[ge] = carry + s4; mine[ge + 1] = os4 + last; }
                        carry = olast;
                    }
            if (hi == 0) mine[32] = carry;
        }
        f32x16 oc[2];
#pragma unroll
        for (int r = 0; r < 16; ++r) { oc[0][r] = 0.f; oc[1][r] = 0.f; }
        bf16x8 pf[4];
        { bf16x8 vfc[8]; v_frags(vfc, lds + 8192, lane); pack_p(pf, s0); pv_regs(oc, vfc, pf); v_frags(vfc, lds + P_SLOT + 8192, lane); pack_p(pf, s1); pv_regs(oc, vfc, pf); }
#pragma unroll
        for (int r = 0; r < 16; ++r) { out[0][r] += g_c * oc[0][r]; out[1][r] += g_c * oc[1][r]; }
    }
    __syncthreads();
    {
        const int j = lane & 31, sub = lane >> 5;
#pragma unroll 2
        for (int it = 0; it < 4; ++it) {
            const int pidx = 8 * w + 2 * it + sub, php = pidx >> 5, qq = pidx & 31, qpp = 64 * qt + pidx;
            float v = 0.f;
#pragma unroll
            for (int x = 0; x < 4; ++x) v += impW[(size_t)((php * 4 + x) * 32 + qq) * 33 + j];
            const int cur = qpp >> 6; const bool valid = 64 * j <= qpp, forced = j == 0 || j == cur || j == cur - 1;
            v = valid ? (forced ? INFINITY : v) : -INFINITY;
            tmpv[w * 64 + lane] = v;
            int rank = 0;
            { f32x4 q8[8];
#pragma unroll
              for (int k8 = 0; k8 < 8; ++k8) q8[k8] = *(const LAS f32x4*)(tmpv + w * 64 + sub * 32 + 4 * k8);
#pragma unroll
              for (int i2 = 0; i2 < 32; ++i2) { const float vi = q8[i2 >> 2][i2 & 3]; rank += (vi > v || (vi == v && i2 < j)) ? 1 : 0; } }
            const unsigned long long bal = __ballot(rank < 16);
            const unsigned mk = sub ? (unsigned)(bal >> 32) : (unsigned)bal;
            if (j == 0) selm[pidx] = mk;
        }
    }
    __syncthreads();
    unsigned um = selm[lane];
#pragma unroll
    for (int o = 32; o > 0; o >>= 1) um |= __shfl_xor(um, o);
    um = __builtin_amdgcn_readfirstlane(um);
    um &= (qt >= 31 ? 0xffffffffu : ((1u << (qt + 1)) - 1u));
    const unsigned mysel = selm[qoff];
    const int nsel = __builtin_popcount(um), nt = nsel + (qt < 8 ? qt + 1 : 9);
    if (tid < 32) { if ((um >> tid) & 1u) tlist[__builtin_popcount(um & ((1u << tid) - 1u))] = (1 << 8) | tid; }
    else if (tid < 41) { const int k = tid - 32; if (qt - k >= 0) tlist[nsel + k] = (2 << 8) | (qt - k); }
    __syncthreads();
    auto slot = [&](int j) -> LAS unsigned char* { return lds + (j % 3) * P_SLOT; };
    auto le = [&](int j) -> int { return tlist[j < nt ? j : nt - 1]; };
    const unsigned kvo = (unsigned)(lane * 256 + w * 8) * 2u, vvo = (unsigned)((16 * (w & 3) + (lane >> 2)) * 256 + (w >> 2) * 32 + (lane & 3) * 8) * 2u;
    auto tile_base = [&](int e_) -> const bf16* { const int e = __builtin_amdgcn_readfirstlane(e_); return ((e >> 8) == 1 ? F_SKV : F_WKV) + ((size_t)u.b * TP + 64 * (e & 255)) * 256 + u.g * 64; };
    auto dmaK = [&](int e_, LAS unsigned char* kslot) { glds16s(kvo, tile_base(e_), (unsigned)__builtin_amdgcn_readfirstlane((int)((unsigned)(__UINTPTR_TYPE__)kslot + (unsigned)w * 1024u))); };
    auto dmaV = [&](int e_, LAS unsigned char* vslot) { glds16s(vvo, tile_base(e_) + 128, (unsigned)__builtin_amdgcn_readfirstlane((int)((unsigned)(__UINTPTR_TYPE__)vslot + (unsigned)w * 1024u))); };
    dmaK(le(0), slot(0)); dmaV(le(0), slot(0) + 8192);
    dmaK(le(1), slot(1)); dmaV(le(1), slot(1) + 8192);
    dmaK(le(2), slot(2));
    float m_run = 0.f, l_run = 0.f; f32x16 ot[2];
#pragma unroll
    for (int r = 0; r < 16; ++r) { ot[0][r] = 0.f; ot[1][r] = 0.f; }
    int cur_type = 1; bool first = true;
    ATT_WAIT_BAR(0);
    bf16x8 kf[8];
    kfrags(kf, slot(0), r32, hi);
    int eA = __builtin_amdgcn_readfirstlane(le(0)), eB = __builtin_amdgcn_readfirstlane(le(1)), eC = __builtin_amdgcn_readfirstlane(le(2)), eD = __builtin_amdgcn_readfirstlane(le(3));
    LAS unsigned char* sl0 = lds; LAS unsigned char* sl1 = lds + P_SLOT; LAS unsigned char* sl2 = lds + 2 * P_SLOT;
#pragma unroll 1
    for (int t = 0; t < nt; ++t) {
        const int e = eA, type = e >> 8, idx = e & 255;
        const int eNv = le(t + 4);
        dmaK(eD, sl0); dmaV(eC, sl2 + 8192);
        if (type != cur_type) {
            const float lt = xsum_f(l_run), scl = g_s / lt;
#pragma unroll
            for (int r = 0; r < 16; ++r) { out[0][r] += scl * ot[0][r]; out[1][r] += scl * ot[1][r]; ot[0][r] = 0.f; ot[1][r] = 0.f; }
            m_run = 0.f; l_run = 0.f; cur_type = type; first = true;
        }
        float cinit = -m_run; int mode = 0;
        if (type == 1) { if (!((mysel >> (idx & 31)) & 1u)) cinit = NEG; mode = idx == qt ? 1 : 0; }
        else mode = idx == qt ? 1 : (idx == qt - 8 ? 2 : 0);
        f32x16 s[2];
        qk_regs(s, kf, qf, cinit);
        bf16x8 vf[8]; v_frags(vf, sl0 + 8192, lane);
        __builtin_amdgcn_sched_barrier(0);
        if (mode) { int qo_ = qoff; asm volatile("" : "+v"(qo_)); edge_mask(s, mode, qo_, hi); }
        float tm;
        if (first) {
            tm = fmaxf(s[0][0], s[1][0]);
#pragma unroll
            for (int r = 1; r < 16; ++r) tm = fmaxf(tm, fmaxf(s[0][r], s[1][r]));
            tm = fmaxf(tm, xhalf(tm));
        } else {
            int ti = max(__float_as_int(s[0][0]), __float_as_int(s[1][0])), tj = max(__float_as_int(s[0][8]), __float_as_int(s[1][8]));
#pragma unroll
            for (int r = 1; r < 8; ++r) { ti = max(ti, max(__float_as_int(s[0][r]), __float_as_int(s[1][r]))); tj = max(tj, max(__float_as_int(s[0][r + 8]), __float_as_int(s[1][r + 8]))); }
            ti = xmax_i(max(ti, tj));
            tm = __int_as_float(ti);
        }
        if (first || __any(tm > 8.f)) {
            const float dl = first ? (tm > -1e29f ? tm : 0.f) : fmaxf(tm, 0.f), alpha = first ? 1.f : __builtin_amdgcn_exp2f(-dl);
            m_run += dl; l_run *= alpha; first = false;
#pragma unroll
            for (int r = 0; r < 16; ++r) { s[0][r] -= dl; s[1][r] -= dl; ot[0][r] *= alpha; ot[1][r] *= alpha; }
        }
#pragma unroll
        for (int r = 0; r < 16; ++r) { s[0][r] = __builtin_amdgcn_exp2f(s[0][r]); s[1][r] = __builtin_amdgcn_exp2f(s[1][r]); }
        { typedef float f32x2_ __attribute__((ext_vector_type(2)));
          f32x2_ r2 = {0.f, 0.f}, r3 = {0.f, 0.f};
#pragma unroll
          for (int r = 0; r < 16; r += 2) { r2 += (f32x2_){s[0][r], s[0][r + 1]}; r3 += (f32x2_){s[1][r], s[1][r + 1]}; }
          r2 += r3; l_run += r2[0] + r2[1]; }
        bf16x8 pf[4]; pack_p(pf, s);
        if (t + 1 < nt) kfrags(kf, sl1, r32, hi);
        pv_regs(ot, vf, pf);
        eA = eB; eB = eC; eC = eD; eD = __builtin_amdgcn_readfirstlane(eNv);
        { LAS unsigned char* t_ = sl0; sl0 = sl1; sl1 = sl2; sl2 = t_; }
        ATT_WAIT_BAR(2);
    }
    asm volatile("s_waitcnt vmcnt(0)" ::: "memory");
    __builtin_amdgcn_s_barrier(); asm volatile("" ::: "memory");
    {
        const float lt = xsum_f(l_run), scl = g_w / lt;
#pragma unroll
        for (int r = 0; r < 16; ++r) { out[0][r] += scl * ot[0][r]; out[1][r] += scl * ot[1][r]; }
        int qrow_ = qrow; asm volatile("" : "+v"(qrow_));
        bf16* op = F_O + (size_t)qrow_ * 512 + h * 64;
#pragma unroll
        for (int dh = 0; dh < 2; ++dh)
#pragma unroll
            for (int q4 = 0; q4 < 4; ++q4) { const u32x2 wv = {cvtpk(out[dh][4 * q4], out[dh][4 * q4 + 1]), cvtpk(out[dh][4 * q4 + 2], out[dh][4 * q4 + 3])};
                *(u32x2*)(op + 32 * dh + 8 * q4 + 4 * hi) = wv; }
    }
}
DEV void attn_phase(const Frame& F, const int l) {
    const int vcu = (F.G % 8 == 0) ? (F.bid % 8) * (F.G / 8) + F.bid / 8 : F.bid;
    for (int pi = vcu; pi < 256; pi += F.G) {
        const int bg = pi >> 4, sidx = pi & 15, where = pi % 3;
#pragma unroll 1
        for (int k = 0; k < 3; ++k) {
            const Frame Fu = launder(F);
            if (k == where) { Unit us; us.samp = 1; us.b = pi >> 1; us.g = pi & 1; us.qt = 0; attn_unit(Fu, l, us); }
            else { const int which = k < where ? k : k - 1; Unit u; u.samp = 0; u.b = bg >> 1; u.g = bg & 1; u.qt = which == 0 ? 31 - sidx : sidx; attn_unit_p(Fu, l, u); }
        }
    }
}
}
DEV void ph_win_copy(const Frame& F, const int l, const int part, const int nparts) {
    constexpr unsigned per = 508u * 256u / 4u, n = (unsigned)BS * per; const unsigned stride = (unsigned)nparts * NTHREADS;
    const f32x4* src0 = (const f32x4*)(F.a->state_win + ((size_t)l * BS * 512 + 4) * 256); f32x4* dst0 = (f32x4*)(F.a->out + OUT_WIN_S + (size_t)l * BS * 512 * 256);
    for (unsigned i0 = (unsigned)part * NTHREADS + (unsigned)F.tid; i0 < n; i0 += 4u * stride) { f32x4 v[4];
#pragma unroll
        for (int q = 0; q < 4; ++q) { const unsigned i = i0 + q * stride; if (i < n) { const unsigned b = i / per, o = i - b * per; v[q] = __builtin_nontemporal_load(src0 + (size_t)b * (512 * 256 / 4) + o); } }
#pragma unroll
        for (int q = 0; q < 4; ++q) { const unsigned i = i0 + q * stride; if (i < n) { const unsigned b = i / per, o = i - b * per; __builtin_nontemporal_store(v[q], dst0 + (size_t)b * (512 * 256 / 4) + o); } } }
}
#define GRID_BAR() do { Frame Fb = launder(F0); int xq_ = xcc; asm volatile("" : "+s"(xq_)); XcdBarrier b_; b_.bar = (unsigned*)(Fb.a->ws + WS_CTL) + CW_BAR; b_.x = (unsigned)xq_; b_.st = (volatile LAS unsigned*)(Fb.lds + LDSCTL_OFF + 64); b_.t0 = Fb.tid == 0; xcd_barrier(b_); } while (0)
template <int l> DEV void run_layer(const Frame& F0, const int xcc, const int lo, const int hi) {
#define IN(k) (lo <= (k) && (k) < hi)
#define SEAM(k) do { if (IN(k) && IN((k) + 1)) GRID_BAR(); } while (0)
        constexpr int P = 1 + 7 * l;
        if (IN(P + 0)) {   Frame F = launder(F0);
            pg8::Gemm g{F_XB, (F_w1 + l * F_wstr), NT, N1, D}; pg8::StaticOrder S; S.init(NT, N1, F.G, F.bid);
            pg8::EpiProj E{l, F.a->ws, F.a->out, (LAS float*)(F.lds + RING_BYTES)};
            pg8::gemm_phase<pg8::EpiProj, pg8::StaticOrder, true, true>(F.lds, g, S, E, F.wave);
#ifdef DUP_G1
            pg8::gemm_phase<pg8::EpiProj, pg8::StaticOrder, true, true>(F.lds, g, S, E, F.wave);
#endif
            { const int nwg = (NT / 256) * (N1 / 256), full = nwg % F.G;
              if (full != 0 && F.bid >= full) ph_win_copy(F, l, F.bid - full, F.G - full);
              else if (full == 0) ph_win_copy(F, l, F.bid, F.G); }
        }
        SEAM(P + 0);
        if (IN(P + 1)) {
#ifdef CONVCMP_SIMPLE
        { Frame F = launder(F0); ph_conv_simple(F, l); }
        { Frame F = launder(F0); ph_compress_simple(F, l); }
#else
        { Frame F = launder(F0); ph_compress(F, l); }
        { Frame F = launder(F0); ph_conv(F, l); }
#ifdef DUP_CC
        __syncthreads();
        { Frame F = launder(F0); ph_compress(F, l); }
        { Frame F = launder(F0); ph_conv(F, l); }
#endif
#endif
        }
        SEAM(P + 1);
#ifdef ATTN_SIMPLE
        if (IN(P + 2)) { Frame F = launder(F0); ph_attn_simple(F, l); }
#else
        if (IN(P + 2)) { Frame F = launder(F0); att::attn_phase(F, l); }
#ifdef DUP_ATTN
        if (IN(P + 2)) { __syncthreads(); Frame F = launder(F0); att::attn_phase(F, l); }
#endif
#endif
        SEAM(P + 2);
        if (IN(P + 3)) {   Frame F = launder(F0);
            pg8::StaticOrder S; S.init(NP, D, F.G, F.bid);
            const bool early = (F.bid >> 3) & 1;
            if (early) { { mini::EpiGate<0> E{F_GM, F_T}; mini::gemm<8, 1>(F, F_CACT, (F_wc + l * F_wstr), DC, E); } { mini::EpiGate<1> E{F_GM, F_T}; mini::gemm<8, 1>(F, F_O, (F_wn + l * F_wstr), 512, E); } __syncthreads(); }
            { pg8::Gemm g{F_CACT, (F_wc + l * F_wstr), NP, D, DC}; pg8::EpiGate<0> E{F_GM, F_T}; pg8::gemm_phase<pg8::EpiGate<0>, pg8::StaticOrder, true, true>(F.lds, g, S, E, F.wave); }
            { pg8::Gemm g{F_O, (F_wn + l * F_wstr), NP, D, 512}; pg8::EpiGate<1> E{F_GM, F_T}; pg8::gemm_phase<pg8::EpiGate<1>, pg8::StaticOrder, true, true>(F.lds, g, S, E, F.wave); }
            if (!early) { { mini::EpiGate<0> E{F_GM, F_T}; mini::gemm<8, 1>(F, F_CACT, (F_wc + l * F_wstr), DC, E); } { mini::EpiGate<1> E{F_GM, F_T}; mini::gemm<8, 1>(F, F_O, (F_wn + l * F_wstr), 512, E); } }
        }
        SEAM(P + 3);
        if (IN(P + 4)) {   Frame F = launder(F0);
            pg8::Gemm g{F_T, (F_wo + l * F_wstr), NP, D, D}; pg8::StaticOrder S; S.init(NP, D, F.G, F.bid);
            const bool early = (F.bid >> 3) & 1;
            if (early) { mini::EpiRes E2{F_X, F_XB, (F_ss + (size_t)(2 * l + 1) * NT * 16), (l == 0 ? F.a->x_sample - (size_t)NP * D : (const float*)F_X), true}; mini::gemm<8, 1>(F, F_T, (F_wo + l * F_wstr), D, E2); __syncthreads(); }
            pg8::EpiRes E{F_X, F_XB, (F_ss + (size_t)(2 * l + 1) * NT * 16), (l == 0 ? F.a->x_prompt : (const float*)F_X), true}; pg8::gemm_phase<pg8::EpiRes, pg8::StaticOrder, true, true>(F.lds, g, S, E, F.wave);
            if (!early) { mini::EpiRes E2{F_X, F_XB, (F_ss + (size_t)(2 * l + 1) * NT * 16), (l == 0 ? F.a->x_sample - (size_t)NP * D : (const float*)F_X), true}; mini::gemm<8, 1>(F, F_T, (F_wo + l * F_wstr), D, E2); }
        }
        SEAM(P + 4);
        if (IN(P + 5)) {   Frame F = launder(F0);
            pg8::Gemm g{F_XB, (F_wup + l * F_wstr), NP, DFF, D}; pg8::StaticOrder S; S.init(NP, DFF, F.G, F.bid);
            const bool early = (F.bid >> 3) & 1;
            if (early) { mini::EpiRelu2 E2{(F_ss + (size_t)(2 * l + 1) * NT * 16), F_HID}; mini::gemm<2, 4>(F, F_XB, (F_wup + l * F_wstr), D, E2); __syncthreads(); }
            pg8::EpiRelu2 E{(F_ss + (size_t)(2 * l + 1) * NT * 16), F_HID}; pg8::gemm_phase<pg8::EpiRelu2, pg8::StaticOrder, true, true>(F.lds, g, S, E, F.wave);
            if (!early) { mini::EpiRelu2 E2{(F_ss + (size_t)(2 * l + 1) * NT * 16), F_HID}; mini::gemm<2, 4>(F, F_XB, (F_wup + l * F_wstr), D, E2); }
        }
        SEAM(P + 5);
        if (IN(P + 6)) {   Frame F = launder(F0);
            pg8::Gemm g{F_HID, (F_wdn + l * F_wstr), NP, D, DFF}; pg8::StaticOrder S; S.init(NP, D, F.G, F.bid);
            const bool early = (F.bid >> 3) & 1;
            if (early) { mini::EpiRes E2{F_X, F_XB, (F_ss + (size_t)(2 * l + 2) * NT * 16), (const float*)F_X, l == 0}; mini::gemm<8, 1>(F, F_HID, (F_wdn + l * F_wstr), DFF, E2); __syncthreads(); }
            pg8::EpiRes E{F_X, F_XB, (F_ss + (size_t)(2 * l + 2) * NT * 16), (const float*)F_X, l == 0}; pg8::gemm_phase<pg8::EpiRes, pg8::StaticOrder, true, true>(F.lds, g, S, E, F.wave);
            if (!early) { mini::EpiRes E2{F_X, F_XB, (F_ss + (size_t)(2 * l + 2) * NT * 16), (const float*)F_X, l == 0}; mini::gemm<8, 1>(F, F_HID, (F_wdn + l * F_wstr), DFF, E2); }
        }
        SEAM(P + 6);
}
__global__ void __launch_bounds__(NTHREADS, 2) mk_fwd(Args args) {
    extern __shared__ __attribute__((aligned(16))) unsigned char lds[];
    Frame F0; F0.a = (const __attribute__((address_space(4))) Args*)__builtin_amdgcn_kernarg_segment_ptr(); (void)args;
    F0.lds = (LAS unsigned char*)lds; F0.tid = threadIdx.x; F0.lane = F0.tid & 63; F0.wave = __builtin_amdgcn_readfirstlane(F0.tid >> 6); F0.G = gridDim.x; F0.bid = blockIdx.x;
    for (int u = F0.tid; u < (LDS_BYTES - LDSCTL_OFF) / 4; u += NTHREADS) ((LAS unsigned*)(F0.lds + LDSCTL_OFF))[u] = 0u;
    __syncthreads();
    const int lo = args.ph_lo, hi = args.ph_hi;
    int xcc = 0;
    if (hi - lo > 1) { XcdBarrier b0 = xcd_barrier_post((unsigned*)(args.ws + WS_CTL) + CW_BAR, (volatile LAS unsigned*)(F0.lds + LDSCTL_OFF + 64), F0.tid == 0); xcc = __builtin_amdgcn_readfirstlane((int)b0.x); }
    if (IN(0)) { Frame F = launder(F0); p0_prologue(F); }
#ifdef DUP_PRO
    if (IN(0)) { __syncthreads(); Frame F = launder(F0); p0_prologue(F); }
#endif
    SEAM(0);
    run_layer<0>(F0, xcc, lo, hi);
    run_layer<1>(F0, xcc, lo, hi);
#ifdef DBG_STOP
    if (IN(15)) { Frame F = launder(F0);
        if (DBG_STOP == 1) ph_dump(F, F_XB, D, F_XB + 512, D);
        if (DBG_STOP == 2) ph_dump(F, F_U, DC, F_Q, 512);
        if (DBG_STOP == 3) ph_dump(F, F_CACT, DC, F_SKV, 256);
        if (DBG_STOP == 4) ph_dump(F, F_O, 512, F_O, 512);
        if (DBG_STOP == 5) ph_dump(F, F_T, D, F_T + 512, D);
        if (DBG_STOP == 6) ph_dump(F, F_XB, D, F_XB + 512, D);
        if (DBG_STOP == 7) ph_dump(F, F_HID, DFF, F_HID + 2048, DFF);
        if (DBG_STOP == 8) ph_dump(F, F_XB, D, F_XB + 512, D); }
#else
    if (IN(15)) { Frame F = launder(F0); ph_final(F); }
#ifdef DUP_FIN
    if (IN(15)) { Frame F = launder(F0); ph_final(F); }
#endif
#endif
}

extern "C" void kernel_launch(void* const* d_in, const int* in_sizes, int n_in, void* d_out, int out_size, void* d_ws, size_t ws_size, hipStream_t stream) {
    (void)in_sizes; (void)n_in; (void)out_size;
    static int grid = 0;
    if (grid == 0) {
        if (ws_size < WM.end) { fprintf(stderr, "kernel_launch: workspace too small (%zu < %zu)\n", ws_size, (size_t)WM.end); grid = -1; return; }
        int dev = 0, cus = 0, per_cu = 0;
        if (hipGetDevice(&dev) != hipSuccess || hipDeviceGetAttribute(&cus, hipDeviceAttributeMultiprocessorCount, dev) != hipSuccess) { grid = -1; return; }
        if (hipFuncSetAttribute((const void*)mk_fwd, hipFuncAttributeMaxDynamicSharedMemorySize, LDS_BYTES) != hipSuccess) { fprintf(stderr, "kernel_launch: hipFuncSetAttribute failed\n"); grid = -1; return; }
        if (hipOccupancyMaxActiveBlocksPerMultiprocessor(&per_cu, (const void*)mk_fwd, NTHREADS, LDS_BYTES) != hipSuccess || per_cu < 1) { fprintf(stderr, "kernel_launch: occupancy query says %d\n", per_cu); }
        (void)hipGetLastError();
        grid = cus;
    }
    if (grid < 0) return;
    (void)hipMemsetAsync((char*)d_ws + WS_CTL, 0, CTL_ZERO_BYTES, stream);
    Args a{};
    a.x_prompt = (const float*)d_in[0]; a.x_sample = (const float*)d_in[1]; a.cache_cmp = (const float*)d_in[2]; a.cache_sel = (const float*)d_in[3];
    a.state_win = (const float*)d_in[4]; a.state_conv = (const float*)d_in[5]; a.page_table = (const int*)d_in[6];
    a.norm_mix_g = (const float*)d_in[7]; a.w_in = (const float*)d_in[8]; a.dw_w = (const float*)d_in[9]; a.dw_b = (const float*)d_in[10];
    a.ln_g = (const float*)d_in[11]; a.ln_b = (const float*)d_in[12]; a.w_conv_out = (const float*)d_in[13]; a.cmp_pos = (const float*)d_in[14];
    a.w_cmp = (const float*)d_in[15]; a.w_nsa_out = (const float*)d_in[16]; a.w_out = (const float*)d_in[17]; a.norm_mlp_g = (const float*)d_in[18];
    a.w_up = (const float*)d_in[19]; a.w_down = (const float*)d_in[20]; a.norm_final_g = (const float*)d_in[21];
    a.out = (float*)d_out; a.ws = (unsigned char*)d_ws;
#ifndef MK_PER_PHASE
    a.ph_lo = 0; a.ph_hi = 16;
    hipLaunchKernelGGL(mk_fwd, dim3(grid), dim3(NTHREADS), LDS_BYTES, stream, a);
#else
#ifdef DBG_STOP
    for (int ph = 0; ph < 16; ++ph) { if (ph >= DBG_STOP && ph != 15) continue; a.ph_lo = ph; a.ph_hi = ph + 1; hipLaunchKernelGGL(mk_fwd, dim3(grid), dim3(NTHREADS), LDS_BYTES, stream, a); }
    if (0)
#endif
    for (int ph = 0; ph < 16; ++ph) { a.ph_lo = ph; a.ph_hi = ph + 1; hipLaunchKernelGGL(mk_fwd, dim3(grid), dim3(NTHREADS), LDS_BYTES, stream, a); }
#endif
}
```

```cpp
#include <hip/hip_runtime.h>
#include <stdint.h>
#include <math.h>
#include <cstdio>

#define DEV __device__ __forceinline__
#define LAS __attribute__((address_space(3)))
#define GAS __attribute__((address_space(1)))

namespace cfg {
constexpr int D = 1024, BP = 8, TP = 2048, BS = 128, TS = 4, NPAGES = 16, NPOOL = 2560;
constexpr int DC = 512, CK = 31, DFF = 4096, INC = 4376, N1 = 4608;
constexpr int NP = BP * TP, NS = BS * TS, NT = NP + NS, NB = BP + BS, NCMP = 127;
constexpr float EPS = 1e-6f;
constexpr size_t OUT_Y = 0;
constexpr size_t OUT_CMP_P = (size_t)NT * D;
constexpr size_t OUT_CMP_S = OUT_CMP_P + (size_t)2 * NP * 256;
constexpr size_t OUT_SEL_P = OUT_CMP_S + (size_t)2 * NS * 256;
constexpr size_t OUT_SEL_S = OUT_SEL_P + (size_t)2 * NP * 256;
constexpr size_t OUT_WIN_P = OUT_SEL_S + (size_t)2 * NS * 256;
constexpr size_t OUT_WIN_S = OUT_WIN_P + (size_t)2 * BP * 512 * 256;
constexpr size_t OUT_CONV_P = OUT_WIN_S + (size_t)2 * BS * 512 * 256;
constexpr size_t OUT_CONV_S = OUT_CONV_P + (size_t)2 * BP * 30 * 512;
constexpr size_t OUT_TOTAL = OUT_CONV_S + (size_t)2 * BS * 30 * 512;
}
using namespace cfg;
constexpr size_t MiB = 1u << 20;
constexpr size_t WS_CTL = 0, CTL_ZERO_BYTES = 64 * 1024, CTL_BYTES = 8 * MiB;
constexpr int CW_BAR = 4096, CW_SS = 16384;
static_assert((size_t)(CW_SS + 5 * NT * 16) * 4 <= 8 * (size_t)(1u << 20), "ss region");
struct WsMap {
    size_t w1, wc, wn, wo, wup, wdn, wstride, wcmp, cbias, rope, X, XB, U, Q, CKV, SKV, WKV, GN, GM, CACT, KC, VC, KCB, VCB, O, T, HID, end;
};
constexpr size_t al256(size_t b) { return (b + 255) & ~(size_t)255; }
constexpr WsMap ws_map() {
    WsMap m{}; size_t o = CTL_BYTES;
    m.w1 = o; o += al256((size_t)N1 * D * 2); m.wc = o; o += al256((size_t)D * DC * 2); m.wn = o; o += al256((size_t)D * 512 * 2); m.wo = o; o += al256((size_t)D * D * 2);
    m.wup = o; o += al256((size_t)DFF * D * 2); m.wdn = o; o += al256((size_t)D * DFF * 2); m.wstride = o - m.w1; o += m.wstride;
    m.wcmp = o; o += al256((size_t)4 * 128 * 1024 * 2); m.cbias = o; o += al256(4 * 64 * 4); m.rope = o; o += al256((size_t)2052 * 64 * 4);
    m.X = o; o += al256((size_t)NT * D * 4); m.XB = o; o += al256((size_t)NT * D * 2); m.U = o; o += al256((size_t)NT * DC * 2); m.Q = o; o += al256((size_t)NT * 512 * 2);
    m.CKV = o; o += al256((size_t)NT * 256 * 2); m.SKV = o; o += al256((size_t)NT * 256 * 2); m.WKV = o; o += al256((size_t)NT * 256 * 2); m.GN = o; o += al256((size_t)NT * 24 * 4);
    m.GM = o; o += al256((size_t)NT * 2048 * 2); m.CACT = o; o += al256((size_t)NT * DC * 2); m.KC = o; o += al256((size_t)NB * 2 * NCMP * 64 * 4); m.VC = o; o += al256((size_t)NB * 2 * NCMP * 64 * 4); m.KCB = o; o += al256((size_t)NB * 2 * 128 * 64 * 2); m.VCB = o; o += al256((size_t)NB * 2 * 128 * 64 * 2);
    m.O = o; o += al256((size_t)NT * 512 * 2); m.T = o; o += al256((size_t)NT * D * 2); m.HID = o; o += al256((size_t)NT * DFF * 2); m.end = o; return m;
}
constexpr WsMap WM = ws_map();
namespace pg8 {
#define PG8_LAS __attribute__((address_space(3)))
typedef unsigned short bf16_t;
typedef short bf16x8 __attribute__((ext_vector_type(8)));
typedef float f32x4 __attribute__((ext_vector_type(4)));
typedef unsigned u32x4 __attribute__((ext_vector_type(4)));
constexpr int BM = 256, BK = 64, HALF = 128, HTB = HALF * BK * 2  , STAGE_BYTES = 8 * HTB, NXCD = 8, WGM = 8;

__host__ __device__ __forceinline__ int lds_byte(int r, int c) { const int st = (r >> 4) * 2 + (c >> 5), rr = r & 15, cc = c & 31, ob = rr * 64 + cc * 2; return st * 1024 + (ob ^ (((ob >> 9) & 1) << 5)); }
__host__ __device__ __forceinline__ void stage_rc(int b, int& R, int& C) { const int st = b / 1024, sb = b % 1024, swz = sb ^ (((sb >> 9) & 1) << 5); R = (st >> 1) * 16 + swz / 64; C = (st & 1) * 32 + (swz % 64) / 2; }
__host__ __device__ __forceinline__ int perm32(int rho) { const int n = rho >> 4, i = rho & 15; return 8 * (i >> 2) + 4 * n + (i & 3); }

struct Unit { int pm, pn; };
struct Gemm { const bf16_t* A; const bf16_t* Bt; int M, N, K; };

struct StaticOrder {
    int nM, nN, nwg, G, c;
    __host__ __device__ void init(int M, int N, int G_, int c_) { nM = M / BM; nN = N / BM; nwg = nM * nN; G = G_; c = c_; }
    __host__ __device__ bool next(int i, Unit& u) const {
        const long L = (long)i * G + c; if (L >= nwg) return false;
        int wgid = (int)L; { const int q = nwg / NXCD, r = nwg % NXCD, xcd = wgid % NXCD, off = wgid / NXCD; wgid = (xcd < r ? xcd * (q + 1) : r * (q + 1) + (xcd - r) * q) + off; }
        const int nig = WGM * nN, gid = wgid / nig, fm = gid * WGM, gsz = (nM - fm) < WGM ? (nM - fm) : WGM;
        u.pm = fm + ((wgid % nig) % gsz); u.pn = (wgid % nig) / gsz; return true;
    }
    __device__ __forceinline__ void a_ready(const Unit&) const {}
    __device__ __forceinline__ void done(const Unit&) const {}
};
typedef float f32x2_t __attribute__((ext_vector_type(2))); typedef __bf16 bf16x2_t __attribute__((ext_vector_type(2)));
__device__ __forceinline__ unsigned cvt_pk_bf16(float lo, float hi) { const f32x2_t v = {lo, hi}; const bf16x2_t b = __builtin_convertvector(v, bf16x2_t); return __builtin_bit_cast(unsigned, b); }
__device__ __forceinline__ float fsigmoid(float x) { return __builtin_amdgcn_rcpf(1.0f + __builtin_amdgcn_exp2f(-1.4426950408889634f * x)); }
__device__ __forceinline__ u32x4 pack8(f32x4 a, f32x4 b) { u32x4 w; w.x = cvt_pk_bf16(a[0], a[1]); w.y = cvt_pk_bf16(a[2], a[3]); w.z = cvt_pk_bf16(b[0], b[1]); w.w = cvt_pk_bf16(b[2], b[3]); return w; }
__device__ __forceinline__ void unpack8(u32x4 w, f32x4& a, f32x4& b) {
    a[0] = __uint_as_float(w.x << 16); a[1] = __uint_as_float(w.x & 0xffff0000u); a[2] = __uint_as_float(w.y << 16); a[3] = __uint_as_float(w.y & 0xffff0000u);
    b[0] = __uint_as_float(w.z << 16); b[1] = __uint_as_float(w.z & 0xffff0000u); b[2] = __uint_as_float(w.w << 16); b[3] = __uint_as_float(w.w & 0xffff0000u); }
__device__ __forceinline__ float row_rs(const float* ss, int row) {
    const f32x4 a = *(const f32x4*)(ss + (size_t)row * 16), b = *(const f32x4*)(ss + (size_t)row * 16 + 4), c = *(const f32x4*)(ss + (size_t)row * 16 + 8), d = *(const f32x4*)(ss + (size_t)row * 16 + 12);
    const float s = (((a[0] + a[1]) + (a[2] + a[3])) + ((b[0] + b[1]) + (b[2] + b[3]))) + (((c[0] + c[1]) + (c[2] + c[3])) + ((d[0] + d[1]) + (d[2] + d[3])));
    return 1.0f / sqrtf(s * (1.0f / D) + EPS); }

struct EpiProj {
    static constexpr bool PERM = true, AFTER_DRAIN = false;
    int layer; unsigned char* ws; float* out; PG8_LAS float* rsl;
    __device__ __forceinline__ void operator()(const f32x4 (&acc)[2][2][4][2], const Unit& u, int wr, int wc, int fr, int fq) const {
        const int pn = u.pn;
        const float* ss = (const float*)((const unsigned*)(ws + WS_CTL) + CW_SS) + (size_t)(2 * layer) * NT * 16;
        { const int t_ = (wr * 4 + wc) * 64 + fq * 16 + fr;
          if (t_ < BM) rsl[t_] = row_rs(ss, u.pm * BM + t_);
          asm volatile("s_waitcnt lgkmcnt(0)" ::: "memory"); __builtin_amdgcn_s_barrier(); asm volatile("" ::: "memory"); }
#define EP_ROW() const int row = u.pm * BM + ai * HALF + wr * 64 + m * 16 + fr; const float rs = rsl[ai * HALF + wr * 64 + m * 16 + fr]; const bool prompt = row < NP; \
                 const int b = prompt ? (row >> 11) : ((row - NP) >> 2), t = prompt ? (row & 2047) : ((row - NP) & 3), pos = prompt ? t : TP + t; (void)b; (void)pos;
#define EP_LOOP _Pragma("unroll") for (int ai = 0; ai < 2; ++ai) _Pragma("unroll") for (int m = 0; m < 4; ++m)
#define EP_FENCE() do { if (m & 1) asm volatile("" ::: "memory"); } while (0)
        if (pn < 4) {
            bf16_t* U = (bf16_t*)(ws + WM.U);
            EP_LOOP { EP_ROW();
                f32x4 uu[2];
#pragma unroll
                for (int n = 0; n < 2; ++n) { const f32x4 a = acc[ai][0][m][n] * rs, bb = acc[ai][1][m][n] * rs;
#pragma unroll
                    for (int i = 0; i < 4; ++i) uu[n][i] = a[i] * fsigmoid(bb[i]); }
                const int col = 128 * pn + 32 * wc + 8 * fq;
                *(u32x4*)(U + (size_t)row * DC + col) = pack8(uu[0], uu[1]);
                if (prompt) { if (t >= TP - 30) { float* o = out + OUT_CONV_P + ((size_t)(layer * BP + b) * 30 + (t - (TP - 30))) * DC + col; *(f32x4*)o = uu[0]; *(f32x4*)(o + 4) = uu[1]; } }
                else { float* o = out + OUT_CONV_S + ((size_t)(layer * BS + b) * 30 + 26 + t) * DC + col; *(f32x4*)o = uu[0]; *(f32x4*)(o + 4) = uu[1]; }
                EP_FENCE(); }
        } else if (pn < 6 || pn == 7 || pn == 8) {
            const bool isq = pn < 6; const int kv = wc >> 1, g = wc & 1, d0 = 8 * fq; const bool rot = isq || kv == 0;
            const float* rope = (const float*)(ws + WM.rope);
            EP_LOOP { EP_ROW();
                f32x4 o1[2], o2[2];
                const float* rp = rope + (size_t)pos * 64 + d0;
#pragma unroll
                for (int n = 0; n < 2; ++n) { const f32x4 x1 = acc[ai][0][m][n] * rs, x2 = acc[ai][1][m][n] * rs;
                    if (rot) { const f32x4 c = *(const f32x4*)(rp + 4 * n), s = *(const f32x4*)(rp + 32 + 4 * n); o1[n] = x1 * c - x2 * s; o2[n] = x2 * c + x1 * s; }
                    else { o1[n] = x1; o2[n] = x2; } }
                if (isq) { const int h = 4 * (pn - 4) + wc; bf16_t* qp = (bf16_t*)(ws + WM.Q) + (size_t)row * 512 + h * 64 + d0; const float c2 = 0.125f * 1.4426950408889634f;
                    *(u32x4*)qp = pack8(o1[0] * c2, o1[1] * c2); *(u32x4*)(qp + 32) = pack8(o2[0] * c2, o2[1] * c2); }
                else { const int col = kv * 128 + g * 64 + d0; bf16_t* kp = (bf16_t*)(ws + (pn == 7 ? WM.SKV : WM.WKV)) + (size_t)row * 256 + col;
                    *(u32x4*)kp = pack8(o1[0], o1[1]); *(u32x4*)(kp + 32) = pack8(o2[0], o2[1]);
                    float* o = nullptr;
                    if (pn == 7) o = prompt ? out + OUT_SEL_P + ((size_t)layer * NP + row) * 256 + col : out + OUT_SEL_S + ((size_t)layer * NS + (row - NP)) * 256 + col;
                    else if (prompt) { if (t >= TP - 512) o = out + OUT_WIN_P + ((size_t)(layer * BP + b) * 512 + (t - (TP - 512))) * 256 + col; }
                    else o = out + OUT_WIN_S + ((size_t)(layer * BS + b) * 512 + 508 + t) * 256 + col;
                    if (o) { __builtin_nontemporal_store(o1[0], (f32x4*)o); __builtin_nontemporal_store(o1[1], (f32x4*)(o + 4)); __builtin_nontemporal_store(o2[0], (f32x4*)(o + 32)); __builtin_nontemporal_store(o2[1], (f32x4*)(o + 36)); } }
                EP_FENCE(); }
        } else if (pn == 6) {
            bf16_t* CKV = (bf16_t*)(ws + WM.CKV);
            EP_LOOP { EP_ROW();
#pragma unroll
                for (int bj = 0; bj < 2; ++bj) { const int col = 128 * bj + 32 * wc + 8 * fq; const f32x4 v0 = acc[ai][bj][m][0] * rs, v1 = acc[ai][bj][m][1] * rs;
                    *(u32x4*)(CKV + (size_t)row * 256 + col) = pack8(v0, v1);
                    float* o = prompt ? out + OUT_CMP_P + ((size_t)layer * NP + row) * 256 + col : out + OUT_CMP_S + ((size_t)layer * NS + (row - NP)) * 256 + col;
                    __builtin_nontemporal_store(v0, (f32x4*)o); __builtin_nontemporal_store(v1, (f32x4*)(o + 4)); }
                EP_FENCE(); }
        } else if (pn < 17) {
            bf16_t* GM = (bf16_t*)(ws + WM.GM);
            EP_LOOP { EP_ROW();
#pragma unroll
                for (int bj = 0; bj < 2; ++bj) { const int col = (pn - 9) * 256 + 128 * bj + 32 * wc + 8 * fq; f32x4 v0 = acc[ai][bj][m][0] * rs, v1 = acc[ai][bj][m][1] * rs;
#pragma unroll
                    for (int i = 0; i < 4; ++i) { v0[i] = fsigmoid(v0[i]); v1[i] = fsigmoid(v1[i]); }
                    *(u32x4*)(GM + (size_t)row * 2048 + col) = pack8(v0, v1); }
                EP_FENCE(); }
        } else {
            float* GN = (float*)(ws + WM.GN);
            if (wc == 0 && fq < 3) {
                EP_LOOP { EP_ROW();
#pragma unroll
                    for (int n = 0; n < 2; ++n) { f32x4 v = acc[ai][0][m][n] * rs;
#pragma unroll
                        for (int i = 0; i < 4; ++i) v[i] = fsigmoid(v[i]);
                        *(f32x4*)(GN + (size_t)row * 24 + 8 * fq + 4 * n) = v; }
                    EP_FENCE(); }
            }
        }
#undef EP_ROW
#undef EP_LOOP
#undef EP_FENCE
    }
};
struct EpiRelu2 {
    static constexpr bool PERM = true, AFTER_DRAIN = false;
    const float* ss; bf16_t* H; PG8_LAS float* rsl;
    __device__ __forceinline__ void operator()(const f32x4 (&acc)[2][2][4][2], const Unit& u, int wr, int wc, int fr, int fq) const {
        { const int t_ = (wr * 4 + wc) * 64 + fq * 16 + fr;
          if (t_ < BM) rsl[t_] = row_rs(ss, u.pm * BM + t_);
          asm volatile("s_waitcnt lgkmcnt(0)" ::: "memory"); __builtin_amdgcn_s_barrier(); asm volatile("" ::: "memory"); }
#pragma unroll
        for (int ai = 0; ai < 2; ++ai)
#pragma unroll
            for (int m = 0; m < 4; ++m) {
                const int row = u.pm * BM + ai * HALF + wr * 64 + m * 16 + fr; const float rs = rsl[ai * HALF + wr * 64 + m * 16 + fr];
#pragma unroll
                for (int bj = 0; bj < 2; ++bj) { const int col = u.pn * BM + 128 * bj + 32 * wc + 8 * fq; f32x4 v0 = acc[ai][bj][m][0] * rs, v1 = acc[ai][bj][m][1] * rs;
#pragma unroll
                    for (int i = 0; i < 4; ++i) { float a = fmaxf(v0[i], 0.f), c = fmaxf(v1[i], 0.f); v0[i] = a * a; v1[i] = c * c; }
                    *(u32x4*)(H + (size_t)row * DFF + col) = pack8(v0, v1); }
            }
    }
};
template <int MODE> struct EpiGate {
    static constexpr bool PERM = true, AFTER_DRAIN = false;
    const bf16_t* GM; bf16_t* T;
    __device__ __forceinline__ void operator()(const f32x4 (&acc)[2][2][4][2], const Unit& u, int wr, int wc, int fr, int fq) const {
#pragma unroll
        for (int ai = 0; ai < 2; ++ai)
#pragma unroll
            for (int m = 0; m < 4; ++m) {
                const int row = u.pm * BM + ai * HALF + wr * 64 + m * 16 + fr;
#pragma unroll
                for (int bj = 0; bj < 2; ++bj) { const int col = u.pn * BM + 128 * bj + 32 * wc + 8 * fq;
                    f32x4 g0, g1; unpack8(*(const u32x4*)(GM + (size_t)row * 2048 + MODE * 1024 + col), g0, g1);
                    f32x4 v0 = acc[ai][bj][m][0] * g0, v1 = acc[ai][bj][m][1] * g1;
                    if (MODE == 1) { f32x4 t0, t1; unpack8(*(const u32x4*)(T + (size_t)row * D + col), t0, t1); v0 += t0; v1 += t1; }
                    *(u32x4*)(T + (size_t)row * D + col) = pack8(v0, v1); }
            }
    }
};
struct EpiRes {
    static constexpr bool PERM = true, AFTER_DRAIN = false;
    float* X; bf16_t* XB; float* ssn; const float* Xs; bool wxb;
    __device__ __forceinline__ void operator()(const f32x4 (&acc)[2][2][4][2], const Unit& u, int wr, int wc, int fr, int fq) const {
#pragma unroll
        for (int ai = 0; ai < 2; ++ai)
#pragma unroll
            for (int m = 0; m < 4; ++m) {
                const int row = u.pm * BM + ai * HALF + wr * 64 + m * 16 + fr; float q = 0.f;
#pragma unroll
                for (int bj = 0; bj < 2; ++bj) { const int col = u.pn * BM + 128 * bj + 32 * wc + 8 * fq; float* xp = X + (size_t)row * D + col; const float* xs = Xs + (size_t)row * D + col;
                    const f32x4 x0 = *(const f32x4*)xs + acc[ai][bj][m][0], x1 = *(const f32x4*)(xs + 4) + acc[ai][bj][m][1];
                    *(f32x4*)xp = x0; *(f32x4*)(xp + 4) = x1; if (wxb) *(u32x4*)(XB + (size_t)row * D + col) = pack8(x0, x1);
                    q += (x0[0] * x0[0] + x0[1] * x0[1]) + (x0[2] * x0[2] + x0[3] * x0[3]) + (x1[0] * x1[0] + x1[1] * x1[1]) + (x1[2] * x1[2] + x1[3] * x1[3]); }
                q += __shfl_xor(q, 16); q += __shfl_xor(q, 32);
                if (fq == 0) ssn[(size_t)row * 16 + u.pn * 4 + wc] = q;
            }
    }
};
template <class Epi, class Sched, bool ALIGN_EPI = false, bool SP2 = false>
__device__ __forceinline__ void gemm_phase(PG8_LAS unsigned char* lds, const Gemm g, const Sched& S, const Epi& E, const int wave_id) {
    int tid_ = wave_id * 64 + (int)__builtin_amdgcn_mbcnt_hi(~0u, __builtin_amdgcn_mbcnt_lo(~0u, 0u)); asm volatile("" : "+v"(tid_));
    const int tid = tid_, wid = __builtin_amdgcn_readfirstlane(tid >> 6), lane = tid & 63, wr = wid >> 2, wc = wid & 3, fr = lane & 15, fq = lane >> 4;
    const int K = g.K, nt = K / BK;
    unsigned voffA[2], voffB[2];
#pragma unroll
    for (int i = 0; i < 2; ++i) { int R, C; stage_rc(tid * 16 + i * 8192, R, C); const int Rb = Epi::PERM ? ((R & ~31) + perm32(R & 31)) : R;
        voffA[i] = (unsigned)(R * K + C) * 2u; voffB[i] = (unsigned)(Rb * K + C) * 2u; }
    const size_t kstep = (size_t)(BK * 2);
    const size_t hstep = (size_t)HALF * K * 2;
    const size_t tstep = 2 * hstep;
    const unsigned ldsw = (unsigned)wid * 1024u;
    const int aoff = lds_byte(wr * 64 + fr, fq * 8), boff = lds_byte(wc * 32 + fr, fq * 8);
#define PG8_SA(b, h) (((b) * 2 + (h)) * HTB)
#define PG8_SB(b, h) ((4 + (b) * 2 + (h)) * HTB)
#define PG8_STAGE(bufoff, gbase, voff) do { _Pragma("unroll") for (int _i = 0; _i < 2; ++_i) \
        __builtin_amdgcn_global_load_lds((const unsigned*)((const char*)(gbase) + (voff)[_i]), (PG8_LAS unsigned*)(lds + (bufoff) + ldsw + _i * 8192), 16, 0, 0); } while (0)
#define PG8_LDA(dst, b, h) do { _Pragma("unroll") for (int m = 0; m < 4; ++m) _Pragma("unroll") for (int k = 0; k < 2; ++k) dst[m][k] = *(const PG8_LAS bf16x8*)(lds + PG8_SA(b, h) + aoff + m * 2048 + k * 1024); } while (0)
#define PG8_LDB(dst, b, h) do { _Pragma("unroll") for (int n = 0; n < 2; ++n) _Pragma("unroll") for (int k = 0; k < 2; ++k) dst[n][k] = *(const PG8_LAS bf16x8*)(lds + PG8_SB(b, h) + boff + n * 2048 + k * 1024); } while (0)
#define PG8_MMA(ai, bj, At, Bt) do { __builtin_amdgcn_s_setprio(1); _Pragma("unroll") for (int m = 0; m < 4; ++m) _Pragma("unroll") for (int n = 0; n < 2; ++n) _Pragma("unroll") for (int k = 0; k < 2; ++k) \
        acc[ai][bj][m][n] = __builtin_amdgcn_mfma_f32_16x16x32_bf16(Bt[n][k], At[m][k], acc[ai][bj][m][n], 0, 0, 0); __builtin_amdgcn_s_setprio(0); } while (0)
#define PG8_WAIT_V(n) asm volatile("s_waitcnt vmcnt(" #n ")" ::: "memory")
#define PG8_WAIT_L(n) asm volatile("s_waitcnt lgkmcnt(" #n ")" ::: "memory")
#define PG8_BAR __builtin_amdgcn_s_barrier()
#define PG8_SCHED __builtin_amdgcn_sched_barrier(0)
    Unit cur, nxt; int ui = 0;
    if (!S.next(0, cur)) return;
    f32x4 acc[2][2][4][2];
#pragma unroll
    for (int a = 0; a < 2; ++a)
#pragma unroll
        for (int b = 0; b < 2; ++b)
#pragma unroll
            for (int m = 0; m < 4; ++m)
#pragma unroll
                for (int n = 0; n < 2; ++n) acc[a][b][m][n] = (f32x4){0.f, 0.f, 0.f, 0.f};
    bf16x8 At[4][2], B0[2][2], B1[2][2];
    const char* cA = (const char*)g.A + (size_t)cur.pm * tstep; const char* cB = (const char*)g.Bt + (size_t)cur.pn * tstep;
    S.a_ready(cur);
    if constexpr (SP2) {
        PG8_STAGE(PG8_SB(0, 0), cB, voffB); PG8_STAGE(PG8_SB(0, 1), cB + hstep, voffB); PG8_STAGE(PG8_SA(0, 0), cA, voffA); PG8_STAGE(PG8_SA(0, 1), cA + hstep, voffA);
        if (wr == 1) PG8_BAR;
        PG8_WAIT_V(2); PG8_BAR;
        PG8_STAGE(PG8_SB(1, 0), cB + kstep, voffB); PG8_STAGE(PG8_SA(1, 0), cA + kstep, voffA); PG8_STAGE(PG8_SB(1, 1), cB + hstep + kstep, voffB);
        PG8_WAIT_V(6); PG8_BAR;
    } else {
        PG8_STAGE(PG8_SB(0, 0), cB, voffB); PG8_STAGE(PG8_SA(0, 0), cA, voffA); PG8_STAGE(PG8_SB(0, 1), cB + hstep, voffB); PG8_STAGE(PG8_SA(0, 1), cA + hstep, voffA);
        if (wr == 1) PG8_BAR;
        PG8_WAIT_V(4); PG8_BAR;
        PG8_STAGE(PG8_SB(1, 0), cB + kstep, voffB); PG8_STAGE(PG8_SA(1, 0), cA + kstep, voffA); PG8_STAGE(PG8_SB(1, 1), cB + hstep + kstep, voffB);
        PG8_WAIT_V(6); PG8_BAR;
    }
    for (;;) {
        const bool has_next = S.next(ui + 1, nxt);
        const char* nA = has_next ? (const char*)g.A + (size_t)nxt.pm * tstep : cA; const char* nB = has_next ? (const char*)g.Bt + (size_t)nxt.pn * tstep : cB;
        for (int t = 0; t < nt; t += 2) {
            const bool last = (t == nt - 2);
            const char* a1 = cA + (size_t)(t + 1) * kstep;
            const char* a2 = last ? nA : cA + (size_t)(t + 2) * kstep; const char* b2 = last ? nB : cB + (size_t)(t + 2) * kstep;
            const char* a3 = a2 + kstep; const char* b3 = b2 + kstep;
            if (last && has_next) S.a_ready(nxt);
            if constexpr (SP2) {
            PG8_LDB(B0, 0, 0); PG8_LDB(B1, 0, 1); PG8_SCHED; PG8_LDA(At, 0, 0); PG8_STAGE(PG8_SA(1, 1), a1 + hstep, voffA);
            PG8_WAIT_V(8); PG8_WAIT_L(0); PG8_BAR; PG8_MMA(0, 0, At, B0); PG8_MMA(0, 1, At, B1); PG8_BAR; PG8_SCHED;
            PG8_LDA(At, 0, 1); PG8_STAGE(PG8_SB(0, 0), b2, voffB); PG8_STAGE(PG8_SB(0, 1), b2 + hstep, voffB); PG8_STAGE(PG8_SA(0, 0), a2, voffA);
            PG8_WAIT_V(8); PG8_WAIT_L(0); PG8_BAR; PG8_MMA(1, 0, At, B0); PG8_MMA(1, 1, At, B1); PG8_BAR; PG8_SCHED;
            PG8_LDB(B0, 1, 0); PG8_LDB(B1, 1, 1); PG8_SCHED; PG8_LDA(At, 1, 0); PG8_STAGE(PG8_SA(0, 1), a2 + hstep, voffA);
            PG8_WAIT_V(8); PG8_WAIT_L(0); PG8_BAR; PG8_MMA(0, 0, At, B0); PG8_MMA(0, 1, At, B1); PG8_BAR; PG8_SCHED;
            PG8_LDA(At, 1, 1); PG8_STAGE(PG8_SB(1, 0), b3, voffB); PG8_STAGE(PG8_SB(1, 1), b3 + hstep, voffB); PG8_STAGE(PG8_SA(1, 0), a3, voffA);
            PG8_WAIT_V(8); PG8_WAIT_L(0); PG8_BAR; PG8_MMA(1, 0, At, B0); PG8_MMA(1, 1, At, B1); PG8_BAR; PG8_SCHED;
            } else {
            PG8_LDB(B0, 0, 0); PG8_SCHED; PG8_LDA(At, 0, 0); PG8_STAGE(PG8_SA(1, 1), a1 + hstep, voffA);
            PG8_WAIT_L(8); PG8_BAR; PG8_WAIT_L(0); PG8_MMA(0, 0, At, B0); PG8_BAR; PG8_SCHED;
            PG8_LDB(B1, 0, 1); PG8_STAGE(PG8_SB(0, 0), b2, voffB);
            PG8_BAR; PG8_WAIT_L(0); PG8_MMA(0, 1, At, B1); PG8_BAR;
            PG8_LDA(At, 0, 1); PG8_STAGE(PG8_SA(0, 0), a2, voffA);
            PG8_BAR; PG8_WAIT_L(0); PG8_MMA(1, 0, At, B0); PG8_BAR; PG8_SCHED;
            PG8_STAGE(PG8_SB(0, 1), b2 + hstep, voffB);
            PG8_WAIT_V(6); PG8_BAR; PG8_MMA(1, 1, At, B1); PG8_BAR;
            PG8_LDB(B0, 1, 0); PG8_SCHED; PG8_LDA(At, 1, 0); PG8_STAGE(PG8_SA(0, 1), a2 + hstep, voffA);
            PG8_WAIT_L(8); PG8_BAR; PG8_WAIT_L(0); PG8_MMA(0, 0, At, B0); PG8_BAR; PG8_SCHED;
            PG8_LDB(B1, 1, 1); PG8_STAGE(PG8_SB(1, 0), b3, voffB);
            PG8_BAR; PG8_WAIT_L(0); PG8_MMA(0, 1, At, B1); PG8_BAR;
            PG8_LDA(At, 1, 1); PG8_STAGE(PG8_SA(1, 0), a3, voffA);
            PG8_BAR; PG8_WAIT_L(0); PG8_MMA(1, 0, At, B0); PG8_BAR; PG8_SCHED;
            PG8_STAGE(PG8_SB(1, 1), b3 + hstep, voffB);
            PG8_WAIT_V(6); PG8_BAR; PG8_MMA(1, 1, At, B1); PG8_BAR;
            }
        }
        if constexpr (ALIGN_EPI) { if (wr == 0) PG8_BAR; }
        if constexpr (!Epi::AFTER_DRAIN) { E(acc, cur, wr, wc, fr, fq); S.done(cur); }
        if (!has_next) break;
#pragma unroll
        for (int a = 0; a < 2; ++a)
#pragma unroll
            for (int b = 0; b < 2; ++b)
#pragma unroll
                for (int m = 0; m < 4; ++m)
#pragma unroll
                    for (int n = 0; n < 2; ++n) acc[a][b][m][n] = (f32x4){0.f, 0.f, 0.f, 0.f};
        cur = nxt; cA = nA; cB = nB; ++ui;
        if constexpr (ALIGN_EPI) { if (wr == 1) PG8_BAR; }
    }
    PG8_WAIT_V(0);
    if constexpr (!ALIGN_EPI) { if (wr == 0) PG8_BAR; }
    PG8_BAR;
    if constexpr (Epi::AFTER_DRAIN) { E.fused(acc, cur, wr, wc, fr, fq, lds, wid, lane); S.done(cur); }
#undef PG8_SA
#undef PG8_SB
#undef PG8_STAGE
#undef PG8_LDA
#undef PG8_LDB
#undef PG8_MMA
#undef PG8_WAIT_V
#undef PG8_WAIT_L
#undef PG8_BAR
#undef PG8_SCHED
}
}
#define XB_TMO      128
#define XB_XCNT(j)  (256  + 64 * (j))
#define XB_XSUB(j)  (1280 + 64 * (j))
#define XB_XGEN(j)  (2304 + 64 * (j))
#define XB_TOP      3328
#define XB_TOPGEN   3392
#define XCD_BAR_WORDS 3456
#define XB_SPIN_CAP (1u << 22)

__device__ __forceinline__ unsigned xb_ld(unsigned* p)              { return __hip_atomic_load(p, __ATOMIC_RELAXED, __HIP_MEMORY_SCOPE_AGENT); }
__device__ __forceinline__ unsigned xb_add(unsigned* p, unsigned v) { return __hip_atomic_fetch_add(p, v, __ATOMIC_RELAXED, __HIP_MEMORY_SCOPE_AGENT); }
__device__ __forceinline__ unsigned xb_xcc_id() { return (unsigned)__builtin_amdgcn_s_getreg((3 << 11) | 20) & 0xFu; }
#define XB_SPIN(cond, bar) do { unsigned _sp = 0; while (cond) { __builtin_amdgcn_s_sleep(1); \
    if ((++_sp & 255u) == 0u) { if (xb_ld(&(bar)[XB_TMO])) break; if (_sp > XB_SPIN_CAP) { atomicAdd(&(bar)[XB_TMO], 1u); break; } } } } while (0)

struct XcdBarrier {
    unsigned* bar; unsigned x;
    volatile LAS unsigned* st;
    bool t0;
};

__device__ __forceinline__ XcdBarrier xcd_barrier_post(unsigned* bar, volatile LAS unsigned* st, bool t0) {
    XcdBarrier b; b.bar = bar; b.x = xb_xcc_id(); b.st = st; b.t0 = t0;
    if (t0) (void)xb_add(&bar[XB_XCNT(b.x)], 1u);
    return b;
}
__device__ __forceinline__ void xcd_barrier_complete(unsigned* bar, unsigned x, unsigned& nloc, unsigned& nx) {
    const unsigned G = gridDim.x * gridDim.y * gridDim.z;
    unsigned sum, cnt, mine, sp = 0u;
    for (;;) {
        sum = 0u; cnt = 0u; mine = 0u;
#pragma unroll
        for (unsigned j = 0; j < 16; ++j) { const unsigned c = xb_ld(&bar[XB_XCNT(j)]); sum += c; cnt += (c > 0u) ? 1u : 0u; mine = (j == x) ? c : mine; }
        if (sum == G) break;
        __builtin_amdgcn_s_sleep(1);
        if ((++sp & 255u) == 0u) { if (xb_ld(&bar[XB_TMO])) break; if (sp > XB_SPIN_CAP) { atomicAdd(&bar[XB_TMO], 1u); break; } }
    }
    nloc = mine > 0u ? mine : 1u; nx = cnt > 0u ? cnt : 1u;
}

__device__ __forceinline__ void xcd_barrier(const XcdBarrier& b) {
    asm volatile("s_waitcnt vmcnt(0)" ::: "memory");
    __syncthreads();
    if (b.t0) {
        unsigned* bar = b.bar;
        __builtin_amdgcn_s_waitcnt(0);
        unsigned nloc = b.st[0], nx = b.st[1];
        if (nloc == 0u) { xcd_barrier_complete(bar, b.x, nloc, nx); b.st[0] = nloc; b.st[1] = nx; }
        const unsigned old = xb_add(&bar[XB_XSUB(b.x)], 1u);
        const unsigned gen = old / nloc;
        if (old + 1u == (gen + 1u) * nloc) {
            __builtin_amdgcn_fence(__ATOMIC_RELEASE, "agent");
            asm volatile("s_waitcnt vmcnt(0)" ::: "memory");
            const unsigned og = xb_add(&bar[XB_TOP], 1u);
            const unsigned tg = og / nx;
            if (og + 1u == (tg + 1u) * nx) xb_add(&bar[XB_TOPGEN], 1u);
            else XB_SPIN(xb_ld(&bar[XB_TOPGEN]) == tg, bar);
            __builtin_amdgcn_fence(__ATOMIC_ACQUIRE, "agent");
            xb_add(&bar[XB_XGEN(b.x)], 1u);
            asm volatile("s_waitcnt vmcnt(0)" ::: "memory");
        } else {
            XB_SPIN(xb_ld(&bar[XB_XGEN(b.x)]) == gen, bar);
            __builtin_amdgcn_fence(__ATOMIC_ACQUIRE, "agent");
            asm volatile("s_waitcnt vmcnt(0)" ::: "memory");
        }
    }
    __syncthreads();
}
typedef unsigned short bf16;
typedef unsigned v4u __attribute__((ext_vector_type(4)));
typedef float f32x4 __attribute__((ext_vector_type(4)));
constexpr int NWAVES = 8, NTHREADS = 512;
constexpr int LDS_BYTES = 147456, RING_BYTES = 131072, LDSCTL_OFF = LDS_BYTES - 1024;
struct Args {
    const float *x_prompt, *x_sample, *cache_cmp, *cache_sel, *state_win, *state_conv; const int* page_table;
    const float *norm_mix_g, *w_in, *dw_w, *dw_b, *ln_g, *ln_b, *w_conv_out, *cmp_pos, *w_cmp, *w_nsa_out, *w_out, *norm_mlp_g, *w_up, *w_down, *norm_final_g;
    float* out; unsigned char* ws; int ph_lo, ph_hi;
};
struct Frame {
    LAS unsigned char* lds; int tid, lane, wave, G, bid;
    const __attribute__((address_space(4))) Args* a;
};
#define WSP(T, off) ((T*)(F.a->ws + (off)))
#define F_ctl   WSP(unsigned, WS_CTL)
#define F_ss    ((float*)(WSP(unsigned, WS_CTL) + CW_SS))
#define F_w1    WSP(bf16, WM.w1)
#define F_wc    WSP(bf16, WM.wc)
#define F_wn    WSP(bf16, WM.wn)
#define F_wo    WSP(bf16, WM.wo)
#define F_wup   WSP(bf16, WM.wup)
#define F_wdn   WSP(bf16, WM.wdn)
#define F_wstr  (WM.wstride / 2)
#define F_wcmp  WSP(bf16, WM.wcmp)
#define F_cbias WSP(float, WM.cbias)
#define F_rope  WSP(float, WM.rope)
#define F_X     WSP(float, WM.X)
#define F_XB    WSP(bf16, WM.XB)
#define F_U     WSP(bf16, WM.U)
#define F_Q     WSP(bf16, WM.Q)
#define F_CKV   WSP(bf16, WM.CKV)
#define F_SKV   WSP(bf16, WM.SKV)
#define F_WKV   WSP(bf16, WM.WKV)
#define F_GN    WSP(float, WM.GN)
#define F_GM    WSP(bf16, WM.GM)
#define F_CACT  WSP(bf16, WM.CACT)
#define F_KC    WSP(float, WM.KC)
#define F_VC    WSP(float, WM.VC)
#define F_KCB   WSP(bf16, WM.KCB)
#define F_VCB   WSP(bf16, WM.VCB)
#define F_O     WSP(bf16, WM.O)
#define F_T     WSP(bf16, WM.T)
#define F_HID   WSP(bf16, WM.HID)
DEV float bf2f(bf16 v) { return __uint_as_float((unsigned)v << 16); }
DEV unsigned f2bf(float f) { unsigned u = __builtin_bit_cast(unsigned, f); return (u + 0x7fffu + ((u >> 16) & 1u)) >> 16; }
DEV unsigned pk2(float lo, float hi) { return f2bf(lo) | (f2bf(hi) << 16); }
template <int CTRL> DEV float dpp_mov(float v) { return __int_as_float(__builtin_amdgcn_update_dpp(0, __float_as_int(v), CTRL, 0xf, 0xf, false)); }
DEV float wave_sum(float v) {
    { const auto r = __builtin_amdgcn_permlane32_swap(__float_as_uint(v), __float_as_uint(v), false, false); v = __uint_as_float(r[0]) + __uint_as_float(r[1]); }
    v += __shfl_xor(v, 16);
    v += dpp_mov<0x140>(v);
    v += dpp_mov<0x141>(v);
    v += dpp_mov<0x4E>(v);
    v += dpp_mov<0xB1>(v);
    return v;
}
DEV float wave_max(float v) {
#pragma unroll
    for (int o = 32; o > 0; o >>= 1) v = fmaxf(v, __shfl_xor(v, o));
    return v;
}
DEV float sigm(float x) { return 1.0f / (1.0f + expf(-x)); }

DEV void tr_item(const float* W, int K, int N, bf16* WT, int dst_row0, int src_col0, int cnt, const float* ksc, LAS float* scr, int k0, int lane) {
    const int kk8 = lane >> 3, c4 = (lane & 7) * 4;
    f32x4 v[8];
#pragma unroll
    for (int i = 0; i < 8; ++i) { v[i] = (f32x4){0.f, 0.f, 0.f, 0.f}; if (c4 < cnt) v[i] = *(const f32x4*)(W + (size_t)(k0 + 8 * i + kk8) * N + src_col0 + c4); }
#pragma unroll
    for (int i = 0; i < 8; ++i) { const int kk = 8 * i + kk8; f32x4 x = v[i]; if (ksc) x = x * ksc[k0 + kk];
        scr[kk * 33 + c4] = x[0]; scr[kk * 33 + c4 + 1] = x[1]; scr[kk * 33 + c4 + 2] = x[2]; scr[kk * 33 + c4 + 3] = x[3]; }
    asm volatile("s_waitcnt lgkmcnt(0)" ::: "memory");
    const int c8 = lane & 7;
#pragma unroll
    for (int j = 0; j < 4; ++j) { const int n = (lane >> 3) + 8 * j; const LAS float* s = scr + (8 * c8) * 33 + n;
        v4u o; o.x = pk2(s[0 * 33], s[1 * 33]); o.y = pk2(s[2 * 33], s[3 * 33]); o.z = pk2(s[4 * 33], s[5 * 33]); o.w = pk2(s[6 * 33], s[7 * 33]);
        *(v4u*)(WT + (size_t)(dst_row0 + n) * K + k0 + 8 * c8) = o; }
    asm volatile("s_waitcnt lgkmcnt(0)" ::: "memory");
}
DEV void w1_map(int ng, int& src, int& cnt) {
    const int t = ng >> 3, j0 = (ng & 7) * 32, bj = j0 >> 7, jj = j0 & 127; cnt = 32;
    if (t < 4) src = 128 * t + jj + 512 * bj;
    else if (t < 6) src = 1024 + (4 * (t - 4) + (jj >> 5)) * 64 + 32 * bj;
    else if (t == 6) src = 1536 + j0;
    else if (t < 9) { const int seg = jj >> 5; src = 1792 + 256 * (t - 7) + (seg >> 1) * 128 + (seg & 1) * 64 + 32 * bj; }
    else if (t < 17) src = 2328 + (t - 9) * 256 + j0;
    else { src = 2304; cnt = (j0 == 0) ? 24 : 0; }
}
DEV void p0_prologue(Frame& F) {
    LAS float* scr = (LAS float*)(F.lds + F.wave * 16384);
    const int gw = F.bid * NWAVES + F.wave, NGW = F.G * NWAVES, lane = F.lane;
    constexpr int I_W1 = 16 * 144, I_WC = 8 * 32, I_WO = 16 * 32, I_WUP = 16 * 128, I_WDN = 64 * 32, I_L = I_W1 + 2 * I_WC + I_WO + I_WUP + I_WDN, I_CMP = 256;
    for (int it = gw; it < 2 * I_L + I_CMP; it += NGW) {
        if (it >= 2 * I_L) {
            const int r = it - 2 * I_L, lk = r >> 6, lh = (r >> 5) & 1, q = r & 31, kb = q >> 1, nb = q & 1;
            tr_item(F.a->w_cmp + ((size_t)lk * 32 + 16 * lh) * 4096, 1024, 64, F_wcmp + (size_t)lk * 128 * 1024, lh * 64 + nb * 32, nb * 32, 32, nullptr, scr, kb * 64, lane);
            continue;
        }
        const int l = it / I_L; int r = it % I_L;
        if (r < I_W1) { const int kb = r / 144, ng = r % 144; int src, cnt; w1_map(ng, src, cnt);
            tr_item(F.a->w_in + (size_t)l * D * INC, D, INC, (F_w1 + l * F_wstr), ng * 32, src, cnt, F.a->norm_mix_g + l * D, scr, kb * 64, lane); continue; } r -= I_W1;
        if (r < I_WC) { tr_item(F.a->w_conv_out + (size_t)l * DC * D, DC, D, (F_wc + l * F_wstr), (r % 32) * 32, (r % 32) * 32, 32, nullptr, scr, (r / 32) * 64, lane); continue; } r -= I_WC;
        if (r < I_WC) { tr_item(F.a->w_nsa_out + (size_t)l * 512 * D, 512, D, (F_wn + l * F_wstr), (r % 32) * 32, (r % 32) * 32, 32, nullptr, scr, (r / 32) * 64, lane); continue; } r -= I_WC;
        if (r < I_WO) { tr_item(F.a->w_out + (size_t)l * D * D, D, D, (F_wo + l * F_wstr), (r % 32) * 32, (r % 32) * 32, 32, nullptr, scr, (r / 32) * 64, lane); continue; } r -= I_WO;
        if (r < I_WUP) { tr_item(F.a->w_up + (size_t)l * D * DFF, D, DFF, (F_wup + l * F_wstr), (r % 128) * 32, (r % 128) * 32, 32, F.a->norm_mlp_g + l * D, scr, (r / 128) * 64, lane); continue; } r -= I_WUP;
        tr_item(F.a->w_down + (size_t)l * DFF * D, DFF, D, (F_wdn + l * F_wstr), (r % 32) * 32, (r % 32) * 32, 32, nullptr, scr, (r / 32) * 64, lane);
    }
    __syncthreads();
    if (F.bid < 4) { const float* W = F.a->w_cmp + (size_t)F.bid * 32 * 4096; const float* PE = F.a->cmp_pos + (size_t)F.bid * 2048; LAS float* part = (LAS float*)F.lds;
        float a0 = 0.f, a1 = 0.f, a2 = 0.f, a3 = 0.f;
#pragma unroll 4
        for (int k = 256 * F.wave; k < 256 * F.wave + 256; k += 4) { a0 += PE[k] * W[(size_t)k * 64 + lane]; a1 += PE[k + 1] * W[(size_t)(k + 1) * 64 + lane]; a2 += PE[k + 2] * W[(size_t)(k + 2) * 64 + lane]; a3 += PE[k + 3] * W[(size_t)(k + 3) * 64 + lane]; }
        part[F.wave * 64 + lane] = (a0 + a1) + (a2 + a3);
        __syncthreads();
        if (F.wave == 0) { float s = 0.f;
#pragma unroll
            for (int w2 = 0; w2 < 8; ++w2) s += part[w2 * 64 + lane];
            F_cbias[F.bid * 64 + lane] = s; } }
    for (int idx = F.bid * NTHREADS + F.tid; idx < 2052 * 32; idx += F.G * NTHREADS) { const int pos = idx >> 5, i = idx & 31;
        const double ang = (double)pos * pow(10000.0, -(double)i / 32.0);
        F_rope[pos * 64 + i] = (float)cos(ang); F_rope[pos * 64 + 32 + i] = (float)sin(ang); }
    for (int r = (F.G > 4 ? gw - 4 * NWAVES : gw); r < NT && (F.G <= 4 || F.bid >= 4); r += (F.G > 4 ? NGW - 4 * NWAVES : NGW)) {
        const float* src = r < NP ? F.a->x_prompt + (size_t)r * D : F.a->x_sample + (size_t)(r - NP) * D; float q = 0.f;
#pragma unroll
        for (int j = 0; j < 4; ++j) { const f32x4 v = *(const f32x4*)(src + j * 256 + lane * 4);
            unsigned long long w = (unsigned long long)pk2(v[0], v[1]) | ((unsigned long long)pk2(v[2], v[3]) << 32); *(unsigned long long*)(F_XB + (size_t)r * D + j * 256 + lane * 4) = w;
            q += (v[0] * v[0] + v[1] * v[1]) + (v[2] * v[2] + v[3] * v[3]); }
        q = wave_sum(q); if (lane < 16) F_ss[(size_t)r * 16 + lane] = lane == 0 ? q : 0.f;
    }
    { const unsigned stride = (unsigned)F.G * NTHREADS;
      constexpr unsigned per2 = 26u * DC / 4u, n2 = 2u * BS * per2;
      for (unsigned i = (unsigned)F.bid * NTHREADS + (unsigned)F.tid; i < n2; i += stride) { const unsigned lb = i / per2, o = i - lb * per2;
          ((f32x4*)(F.a->out + OUT_CONV_S + (size_t)lb * 30 * DC))[o] = ((const f32x4*)(F.a->state_conv + ((size_t)lb * 30 + 4) * DC))[o]; } }
}

DEV void ph_conv_simple(Frame& F, int l) {
    LAS float* red = (LAS float*)F.lds;
    const int c = F.tid;
    for (int r = F.bid; r < NT; r += F.G) {
        const bool prompt = r < NP; const int b = prompt ? r / TP : (r - NP) / TS, t = prompt ? r % TP : (r - NP) % TS;
        float a = F.a->dw_b[l * DC + c];
        for (int k = 0; k < CK; ++k) { float v;
            if (prompt) { const int tt = t + k - 30; v = tt >= 0 ? bf2f(F_U[((size_t)b * TP + tt) * DC + c]) : 0.f; }
            else { const int j = t + k; v = j < 30 ? F.a->state_conv[((size_t)(l * BS + b) * 30 + j) * DC + c] : bf2f(F_U[((size_t)NP + b * TS + (j - 30)) * DC + c]); }
            a += v * F.a->dw_w[((size_t)l * CK + k) * DC + c]; }
        float s = wave_sum(a);
        __syncthreads();
        if (F.lane == 0) red[F.wave] = s;
        __syncthreads();
        float mean = 0.f;
#pragma unroll
        for (int w = 0; w < 8; ++w) mean += red[w];
        mean *= (1.0f / DC);
        const float d = a - mean; float q = wave_sum(d * d);
        if (F.lane == 0) red[8 + F.wave] = q;
        __syncthreads();
        float var = 0.f;
#pragma unroll
        for (int w = 0; w < 8; ++w) var += red[8 + w];
        var *= (1.0f / DC);
        const float y = d * (1.0f / sqrtf(var + EPS)) * F.a->ln_g[l * DC + c] + F.a->ln_b[l * DC + c];
        F_CACT[(size_t)r * DC + c] = (bf16)f2bf(y * sigm(y));
    }
}
DEV void ph_compress_simple(Frame& F, int l) {
    LAS float* R = (LAS float*)F.lds;
    const int e = F.lane, j = F.wave;
    for (int blk = F.bid; blk < NB * 2 * 2 * 16; blk += F.G) {
        const int i = blk & 15, kv = (blk >> 4) & 1, g = (blk >> 5) & 1, bi = blk >> 6; const bool prompt = bi < BP;
        __syncthreads();
        for (int row = j; row < 144; row += NWAVES) { const int pos = 128 * i + row; float v = 0.f;
            if (pos < 2048) { if (prompt) v = bf2f(F_CKV[((size_t)bi * TP + pos) * 256 + kv * 128 + g * 64 + e]);
                else { const int b = bi - BP, page = F.a->page_table[b * NPAGES + (pos >> 7)]; v = F.a->cache_cmp[(((size_t)l * NPOOL + page) * 128 + (pos & 127)) * 256 + kv * 128 + g * 64 + e]; } }
            R[row * 64 + e] = v; }
        __syncthreads();
        const float* W = F.a->w_cmp + (size_t)(l * 2 + kv) * 32 * 4096;
        float acc = F_cbias[(l * 2 + kv) * 64 + e];
        for (int ll = 0; ll < 16; ++ll)
            for (int d = 0; d < 64; ++d) acc += R[(j * 16 + ll) * 64 + d] * W[(size_t)(ll * 64 + d) * 64 + e] + R[((j + 1) * 16 + ll) * 64 + d] * W[(size_t)((16 + ll) * 64 + d) * 64 + e];
        const int n = 8 * i + j;
        if (kv == 0) { int cpos = 16 * n + 31; if (cpos > 2051) cpos = 2051; const int dd = e & 31; const float c = F_rope[cpos * 64 + dd], s = F_rope[cpos * 64 + 32 + dd];
            const float other = __shfl_xor(acc, 32); acc = e < 32 ? acc * c - other * s : acc * c + other * s; }
        if (n < NCMP) (kv == 0 ? F_KC : F_VC)[((size_t)(bi * 2 + g) * NCMP + n) * 64 + e] = acc;
        (kv == 0 ? F_KCB : F_VCB)[((size_t)(bi * 2 + g) * 128 + n) * 64 + e] = (bf16)(n < NCMP ? f2bf(acc) : 0u);
    }
}
struct RowSrc { const void* p; int isbf; };
DEV RowSrc row_src(const Frame& F, int mode, int l, bool prompt, int b, int bi, int g, int qp, int blkj, int t, int ln, int kv, bool& ok) {
    RowSrc r; r.isbf = 1;
    if (mode == 0) { int n = t * 64 + ln; ok = n < NCMP && 16 * n + 31 <= qp; if (n > 126) n = 126; r.p = (kv ? F_VCB : F_KCB) + ((size_t)(bi * 2 + g) * 128 + n) * 64; return r; }
    if (mode == 1) { const int kpos = 64 * blkj + ln; ok = kpos <= qp;
        if (prompt) { r.p = F_SKV + ((size_t)b * TP + kpos) * 256 + kv * 128 + g * 64; return r; }
        if (blkj < 32) { const int page = F.a->page_table[b * NPAGES + (kpos >> 7)]; r.isbf = 0; r.p = F.a->cache_sel + (((size_t)l * NPOOL + page) * 128 + (kpos & 127)) * 256 + kv * 128 + g * 64; return r; }
        int ii = kpos - TP; if (ii > 3) ii = 3; r.p = F_SKV + ((size_t)NP + b * TS + ii) * 256 + kv * 128 + g * 64; return r; }
    int kpos = qp - 511 + 64 * t + ln; ok = kpos >= 0; if (kpos < 0) kpos = 0;
    if (prompt) { r.p = F_WKV + ((size_t)b * TP + kpos) * 256 + kv * 128 + g * 64; return r; }
    if (kpos < TP) { r.isbf = 0; r.p = F.a->state_win + ((size_t)(l * BS + b) * 512 + (kpos - (TP - 512))) * 256 + kv * 128 + g * 64; return r; }
    r.p = F_WKV + ((size_t)NP + b * TS + (kpos - TP)) * 256 + kv * 128 + g * 64; return r;
}
DEV float row_elem(RowSrc s, int src_lane, int lane) {
    const unsigned long long v = (unsigned long long)s.p; const unsigned lo = __shfl((unsigned)v, src_lane), hi = __shfl((unsigned)(v >> 32), src_lane); const int isbf = __shfl(s.isbf, src_lane);
    const void* p = (const void*)(((unsigned long long)hi << 32) | lo);
    return isbf ? bf2f(((const bf16*)p)[lane]) : ((const float*)p)[lane];
}
DEV void ph_attn_simple(Frame& F, int l) {
    const int lane = F.lane, w = F.wave;
    if (w >= 4) return;
    LAS float* base = (LAS float*)(F.lds + w * 34816);
    LAS float* Ks = base;
    LAS float* qs = base + 64 * 65;
    LAS float* pcs = qs + 256;
    LAS float* sS = pcs + 128;
    LAS int* sel = (LAS int*)(sS + 4096);
    for (int item = F.bid * 4 + w; item < NT * 2; item += F.G * 4) {
        const int r = item >> 1, g = item & 1; const bool prompt = r < NP;
        const int b = prompt ? r / TP : (r - NP) / TS, tq = prompt ? r % TP : (r - NP) % TS, qp = prompt ? tq : TP + tq, bi = prompt ? b : BP + b;
#pragma unroll
        for (int hh = 0; hh < 4; ++hh) qs[hh * 64 + lane] = bf2f(F_Q[(size_t)r * 512 + (g * 4 + hh) * 64 + lane]);
        float ofin[4] = {0.f, 0.f, 0.f, 0.f}; const float* gn = F_GN + (size_t)r * 24;
        for (int mode = 0; mode < 3; ++mode) {
            const int T = mode == 0 ? 2 : (mode == 1 ? 16 : 8); unsigned okm = 0;
            for (int t = 0; t < T; ++t) {
                bool ok; const int bj = mode == 1 ? sel[t] : 0;
                const RowSrc kp = row_src(F, mode, l, prompt, b, bi, g, qp, bj, t, lane, 0, ok); if (ok) okm |= 1u << t;
                for (int i = 0; i < 64; ++i) Ks[i * 65 + lane] = row_elem(kp, i, lane);
                for (int hh = 0; hh < 4; ++hh) { float a = 0.f; for (int d = 0; d < 64; ++d) a += qs[hh * 64 + d] * Ks[lane * 65 + d]; sS[(t * 4 + hh) * 64 + lane] = ok ? a : -1e30f; }
            }
            for (int hh = 0; hh < 4; ++hh) {
                float m = -1e30f; for (int t = 0; t < T; ++t) m = fmaxf(m, sS[(t * 4 + hh) * 64 + lane]);
                m = wave_max(m); float sum = 0.f;
                for (int t = 0; t < T; ++t) { const float pv = ((okm >> t) & 1u) ? exp2f(sS[(t * 4 + hh) * 64 + lane] - m) : 0.f; sS[(t * 4 + hh) * 64 + lane] = pv; sum += pv; }
                sum = wave_sum(sum); const float inv = 1.0f / fmaxf(sum, 1e-30f);
                for (int t = 0; t < T; ++t) sS[(t * 4 + hh) * 64 + lane] *= inv;
            }
            float o[4] = {0.f, 0.f, 0.f, 0.f};
            for (int t = 0; t < T; ++t) {
                bool ok; const int bj = mode == 1 ? sel[t] : 0;
                const RowSrc vp = row_src(F, mode, l, prompt, b, bi, g, qp, bj, t, lane, 1, ok);
                for (int i = 0; i < 64; ++i) { const float v = row_elem(vp, i, lane);
#pragma unroll
                    for (int hh = 0; hh < 4; ++hh) o[hh] += sS[(t * 4 + hh) * 64 + i] * v; }
            }
#pragma unroll
            for (int hh = 0; hh < 4; ++hh) ofin[hh] += gn[mode * 8 + g * 4 + hh] * o[hh];
            if (mode == 0) {
                pcs[lane] = sS[lane] + sS[64 + lane] + sS[128 + lane] + sS[192 + lane];
                pcs[64 + lane] = sS[256 + lane] + sS[320 + lane] + sS[384 + lane] + sS[448 + lane];
                const int nsel = prompt ? 32 : 33, cur = qp >> 6; float imp = 0.f;
                for (int n = 4 * lane - 1; n <= 4 * lane + 3; ++n) if (n >= 0 && n < NCMP && lane < nsel) imp += pcs[n];
                const bool valid = lane < nsel && 64 * lane <= qp, forced = lane == 0 || lane == cur || lane == cur - 1;
                imp = valid ? (forced ? INFINITY : imp) : -INFINITY;
                bool cand = lane < nsel;
                for (int k = 0; k < 16; ++k) { const float m = wave_max(cand ? imp : -INFINITY); const unsigned long long bal = __ballot(cand && imp == m); const int jj = __ffsll((long long)bal) - 1;
                    if (lane == 0) sel[k] = jj; if (lane == jj) cand = false; }
            }
        }
#pragma unroll
        for (int hh = 0; hh < 4; ++hh) { const int h = g * 4 + hh; F_O[(size_t)r * 512 + h * 64 + lane] = (bf16)f2bf(ofin[hh]); }
    }
}
DEV void ph_dump(Frame& F, const bf16* A, int lda, const bf16* B, int ldb) {
    const int gw = F.bid * NWAVES + F.wave, NGW = F.G * NWAVES, lane = F.lane;
    for (int r = gw; r < NT; r += NGW) for (int c = lane; c < 512; c += 64) { F.a->out[OUT_Y + (size_t)r * D + c] = bf2f(A[(size_t)r * lda + c]); F.a->out[OUT_Y + (size_t)r * D + 512 + c] = bf2f(B[(size_t)r * ldb + c]); }
}
DEV void ph_final(Frame& F) {
    const int gw = F.bid * NWAVES + F.wave, NGW = F.G * NWAVES, lane = F.lane; const float* ss = F_ss + (size_t)4 * NT * 16;
    const bool poison = __hip_atomic_load(F_ctl + CW_BAR + XB_TMO, __ATOMIC_RELAXED, __HIP_MEMORY_SCOPE_AGENT) != 0u;
    for (int r = gw; r < NT; r += NGW) { const float rs = poison ? __builtin_nanf("") : pg8::row_rs(ss, r);
#pragma unroll
        for (int j = 0; j < 4; ++j) { const f32x4 v = *(const f32x4*)(F_X + (size_t)r * D + j * 256 + lane * 4), gv = *(const f32x4*)(F.a->norm_final_g + j * 256 + lane * 4);
            __builtin_nontemporal_store(v * rs * gv, (f32x4*)(F.a->out + OUT_Y + (size_t)r * D + j * 256 + lane * 4)); } }
}

DEV Frame launder(const Frame& F0) {
    Frame F; int z = 0; asm volatile("s_mov_b32 %0, 0" : "=s"(z));
    F.wave = F0.wave; F.lane = (int)__builtin_amdgcn_mbcnt_hi(~0u, __builtin_amdgcn_mbcnt_lo(~0u, 0u)) + z; F.tid = F.wave * 64 + F.lane; F.G = F0.G; F.bid = F0.bid; F.lds = F0.lds + z;
    F.a = (const __attribute__((address_space(4))) Args*)((const __attribute__((address_space(4))) char*)__builtin_amdgcn_kernarg_segment_ptr() + z);
    return F;
}
namespace mini {
typedef short bf16x8 __attribute__((ext_vector_type(8)));
template <int KS, int NS, class Epi>
DEV void gemm(const Frame& F, const bf16* A, const bf16* Bt, const int K, const Epi& epi) {
    static_assert(KS * NS == 8, "eight waves");
    constexpr int NC = 64 * NS;
    constexpr int NCG = (NS == 1) ? 16 : 16;
    LAS float* part = (LAS float*)F.lds;
    const int lane = F.lane, w = F.wave, kq = w % KS, nq = w / KS, m = lane & 15, kg = lane >> 4;
    for (int slab = F.bid; slab < 16 * NCG; slab += F.G) {
        const int mi = slab / NCG, ni = slab % NCG, row0 = NP + 32 * mi, col0 = NC * ni;
        f32x4 acc[2][4];
#pragma unroll
        for (int rt = 0; rt < 2; ++rt)
#pragma unroll
            for (int ct = 0; ct < 4; ++ct) acc[rt][ct] = (f32x4){0.f, 0.f, 0.f, 0.f};
        const int klen = K / KS, kbeg = kq * klen;
        const bf16* ap = A + (size_t)(row0 + m) * K + kbeg + 8 * kg; const bf16* bp = Bt + (size_t)(col0 + 64 * nq + m) * K + kbeg + 8 * kg;
#pragma unroll 4
        for (int k = 0; k < klen; k += 32) {
            bf16x8 a[2], b[4];
#pragma unroll
            for (int rt = 0; rt < 2; ++rt) a[rt] = *(const bf16x8*)(ap + (size_t)(16 * rt) * K + k);
#pragma unroll
            for (int ct = 0; ct < 4; ++ct) b[ct] = *(const bf16x8*)(bp + (size_t)(16 * ct) * K + k);
#pragma unroll
            for (int rt = 0; rt < 2; ++rt)
#pragma unroll
                for (int ct = 0; ct < 4; ++ct) acc[rt][ct] = __builtin_amdgcn_mfma_f32_16x16x32_bf16(a[rt], b[ct], acc[rt][ct], 0, 0, 0);
        }
        __syncthreads();
#pragma unroll
        for (int rt = 0; rt < 2; ++rt)
#pragma unroll
            for (int ct = 0; ct < 4; ++ct)
#pragma unroll
                for (int rg = 0; rg < 4; ++rg) part[(size_t)(kq * 32 + 16 * rt + 4 * kg + rg) * NC + 64 * nq + 16 * ct + m] = acc[rt][ct][rg];
        __syncthreads();
        for (int o = F.tid; o < 32 * NC / 4; o += NTHREADS) { const int row = o / (NC / 4), c4 = (o % (NC / 4)) * 4; f32x4 v = *(const LAS f32x4*)(part + (size_t)row * NC + c4);
#pragma unroll
            for (int q = 1; q < KS; ++q) v += *(const LAS f32x4*)(part + (size_t)(q * 32 + row) * NC + c4);
            epi(row0 + row, col0 + c4, v, o); }
    }
}
DEV unsigned long long pack4(f32x4 v) { return (unsigned long long)pg8::cvt_pk_bf16(v[0], v[1]) | ((unsigned long long)pg8::cvt_pk_bf16(v[2], v[3]) << 32); }
DEV f32x4 unpack4(unsigned long long w) { f32x4 v; v[0] = __uint_as_float((unsigned)w << 16); v[1] = __uint_as_float((unsigned)w & 0xffff0000u); v[2] = __uint_as_float((unsigned)(w >> 32) << 16); v[3] = __uint_as_float((unsigned)(w >> 32) & 0xffff0000u); return v; }
template <int MODE> struct EpiGate { const bf16* GM; bf16* T;
    DEV void operator()(int row, int col, f32x4 v, int) const { const f32x4 g = unpack4(*(const unsigned long long*)(GM + (size_t)row * 2048 + MODE * 1024 + col)); f32x4 o = v * g;
        if (MODE == 1) o += unpack4(*(const unsigned long long*)(T + (size_t)row * D + col));
        *(unsigned long long*)(T + (size_t)row * D + col) = pack4(o); } };
struct EpiRes { float* X; bf16* XB; float* ssn; const float* Xs; bool wxb;
    DEV void operator()(int row, int col, f32x4 v, int) const { float* xp = X + (size_t)row * D + col; const f32x4 x = *(const f32x4*)(Xs + (size_t)row * D + col) + v; *(f32x4*)xp = x; if (wxb) *(unsigned long long*)(XB + (size_t)row * D + col) = pack4(x);
        float q = (x[0] * x[0] + x[1] * x[1]) + (x[2] * x[2] + x[3] * x[3]);
        q += __shfl_xor(q, 1); q += __shfl_xor(q, 2); q += __shfl_xor(q, 4); q += __shfl_xor(q, 8);
        if ((col & 63) == 0) ssn[(size_t)row * 16 + (col >> 6)] = q; } };
struct EpiRelu2 { const float* ss; bf16* H;
    DEV void operator()(int row, int col, f32x4 v, int) const { const float rs = pg8::row_rs(ss, row); f32x4 o;
#pragma unroll
        for (int i = 0; i < 4; ++i) { const float a = fmaxf(v[i] * rs, 0.f); o[i] = a * a; }
        *(unsigned long long*)(H + (size_t)row * DFF + col) = pack4(o); } };
}
DEV int queue_next(const Frame& F, unsigned* ctr) {
    LAS int* slot = (LAS int*)(F.lds + LDSCTL_OFF + 128);
    __syncthreads();
    if (F.tid == 0) *slot = (int)__hip_atomic_fetch_add(ctr, 1u, __ATOMIC_RELAXED, __HIP_MEMORY_SCOPE_AGENT);
    __syncthreads();
    return *slot;
}
DEV void ph_conv(const Frame& F, const int l) {
    typedef unsigned u32x4v __attribute__((ext_vector_type(4)));
    LAS bf16* us = (LAS bf16*)F.lds;
    LAS float* os = (LAS float*)(F.lds + 63488);
    const int c = F.tid, lane = F.lane, wv = F.wave;
    float w[CK];
#pragma unroll
    for (int k = 0; k < CK; ++k) w[k] = F.a->dw_w[((size_t)l * CK + k) * DC + c];
    const float bias = F.a->dw_b[l * DC + c];
    const f32x4 g0 = *(const f32x4*)(F.a->ln_g + l * DC + lane * 8), g1 = *(const f32x4*)(F.a->ln_g + l * DC + lane * 8 + 4), b0v = *(const f32x4*)(F.a->ln_b + l * DC + lane * 8), b1v = *(const f32x4*)(F.a->ln_b + l * DC + lane * 8 + 4);
    unsigned* qctr = F_ctl + 8192 + (l * 2 + 1) * 64;
    for (int item = queue_next(F, qctr); item < NP / 32 + BS / 2; item = queue_next(F, qctr)) {
        const bool prompt = item < NP / 32;
        const int r0 = prompt ? item * 32 : NP + (item - NP / 32) * 8, ntok = prompt ? 32 : 8;
        __syncthreads();
        if (prompt) {
            const int b = r0 >> 11, t0 = r0 & 2047;
            u32x4v stg[8];
#pragma unroll
            for (int q = 0; q < 8; ++q) { const int i = F.tid + q * NTHREADS, row = i >> 6, ch = i & 63, tt = t0 - 30 + row; stg[q] = (u32x4v){0u, 0u, 0u, 0u};
                if (i < 62 * 64 && tt >= 0) stg[q] = *(const u32x4v*)(F_U + ((size_t)b * TP + tt) * DC + ch * 8); }
#pragma unroll
            for (int q = 0; q < 8; ++q) { const int i = F.tid + q * NTHREADS, row = i >> 6, ch = i & 63; if (i < 62 * 64) *(LAS u32x4v*)(us + row * 512 + ch * 8) = stg[q]; }
            __syncthreads();
#pragma unroll 1
            for (int tc = 0; tc < 4; ++tc) {
                float a8[8];
#pragma unroll
                for (int t = 0; t < 8; ++t) a8[t] = bias;
#pragma unroll
                for (int i = 0; i < 38; ++i) { const float x = bf2f(us[(8 * tc + i) * 512 + c]);
#pragma unroll
                    for (int t = 0; t < 8; ++t) if (i - t >= 0 && i - t <= 30) a8[t] += x * w[i - t]; }
#pragma unroll
                for (int t = 0; t < 8; ++t) os[(8 * tc + t) * 512 + c] = a8[t];
            }
        } else {
            const int b0 = (r0 - NP) >> 2;
#pragma unroll 1
            for (int bb = 0; bb < 2; ++bb) { const int b = b0 + bb; float x[34];
#pragma unroll
                for (int j = 0; j < 30; ++j) x[j] = F.a->state_conv[((size_t)(l * BS + b) * 30 + j) * DC + c];
#pragma unroll
                for (int j = 0; j < 4; ++j) x[30 + j] = bf2f(F_U[((size_t)NP + b * TS + j) * DC + c]);
#pragma unroll
                for (int t = 0; t < 4; ++t) { float o = bias;
#pragma unroll
                    for (int k = 0; k < CK; ++k) o += x[t + k] * w[k];
                    os[(4 * bb + t) * 512 + c] = o; } }
        }
        __syncthreads();
        for (int t = wv; t < ntok; t += NWAVES) {
            const f32x4 v0 = *(const LAS f32x4*)(os + t * 512 + lane * 8), v1 = *(const LAS f32x4*)(os + t * 512 + lane * 8 + 4);
            const float mean = wave_sum((v0[0] + v0[1]) + (v0[2] + v0[3]) + (v1[0] + v1[1]) + (v1[2] + v1[3])) * (1.0f / DC);
            const f32x4 d0 = v0 - mean, d1 = v1 - mean;
            const float var = wave_sum((d0[0] * d0[0] + d0[1] * d0[1]) + (d0[2] * d0[2] + d0[3] * d0[3]) + (d1[0] * d1[0] + d1[1] * d1[1]) + (d1[2] * d1[2] + d1[3] * d1[3])) * (1.0f / DC);
            const float rs = 1.0f / sqrtf(var + EPS);
            f32x4 y0 = d0 * rs * g0 + b0v, y1 = d1 * rs * g1 + b1v;
#pragma unroll
            for (int i = 0; i < 4; ++i) { y0[i] = y0[i] * pg8::fsigmoid(y0[i]); y1[i] = y1[i] * pg8::fsigmoid(y1[i]); }
            *(u32x4v*)(F_CACT + (size_t)(r0 + t) * DC + lane * 8) = pg8::pack8(y0, y1); }
    }
}
DEV void ph_compress(const Frame& F, const int l) {
    typedef short bf16x8 __attribute__((ext_vector_type(8)));
    typedef unsigned u32x4v __attribute__((ext_vector_type(4)));
    constexpr int BROW = 272, BBUF = 128 * BROW;
    LAS unsigned char* bs = F.lds;
    LAS float* p1s = (LAS float*)(F.lds + 2 * BBUF);
    const int tid = F.tid, lane = F.lane, wv = F.wave, m = lane & 15, kg = lane >> 4;
    const int chunk = 16 * wv + m;
    unsigned* qctr = F_ctl + 8192 + (l * 2 + 0) * 64;
    for (int it = queue_next(F, qctr); it < NB * 4; it = queue_next(F, qctr)) {
        const int item = it < BS * 4 ? it + BP * 4 : it - BS * 4;
        const int kv = item & 1, g = (item >> 1) & 1, bi = item >> 2; const bool prompt = bi < BP;
        const bf16* Wt = F_wcmp + (size_t)(l * 2 + kv) * 128 * 1024;
        f32x4 acc[8];
#pragma unroll
        for (int q = 0; q < 8; ++q) acc[q] = (f32x4){0.f, 0.f, 0.f, 0.f};
        u32x4v ra[3][4][2];
        const bf16* pa = nullptr; const float* sa = nullptr;
        if (prompt) pa = F_CKV + ((size_t)bi * TP + 16 * chunk) * 256 + kv * 128 + g * 64 + 8 * kg;
        else { const int b = bi - BP, page = F.a->page_table[b * NPAGES + (chunk >> 3)]; sa = F.a->cache_cmp + (((size_t)l * NPOOL + page) * 128 + 16 * (chunk & 7)) * 256 + kv * 128 + g * 64 + 8 * kg; }
        auto load_a = [&](int st, int ks) {
#pragma unroll
            for (int q = 0; q < 4; ++q) { const int ll = 2 * ks + (q >> 1), d0 = (q & 1) * 32;
                if (prompt) ra[st][q][0] = *(const u32x4v*)(pa + (size_t)ll * 256 + d0);
                else { ra[st][q][0] = __builtin_nontemporal_load((const u32x4v*)(sa + (size_t)ll * 256 + d0)); ra[st][q][1] = __builtin_nontemporal_load((const u32x4v*)(sa + (size_t)ll * 256 + d0 + 4)); } }
        };
        auto frag_a = [&](int st, int q) -> bf16x8 {
            u32x4v x = ra[st][q][0];
            if (!prompt) { const u32x4v a = ra[st][q][0], b2 = ra[st][q][1];
                x.x = pg8::cvt_pk_bf16(__uint_as_float(a.x), __uint_as_float(a.y)); x.y = pg8::cvt_pk_bf16(__uint_as_float(a.z), __uint_as_float(a.w));
                x.z = pg8::cvt_pk_bf16(__uint_as_float(b2.x), __uint_as_float(b2.y)); x.w = pg8::cvt_pk_bf16(__uint_as_float(b2.z), __uint_as_float(b2.w)); }
            return __builtin_bit_cast(bf16x8, x);
        };
        u32x4v rb[4];
        auto load_b = [&](int ks) {
#pragma unroll
            for (int i = 0; i < 4; ++i) { const int q = tid + i * NTHREADS, e = q >> 4, ch = q & 15; rb[i] = *(const u32x4v*)(Wt + (size_t)e * 1024 + ks * 128 + ch * 8); }
        };
        auto store_b = [&](int buf) {
#pragma unroll
            for (int i = 0; i < 4; ++i) { const int q = tid + i * NTHREADS, e = q >> 4, ch = q & 15; *(LAS u32x4v*)(bs + buf * BBUF + e * BROW + ch * 16) = rb[i]; }
        };
        __syncthreads();
        load_b(0); load_a(0, 0); load_a(1, 1); load_a(2, 2); store_b(0);
        __syncthreads();
#pragma unroll
        for (int ks = 0; ks < 8; ++ks) { const int st = ks % 3;
            if (ks + 1 < 8) load_b(ks + 1);
            const LAS unsigned char* bb = bs + (ks & 1) * BBUF;
            bf16x8 af[4];
#pragma unroll
            for (int q = 0; q < 4; ++q) af[q] = frag_a(st, q);
            if (ks + 3 < 8) load_a(st, ks + 3);
#pragma unroll
            for (int q = 0; q < 4; ++q)
#pragma unroll
                for (int nt = 0; nt < 8; ++nt) { const bf16x8 bf = *(const LAS bf16x8*)(bb + (16 * nt + m) * BROW + (q * 32 + 8 * kg) * 2);
                    acc[nt] = __builtin_amdgcn_mfma_f32_16x16x32_bf16(af[q], bf, acc[nt], 0, 0, 0); }
            if (ks + 1 < 8) store_b((ks + 1) & 1);
            __syncthreads();
        }
#pragma unroll
        for (int rg = 0; rg < 4; ++rg)
#pragma unroll
            for (int nt = 0; nt < 4; ++nt) p1s[(size_t)(16 * wv + 4 * kg + rg) * 64 + 16 * nt + m] = acc[4 + nt][rg];
        __syncthreads();
        bf16* dst = (kv == 0 ? F_KCB : F_VCB) + (size_t)(bi * 2 + g) * 128 * 64;
#pragma unroll
        for (int rg = 0; rg < 4; ++rg) { const int nn = 16 * wv + 4 * kg + rg; float v[4];
#pragma unroll
            for (int nt = 0; nt < 4; ++nt) v[nt] = acc[nt][rg] + (nn < NCMP ? p1s[(size_t)(nn + 1) * 64 + 16 * nt + m] : 0.f) + F_cbias[(l * 2 + kv) * 64 + 16 * nt + m];
            if (kv == 0) { const int pos = 16 * nn + 31 < 2052 ? 16 * nn + 31 : 2051;
#pragma unroll
                for (int nt = 0; nt < 2; ++nt) { const float cs = F_rope[(size_t)pos * 64 + 16 * nt + m], sn = F_rope[(size_t)pos * 64 + 32 + 16 * nt + m]; const float x1 = v[nt], x2 = v[nt + 2]; v[nt] = x1 * cs - x2 * sn; v[nt + 2] = x2 * cs + x1 * sn; } }
#pragma unroll
            for (int nt = 0; nt < 4; ++nt) dst[(size_t)nn * 64 + 16 * nt + m] = (bf16)(nn < NCMP ? f2bf(v[nt]) : 0u); }
    }
}
namespace att {
typedef short bf16x8 __attribute__((ext_vector_type(8)));
typedef short s16x4 __attribute__((ext_vector_type(4)));
typedef float f32x16 __attribute__((ext_vector_type(16)));
typedef unsigned u32x4 __attribute__((ext_vector_type(4)));
typedef unsigned u32x2 __attribute__((ext_vector_type(2)));
constexpr int KROW = 144, KBUF = 64 * KROW, VBUF = 8192, TBUF = KBUF + VBUF;
constexpr int L_BUF0 = 0, L_BUF1 = TBUF, L_IMP = 2 * TBUF, L_SELM = L_IMP + 8 * 32 * 33 * 4, L_TMP = L_SELM + 64 * 4, L_LIST = L_TMP + 8 * 64 * 4, L_TBASE = L_LIST + 64 * 4, L_END = L_TBASE + 64 * 4,
              L_RAW0 = L_END, L_RAW1 = L_RAW0 + 32768, L_RAW2 = L_IMP, L_NEW = L_RAW1 + 32768, L_END2 = L_NEW + 2048;
constexpr float NEG = -1e30f;
constexpr float C2 = 0.125f * 1.4426950408889634f;
DEV int crow(int r, int hi) { return (r & 3) + 8 * (r >> 2) + 4 * hi; }
DEV unsigned cvtpk(float lo, float hi) { return pg8::cvt_pk_bf16(lo, hi); }
DEV float xhalf(float v) { return __shfl_xor(v, 32); }
DEV float from_hi(float v) { const auto r = __builtin_amdgcn_permlane32_swap(__float_as_uint(v), __float_as_uint(v), false, false); return __uint_as_float(r[1]); }
DEV int xmax_i(int v) { const auto r = __builtin_amdgcn_permlane32_swap((unsigned)v, (unsigned)v, false, false); return max((int)r[0], (int)r[1]); }
DEV float xsum_f(float v) { const auto r = __builtin_amdgcn_permlane32_swap(__float_as_uint(v), __float_as_uint(v), false, false); return __uint_as_float(r[0]) + __uint_as_float(r[1]); }

struct Unit { int samp, b, g, qt; };
struct TileRegs { u32x4 k0, k1, v0, v1; int isf32; };

DEV void tile_load(TileRegs& R, const Frame& F, int l, const Unit& u, int type, int idx, int key, int chunk, int rowbase = -1) {
    R.isf32 = 0; const u32x4 z = {0u, 0u, 0u, 0u}; R.k0 = z; R.k1 = z; R.v0 = z; R.v1 = z;
    const int bi = u.samp ? BP + u.b : u.b;
    if (type == 0) {
        const bf16* kp = F_KCB + ((size_t)(bi * 2 + u.g) * 128 + 64 * idx + key) * 64 + chunk * 8; const bf16* vp = F_VCB + ((size_t)(bi * 2 + u.g) * 128 + 64 * idx + key) * 64 + chunk * 8;
        R.k0 = *(const u32x4*)kp; R.v0 = *(const u32x4*)vp; return;
    }
    if (!u.samp) {
        const bf16* p = (type == 1 ? F_SKV : F_WKV) + ((size_t)u.b * TP + 64 * idx + key) * 256 + u.g * 64 + chunk * 8;
        R.k0 = *(const u32x4*)p; R.v0 = *(const u32x4*)(p + 128); return;
    }
    if (idx == 32) {
        if (key < TS) { const bf16* p = (type == 1 ? F_SKV : F_WKV) + ((size_t)NP + u.b * TS + key) * 256 + u.g * 64 + chunk * 8; R.k0 = *(const u32x4*)p; R.v0 = *(const u32x4*)(p + 128); }
        return;
    }
    const float* p;
    if (type == 1) { int rb = rowbase; if (rb < 0) { const int page = F.a->page_table[u.b * NPAGES + (idx >> 1)]; rb = (l * NPOOL + page) * 128 + (idx & 1) * 64; }
        p = F.a->cache_sel + ((size_t)rb + key) * 256 + u.g * 64 + chunk * 8; }
    else p = F.a->state_win + ((size_t)(l * BS + u.b) * 512 + 64 * (idx - 24) + key) * 256 + u.g * 64 + chunk * 8;
    R.isf32 = 1; R.k0 = *(const u32x4*)p; R.k1 = *(const u32x4*)(p + 4); R.v0 = *(const u32x4*)(p + 128); R.v1 = *(const u32x4*)(p + 132);
}
DEV u32x4 f8_to_bf8(u32x4 a, u32x4 b) { u32x4 o; o.x = cvtpk(__uint_as_float(a.x), __uint_as_float(a.y)); o.y = cvtpk(__uint_as_float(a.z), __uint_as_float(a.w)); o.z = cvtpk(__uint_as_float(b.x), __uint_as_float(b.y)); o.w = cvtpk(__uint_as_float(b.z), __uint_as_float(b.w)); return o; }
DEV void tile_store(const TileRegs& R, LAS unsigned char* buf, int key, int chunk) {
    u32x4 k = R.k0, v = R.v0;
    if (R.isf32) { k = f8_to_bf8(R.k0, R.k1); v = f8_to_bf8(R.v0, R.v1); }
    *(LAS u32x4*)(buf + key * KROW + chunk * 16) = k;
    *(LAS u32x4*)(buf + KBUF + (chunk >> 2) * 4096 + key * 64 + (chunk & 3) * 16) = v;
}
DEV void qk_tile(f32x16 (&s)[2], const LAS unsigned char* kb, const bf16x8 (&qf)[4], float cinit, int r32, int hi) {
#pragma unroll
    for (int kvh = 0; kvh < 2; ++kvh) {
        f32x16 a;
#pragma unroll
        for (int r = 0; r < 16; ++r) a[r] = cinit;
#pragma unroll
        for (int st = 0; st < 4; ++st) { const bf16x8 kf = *(const LAS bf16x8*)(kb + (32 * kvh + r32) * KROW + (16 * st + 8 * hi) * 2); a = __builtin_amdgcn_mfma_f32_32x32x16_bf16(kf, qf[st], a, 0, 0, 0); }
        s[kvh] = a;
    }
}
typedef short v4i16_t __attribute__((ext_vector_type(4)));
DEV s16x4 vtr(const LAS unsigned char* p) { return __builtin_bit_cast(s16x4, __builtin_amdgcn_ds_read_tr16_b64_v4i16((LAS v4i16_t*)p)); }
DEV void pv_tile(f32x16 (&o)[2], const LAS unsigned char* vb, const bf16x8 (&pf)[4], int lane) {
    const int g16 = lane >> 4, i = lane & 15, q_ = i >> 2, p_ = i & 3, hi = g16 >> 1, dsub = 16 * (g16 & 1);
    const LAS unsigned char* base = vb + (4 * hi + q_) * 64 + (dsub + 4 * p_) * 2;
#pragma unroll
    for (int dh = 0; dh < 2; ++dh)
#pragma unroll
        for (int st = 0; st < 4; ++st) { const s16x4 lo = vtr(base + dh * 4096 + (16 * st) * 64), hh = vtr(base + dh * 4096 + (16 * st + 8) * 64);
            const bf16x8 vf = {lo[0], lo[1], lo[2], lo[3], hh[0], hh[1], hh[2], hh[3]};
            o[dh] = __builtin_amdgcn_mfma_f32_32x32x16_bf16(vf, pf[st], o[dh], 0, 0, 0); }
}
DEV void pack_p(bf16x8 (&pf)[4], const f32x16 (&p)[2]) {
#pragma unroll
    for (int st = 0; st < 4; ++st) { const f32x16& x = p[st >> 1]; const int r0 = 8 * (st & 1);
        const u32x4 w = {cvtpk(x[r0], x[r0 + 1]), cvtpk(x[r0 + 2], x[r0 + 3]), cvtpk(x[r0 + 4], x[r0 + 5]), cvtpk(x[r0 + 6], x[r0 + 7])};
        pf[st] = __builtin_bit_cast(bf16x8, w); }
}
DEV void edge_mask(f32x16 (&s)[2], int mode, int qoff, int hi) {
    const int qs = qoff - 4 * hi;
#pragma unroll
    for (int kvh = 0; kvh < 2; ++kvh)
#pragma unroll
        for (int r = 0; r < 16; ++r) { const int c = 32 * kvh + (r & 3) + 8 * (r >> 2); const bool keep = mode == 1 ? (c <= qs) : (c > qs); if (!keep) s[kvh][r] = NEG; }
}

DEV void kfrags_row(bf16x8 (&kf)[8], const LAS unsigned char* kb, int r32, int hi) {
#pragma unroll
    for (int st = 0; st < 4; ++st)
#pragma unroll
        for (int kvh = 0; kvh < 2; ++kvh) kf[2 * st + kvh] = *(const LAS bf16x8*)(kb + (32 * kvh + r32) * KROW + 32 * st + 16 * hi);
}
DEV void qk_regs(f32x16 (&s)[2], const bf16x8 (&kf)[8], const bf16x8 (&qf)[4], float cinit);
DEV void v_frags(bf16x8 (&vf)[8], const LAS unsigned char* vb, int lane);
DEV void pv_regs(f32x16 (&o)[2], const bf16x8 (&vf)[8], const bf16x8 (&pf)[4]);
DEV void glds16(const void* gsrc, unsigned lds_dst) { unsigned keep;
    asm volatile("s_mov_b32 %0, m0\n\ts_mov_b32 m0, %2\n\ts_nop 0\n\tglobal_load_lds_dwordx4 %1, off\n\ts_mov_b32 m0, %0" : "=&s"(keep) : "v"(gsrc), "s"(lds_dst) : "memory"); }
DEV void glds16s(unsigned voff, const void* sbase, unsigned lds_dst) { unsigned keep;
    asm volatile("s_mov_b32 %0, m0\n\ts_mov_b32 m0, %3\n\ts_nop 0\n\tglobal_load_lds_dwordx4 %1, %2\n\ts_mov_b32 m0, %0" : "=&s"(keep) : "v"(voff), "s"(sbase), "s"(lds_dst) : "memory"); }
static_assert(L_END2 <= LDSCTL_OFF, "sample-unit LDS");
DEV void attn_unit(const Frame& F, const int l, const Unit u) {
    const int tid = F.tid, lane = F.lane, w = F.wave, hh = w & 3, ph = w >> 2, r32 = lane & 31, hi = lane >> 5;
    const int key = tid >> 3, chunk = tid & 7;
    LAS unsigned char* lds = F.lds;
    LAS float* impW = (LAS float*)(lds + L_IMP); LAS unsigned* selm = (LAS unsigned*)(lds + L_SELM); LAS float* tmpv = (LAS float*)(lds + L_TMP); LAS int* tlist = (LAS int*)(lds + L_LIST);
    const int samp = u.samp, qt = u.qt, h = u.g * 4 + hh;
    const int qoff = 32 * ph + r32;
    const int qi = samp ? (r32 < TS ? r32 : TS - 1) : qoff;
    const int qrow = samp ? NP + u.b * TS + qi : u.b * TP + 64 * qt + qi;
    const int qp = samp ? TP + qi : 64 * qt + qi;
    const int qo = samp ? qi : qoff;
    const bool active = !(samp && ph == 1);
    const bool qvalid = samp ? (ph == 0 && r32 < TS) : true;
    bf16x8 qf[4];
#pragma unroll
    for (int st = 0; st < 4; ++st) qf[st] = *(const bf16x8*)(F_Q + (size_t)qrow * 512 + h * 64 + 16 * st + 8 * hi);
    const float* gn = F_GN + (size_t)qrow * 24;
    const float g_c = gn[h], g_s = gn[8 + h], g_w = gn[16 + h];
    f32x16 out[2];
#pragma unroll
    for (int r = 0; r < 16; ++r) { out[0][r] = 0.f; out[1][r] = 0.f; }
    TileRegs R, R2;
    tile_load(R, F, l, u, 0, 0, key, chunk); tile_load(R2, F, l, u, 0, 1, key, chunk);
    if (tid >= 128 && tid < 144) ((LAS int*)(lds + L_TBASE))[48 + tid - 128] = F.a->page_table[u.b * NPAGES + tid - 128];
    if (tid >= 64 && tid < 128) { const int t2 = tid - 64, ty = t2 >> 5, k4 = (t2 >> 3) & 3, ch = t2 & 7;
        const bf16* p = (ty == 0 ? F_SKV : F_WKV) + ((size_t)NP + u.b * TS + k4) * 256 + u.g * 64 + ch * 8;
        *(LAS u32x4*)(lds + L_NEW + ty * 1024 + k4 * 128 + ch * 16) = *(const u32x4*)p;
        *(LAS u32x4*)(lds + L_NEW + ty * 1024 + 512 + k4 * 128 + ch * 16) = *(const u32x4*)(p + 128); }
    tile_store(R, lds + L_BUF0, key, chunk); tile_store(R2, lds + L_BUF1, key, chunk);
    __syncthreads();
    if (active) {
        f32x16 s0[2], s1[2];
        { bf16x8 kfc[8]; kfrags_row(kfc, lds + L_BUF0, r32, hi); qk_regs(s0, kfc, qf, 0.f); kfrags_row(kfc, lds + L_BUF1, r32, hi); qk_regs(s1, kfc, qf, 0.f); }
        int nlim = qp >= 31 ? ((qp - 31) >> 4) : -1; if (nlim > NCMP - 1) nlim = NCMP - 1;
        const int nl = nlim - 4 * hi;
        float m = NEG;
#pragma unroll
        for (int kvh = 0; kvh < 2; ++kvh)
#pragma unroll
            for (int r = 0; r < 16; ++r) { const int c = 32 * kvh + (r & 3) + 8 * (r >> 2); if (c > nl) s0[kvh][r] = NEG; if (c + 64 > nl) s1[kvh][r] = NEG; m = fmaxf(m, fmaxf(s0[kvh][r], s1[kvh][r])); }
        m = fmaxf(m, xhalf(m));
        float sum = 0.f;
#pragma unroll
        for (int kvh = 0; kvh < 2; ++kvh)
#pragma unroll
            for (int r = 0; r < 16; ++r) { const int c = 32 * kvh + (r & 3) + 8 * (r >> 2);
                const float p0 = c <= nl ? __builtin_amdgcn_exp2f(s0[kvh][r] - m) : 0.f, p1 = c + 64 <= nl ? __builtin_amdgcn_exp2f(s1[kvh][r] - m) : 0.f;
                s0[kvh][r] = p0; s1[kvh][r] = p1; sum += p0 + p1; }
        sum += xhalf(sum);
        const float inv = sum > 0.f ? 1.0f / sum : 0.f;
#pragma unroll
        for (int kvh = 0; kvh < 2; ++kvh)
#pragma unroll
            for (int r = 0; r < 16; ++r) { s0[kvh][r] *= inv; s1[kvh][r] *= inv; }
        {
            LAS float* mine = impW + (size_t)(w * 32 + r32) * 33;
            float carry = 0.f;
#pragma unroll
            for (int t = 0; t < 2; ++t)
#pragma unroll
                for (int kvh = 0; kvh < 2; ++kvh)
#pragma unroll
                    for (int q4 = 0; q4 < 4; ++q4) {
                        const f32x16& x = t == 0 ? s0[kvh] : s1[kvh];
                        const float last = x[4 * q4 + 3], s4 = (x[4 * q4] + x[4 * q4 + 1]) + (x[4 * q4 + 2] + last);
                        const float os4 = from_hi(s4), olast = from_hi(last);
                        const int ge = 16 * t + 8 * kvh + 2 * q4;
                        if (hi == 0) { mine[ge] = carry + s4; mine[ge + 1] = os4 + last; }
                        carry = olast;
                    }
            if (hi == 0) mine[32] = carry;
        }
        f32x16 oc[2];
#pragma unroll
        for (int r = 0; r < 16; ++r) { oc[0][r] = 0.f; oc[1][r] = 0.f; }
        bf16x8 pf[4];
        { bf16x8 vfc[8]; v_frags(vfc, lds + L_BUF0 + KBUF, lane); pack_p(pf, s0); pv_regs(oc, vfc, pf); v_frags(vfc, lds + L_BUF1 + KBUF, lane); pack_p(pf, s1); pv_regs(oc, vfc, pf); }
#pragma unroll
        for (int r = 0; r < 16; ++r) { out[0][r] += g_c * oc[0][r]; out[1][r] += g_c * oc[1][r]; }
    }
    __syncthreads();
    {
        const int j = lane & 31, sub = lane >> 5;
#pragma unroll 2
        for (int it = 0; it < 4; ++it) {
            const int pidx = 8 * w + 2 * it + sub, php = pidx >> 5, qq = pidx & 31;
            const int qpp = samp ? TP + pidx : 64 * qt + pidx;
            float v = 0.f;
            if (!(samp && php == 1)) {
#pragma unroll
                for (int x = 0; x < 4; ++x) v += impW[(size_t)((php * 4 + x) * 32 + qq) * 33 + j];
            }
            const int cur = qpp >> 6; const bool valid = 64 * j <= qpp, forced = j == 0 || j == cur || j == cur - 1;
            v = valid ? (forced ? INFINITY : v) : -INFINITY;
            tmpv[w * 64 + lane] = v;
            int rank = 0;
            { f32x4 q8[8];
#pragma unroll
              for (int k8 = 0; k8 < 8; ++k8) q8[k8] = *(const LAS f32x4*)(tmpv + w * 64 + sub * 32 + 4 * k8);
#pragma unroll
              for (int i2 = 0; i2 < 32; ++i2) { const float vi = q8[i2 >> 2][i2 & 3]; rank += (vi > v || (vi == v && i2 < j)) ? 1 : 0; } }
            const unsigned long long bal = __ballot(rank < (samp ? 15 : 16));
            unsigned mk = sub ? (unsigned)(bal >> 32) : (unsigned)bal;
            if (samp && pidx >= TS) mk = 0u;
            if (j == 0) selm[pidx] = mk;
        }
    }
    __syncthreads();
    unsigned um = selm[lane];
#pragma unroll
    for (int o = 32; o > 0; o >>= 1) um |= __shfl_xor(um, o);
    um = __builtin_amdgcn_readfirstlane(um);
    if (!samp) um &= (qt >= 31 ? 0xffffffffu : ((1u << (qt + 1)) - 1u));
    const unsigned mysel = selm[samp ? qi : qoff];
    LAS int* tbase = (LAS int*)(lds + L_TBASE);
    LAS unsigned char* newkv = lds + L_NEW;
    const int nsel = __builtin_popcount(um), nt = nsel + 10;
    if (tid < 32) { if ((um >> tid) & 1u) { const int pos = __builtin_popcount(um & ((1u << tid) - 1u)); tlist[pos] = (1 << 8) | tid; tbase[pos] = (l * NPOOL + tbase[48 + (tid >> 1)]) * 128 + (tid & 1) * 64; } }
    else if (tid < 42) { const int k = tid - 32;
        if (k == 0) { tlist[nsel] = (1 << 8) | 32; tbase[nsel] = -1; }
        else { const int idx = 33 - k; tlist[nsel + k] = (2 << 8) | idx; tbase[nsel + k] = idx == 32 ? -1 : (l * BS + u.b) * 512 + 64 * (idx - 24); } }
    __syncthreads();
    float m_run = 0.f, l_run = 0.f; f32x16 ot[2];
#pragma unroll
    for (int r = 0; r < 16; ++r) { ot[0][r] = 0.f; ot[1][r] = 0.f; }
    int cur_type = 1;
    const int pw = w & 3, kl = lane >> 3, pch = lane & 7;
    const int roff = pw * 8192 + (kl >> 2) * 1024 + (kl & 3) * 256 + pch * 32;
    const unsigned pvo = (unsigned)((lane >> 4) * 256 + (lane & 15) * 4) * 4u;
    auto lent = [&](int j, int& e, int& rb) { const int jj = j < 63 ? j : 63; e = __builtin_amdgcn_readfirstlane(tlist[jj]); rb = __builtin_amdgcn_readfirstlane(tbase[jj]); };
    auto dma_tile = [&](int e, int rb, LAS unsigned char* raw) {
        if (rb < 0) return;
        const int ty = e >> 8;
        const float* base = (ty == 1 ? F.a->cache_sel : F.a->state_win) + ((size_t)(rb + 16 * pw)) * 256 + u.g * 64;
        const unsigned dst = (unsigned)__builtin_amdgcn_readfirstlane((int)((unsigned)(__UINTPTR_TYPE__)raw + (unsigned)pw * 8192u));
#pragma unroll
        for (int q = 0; q < 8; ++q) glds16s(pvo, base + (q & 3) * 4 * 256 + (q >> 2) * 128, dst + 1024u * q);
    };
    struct Staged { u32x4 ka, va, kb, vb; };
    auto fetch = [&](int e, const LAS unsigned char* raw, Staged& S) {
        if ((e & 255) == 32) { const u32x4 z = {0u, 0u, 0u, 0u}; S.ka = z; S.va = z; S.kb = z; S.vb = z;
            if (pw == 0 && kl < TS) { const LAS unsigned char* np = newkv + ((e >> 8) == 1 ? 0 : 1024) + kl * 128 + pch * 16; S.ka = *(const LAS u32x4*)np; S.va = *(const LAS u32x4*)(np + 512); } }
        else { const LAS unsigned char* rp = raw + roff;
            const u32x4 a0 = *(const LAS u32x4*)rp, a1 = *(const LAS u32x4*)(rp + 16), b0 = *(const LAS u32x4*)(rp + 2048), b1 = *(const LAS u32x4*)(rp + 2064);
            const u32x4 c0 = *(const LAS u32x4*)(rp + 4096), c1 = *(const LAS u32x4*)(rp + 4112), d0 = *(const LAS u32x4*)(rp + 6144), d1 = *(const LAS u32x4*)(rp + 6160);
            S.ka = f8_to_bf8(a0, a1); S.kb = f8_to_bf8(b0, b1); S.va = f8_to_bf8(c0, c1); S.vb = f8_to_bf8(d0, d1); }
    };
    auto put = [&](LAS unsigned char* buf, const Staged& S) {
        const int k0 = 16 * pw + kl, k1 = k0 + 8;
        *(LAS u32x4*)(buf + k0 * KROW + pch * 16) = S.ka; *(LAS u32x4*)(buf + k1 * KROW + pch * 16) = S.kb;
        *(LAS u32x4*)(buf + KBUF + (pch >> 2) * 4096 + k0 * 64 + (pch & 3) * 16) = S.va; *(LAS u32x4*)(buf + KBUF + (pch >> 2) * 4096 + k1 * 64 + (pch & 3) * 16) = S.vb; };
    static_assert(8 * 32 * 33 * 4 >= 32768, "third raw slot overlays the importance table (dead after the block selection)");
    auto rawslot = [&](int k3) -> LAS unsigned char* { return lds + (k3 == 0 ? L_RAW0 : (k3 == 1 ? L_RAW1 : L_RAW2)); };
#define SAMP_WAIT(N) do { const int n_ = (N); if (n_ == 2) asm volatile("s_waitcnt vmcnt(16)" ::: "memory"); else if (n_ == 1) asm volatile("s_waitcnt vmcnt(8)" ::: "memory"); else asm volatile("s_waitcnt vmcnt(0)" ::: "memory"); } while (0)
    int e0, b0, e1, b1, e2, b2, e3, b3;
    lent(0, e0, b0); lent(1, e1, b1); lent(2, e2, b2); lent(3, e3, b3);
    if (ph == 1) {
        dma_tile(e0, b0, rawslot(0)); if (nt > 1) dma_tile(e1, b1, rawslot(1)); if (nt > 2) dma_tile(e2, b2, rawslot(2));
        SAMP_WAIT((nt > 1 && b1 >= 0 ? 1 : 0) + (nt > 2 && b2 >= 0 ? 1 : 0));
        Staged S; fetch(e0, rawslot(0), S); put(lds + L_BUF0, S);
        asm volatile("s_waitcnt lgkmcnt(0)" ::: "memory");
    }
    __syncthreads();
    int s1 = 1;
#pragma unroll 1
    for (int i = 0; i < nt; ++i) {
        const int e = e0, type = e >> 8, idx = e & 255;
        const int j4 = i + 4 < 63 ? i + 4 : 63; const int e4v = tlist[j4], b4v = tbase[j4];
        if (ph == 1) {
            const int s0 = s1 == 0 ? 2 : s1 - 1;
            if (i + 3 < nt) dma_tile(e3, b3, rawslot(s0));
            if (i + 1 < nt) {
                SAMP_WAIT((i + 2 < nt && b2 >= 0 ? 1 : 0) + (i + 3 < nt && b3 >= 0 ? 1 : 0));
                Staged S; fetch(e1, rawslot(s1), S);
                put(lds + ((i & 1) ? L_BUF0 : L_BUF1), S);
                asm volatile("s_waitcnt lgkmcnt(0)" ::: "memory"); }
            s1 = s1 == 2 ? 0 : s1 + 1;
        }
        if (active) {
            if (type != cur_type) {
                const float lt = xsum_f(l_run), sc = g_s / lt;
#pragma unroll
                for (int r = 0; r < 16; ++r) { out[0][r] += sc * ot[0][r]; out[1][r] += sc * ot[1][r]; ot[0][r] = 0.f; ot[1][r] = 0.f; }
                m_run = 0.f; l_run = 0.f; cur_type = type;
            }
            const LAS unsigned char* buf = lds + ((i & 1) ? L_BUF1 : L_BUF0);
            bf16x8 kf[8], vf[8];
            kfrags_row(kf, buf, r32, hi); asm volatile("" ::: "memory");
            v_frags(vf, buf + KBUF, lane); asm volatile("" ::: "memory");
            f32x16 s[2];
            float cinit = -m_run; int mode = 0;
            if (type == 1) { if (!(((mysel >> (idx & 31)) & 1u) || idx == 32)) cinit = NEG; mode = idx == 32 ? 1 : 0; }
            else mode = idx == 32 ? 1 : (idx == 24 ? 2 : 0);
            qk_regs(s, kf, qf, cinit);
            if (mode) { int qo_ = qo; asm volatile("" : "+v"(qo_)); edge_mask(s, mode, qo_, hi); }
            int ti = max(__float_as_int(s[0][0]), __float_as_int(s[1][0]));
#pragma unroll
            for (int r = 1; r < 16; ++r) ti = max(ti, max(__float_as_int(s[0][r]), __float_as_int(s[1][r])));
            ti = xmax_i(ti);
            const float tm = __int_as_float(ti);
            if (__any(ti > 0)) {
                const float dl = fmaxf(tm, 0.f), alpha = __builtin_amdgcn_exp2f(-dl);
                m_run += dl; l_run *= alpha;
#pragma unroll
                for (int r = 0; r < 16; ++r) { s[0][r] -= dl; s[1][r] -= dl; ot[0][r] *= alpha; ot[1][r] *= alpha; }
            }
#pragma unroll
            for (int r = 0; r < 16; ++r) { s[0][r] = __builtin_amdgcn_exp2f(s[0][r]); s[1][r] = __builtin_amdgcn_exp2f(s[1][r]); }
            { typedef float f32x2_ __attribute__((ext_vector_type(2)));
              f32x2_ r2 = {0.f, 0.f};
#pragma unroll
              for (int r = 0; r < 16; r += 2) { r2 += (f32x2_){s[0][r], s[0][r + 1]}; r2 += (f32x2_){s[1][r], s[1][r + 1]}; }
              l_run += r2[0] + r2[1]; }
            bf16x8 pf[4]; pack_p(pf, s); pv_regs(ot, vf, pf);
        }
        e0 = e1; b0 = b1; e1 = e2; b1 = b2; e2 = e3; b2 = b3; e3 = __builtin_amdgcn_readfirstlane(e4v); b3 = __builtin_amdgcn_readfirstlane(b4v);
        __syncthreads();
    }
#undef SAMP_WAIT
    if (active) {
        const float lt = xsum_f(l_run), sc = g_w / lt;
#pragma unroll
        for (int r = 0; r < 16; ++r) { out[0][r] += sc * ot[0][r]; out[1][r] += sc * ot[1][r]; }
        if (qvalid) {
            int qrow_ = qrow; asm volatile("" : "+v"(qrow_));
            bf16* op = F_O + (size_t)qrow_ * 512 + h * 64;
#pragma unroll
            for (int dh = 0; dh < 2; ++dh)
#pragma unroll
                for (int q4 = 0; q4 < 4; ++q4) { const u32x2 wv = {cvtpk(out[dh][4 * q4], out[dh][4 * q4 + 1]), cvtpk(out[dh][4 * q4 + 2], out[dh][4 * q4 + 3])};
                    *(u32x2*)(op + 32 * dh + 8 * q4 + 4 * hi) = wv; }
        }
    }
}
constexpr int P_SLOT = 16384, P_IMP = 3 * P_SLOT, P_SELM = P_IMP + 8 * 32 * 33 * 4, P_TMP = P_SELM + 64 * 4, P_LIST = P_TMP + 8 * 64 * 4, P_END = P_LIST + 64 * 4;
DEV void kfrags(bf16x8 (&kf)[8], const LAS unsigned char* kslot, int r32, int hi) {
#pragma unroll
    for (int st = 0; st < 4; ++st)
#pragma unroll
        for (int kvh = 0; kvh < 2; ++kvh) kf[2 * st + kvh] = *(const LAS bf16x8*)(kslot + (2 * st + hi) * 1024 + (32 * kvh + r32) * 16);
}
DEV void qk_regs(f32x16 (&s)[2], const bf16x8 (&kf)[8], const bf16x8 (&qf)[4], float cinit) {
    f32x16 cv, a0, a1;
#pragma unroll
    for (int r = 0; r < 16; ++r) cv[r] = cinit;
    a0 = __builtin_amdgcn_mfma_f32_32x32x16_bf16(kf[0], qf[0], cv, 0, 0, 0); a1 = __builtin_amdgcn_mfma_f32_32x32x16_bf16(kf[1], qf[0], cv, 0, 0, 0);
#pragma unroll
    for (int st = 1; st < 4; ++st) { a0 = __builtin_amdgcn_mfma_f32_32x32x16_bf16(kf[2 * st], qf[st], a0, 0, 0, 0); a1 = __builtin_amdgcn_mfma_f32_32x32x16_bf16(kf[2 * st + 1], qf[st], a1, 0, 0, 0); }
    s[0] = a0; s[1] = a1;
}
DEV void v_frags(bf16x8 (&vf)[8], const LAS unsigned char* vb, int lane) {
    const int g16 = lane >> 4, i = lane & 15, q_ = i >> 2, p_ = i & 3, hi = g16 >> 1, dsub = 16 * (g16 & 1);
    const LAS unsigned char* base = vb + (4 * hi + q_) * 64 + (dsub + 4 * p_) * 2;
#pragma unroll
    for (int dh = 0; dh < 2; ++dh)
#pragma unroll
        for (int st = 0; st < 4; ++st) { const s16x4 lo = vtr(base + dh * 4096 + (16 * st) * 64), hh = vtr(base + dh * 4096 + (16 * st + 8) * 64);
            vf[4 * dh + st] = (bf16x8){lo[0], lo[1], lo[2], lo[3], hh[0], hh[1], hh[2], hh[3]}; }
}
DEV void pv_regs(f32x16 (&o)[2], const bf16x8 (&vf)[8], const bf16x8 (&pf)[4]) {
#pragma unroll
    for (int st = 0; st < 4; ++st)
#pragma unroll
        for (int dh = 0; dh < 2; ++dh) o[dh] = __builtin_amdgcn_mfma_f32_32x32x16_bf16(vf[4 * dh + st], pf[st], o[dh], 0, 0, 0);
}
DEV void dma_k(const Frame& F, const Unit& u, int e, LAS unsigned char* kslot, int w, int lane) {
    const int type = e >> 8, idx = e & 255; const bf16* src;
    if (type == 0) src = F_KCB + ((size_t)(u.b * 2 + u.g) * 128 + 64 * idx + lane) * 64 + w * 8;
    else src = (type == 1 ? F_SKV : F_WKV) + ((size_t)u.b * TP + 64 * idx + lane) * 256 + u.g * 64 + w * 8;
    glds16(src, (unsigned)__builtin_amdgcn_readfirstlane((int)((unsigned)(__UINTPTR_TYPE__)kslot + (unsigned)w * 1024u)));
}
DEV void dma_v(const Frame& F, const Unit& u, int e, LAS unsigned char* vslot, int w, int lane) {
    const int type = e >> 8, idx = e & 255, row = 16 * (w & 3) + (lane >> 2), col = (w >> 2) * 32 + (lane & 3) * 8; const bf16* src;
    if (type == 0) src = F_VCB + ((size_t)(u.b * 2 + u.g) * 128 + 64 * idx + row) * 64 + col;
    else src = (type == 1 ? F_SKV : F_WKV) + ((size_t)u.b * TP + 64 * idx + row) * 256 + 128 + u.g * 64 + col;
    glds16(src, (unsigned)__builtin_amdgcn_readfirstlane((int)((unsigned)(__UINTPTR_TYPE__)vslot + (unsigned)w * 1024u)));
}
#define ATT_WAIT_BAR(N) do { asm volatile("s_waitcnt vmcnt(" #N ") lgkmcnt(0)" ::: "memory"); __builtin_amdgcn_s_barrier(); asm volatile("" ::: "memory"); } while (0)
DEV void attn_unit_p(const Frame& F, const int l, const Unit u) {
    const int tid = F.tid, lane = F.lane, w = F.wave, hh = w & 3, ph = w >> 2, r32 = lane & 31, hi = lane >> 5;
    LAS unsigned char* lds = F.lds;
    LAS float* impW = (LAS float*)(lds + P_IMP); LAS unsigned* selm = (LAS unsigned*)(lds + P_SELM); LAS float* tmpv = (LAS float*)(lds + P_TMP); LAS int* tlist = (LAS int*)(lds + P_LIST);
    const int qt = u.qt, h = u.g * 4 + hh, qoff = 32 * ph + r32, qrow = u.b * TP + 64 * qt + qoff, qp = 64 * qt + qoff;
    dma_k(F, u, 0, lds, w, lane); dma_v(F, u, 0, lds + 8192, w, lane); dma_k(F, u, 1, lds + P_SLOT, w, lane); dma_v(F, u, 1, lds + P_SLOT + 8192, w, lane);
    bf16x8 qf[4];
#pragma unroll
    for (int st = 0; st < 4; ++st) qf[st] = *(const bf16x8*)(F_Q + (size_t)qrow * 512 + h * 64 + 16 * st + 8 * hi);
    const float* gn = F_GN + (size_t)qrow * 24;
    const float g_c = gn[h], g_s = gn[8 + h], g_w = gn[16 + h];
    f32x16 out[2];
#pragma unroll
    for (int r = 0; r < 16; ++r) { out[0][r] = 0.f; out[1][r] = 0.f; }
    ATT_WAIT_BAR(0);
    {
        f32x16 s0[2], s1[2]; bf16x8 kf[8];
        kfrags(kf, lds, r32, hi); qk_regs(s0, kf, qf, 0.f); kfrags(kf, lds + P_SLOT, r32, hi); qk_regs(s1, kf, qf, 0.f);
        int nlim = qp >= 31 ? ((qp - 31) >> 4) : -1; if (nlim > NCMP - 1) nlim = NCMP - 1;
        const int nl = nlim - 4 * hi;
        float m = NEG;
#pragma unroll
        for (int kvh = 0; kvh < 2; ++kvh)
#pragma unroll
            for (int r = 0; r < 16; ++r) { const int c = 32 * kvh + (r & 3) + 8 * (r >> 2); if (c > nl) s0[kvh][r] = NEG; if (c + 64 > nl) s1[kvh][r] = NEG; m = fmaxf(m, fmaxf(s0[kvh][r], s1[kvh][r])); }
        m = fmaxf(m, xhalf(m));
        float sum = 0.f;
#pragma unroll
        for (int kvh = 0; kvh < 2; ++kvh)
#pragma unroll
            for (int r = 0; r < 16; ++r) { const int c = 32 * kvh + (r & 3) + 8 * (r >> 2);
                const float p0 = c <= nl ? __builtin_amdgcn_exp2f(s0[kvh][r] - m) : 0.f, p1 = c + 64 <= nl ? __builtin_amdgcn_exp2f(s1[kvh][r] - m) : 0.f;
                s0[kvh][r] = p0; s1[kvh][r] = p1; sum += p0 + p1; }
        sum += xhalf(sum);
        const float inv = sum > 0.f ? 1.0f / sum : 0.f;
#pragma unroll
        for (int kvh = 0; kvh < 2; ++kvh)
#pragma unroll
            for (int r = 0; r < 16; ++r) { s0[kvh][r] *= inv; s1[kvh][r] *= inv; }
        {
            LAS float* mine = impW + (size_t)(w * 32 + r32) * 33;
            float carry = 0.f;
#pragma unroll
            for (int t = 0; t < 2; ++t)
#pragma unroll
                for (int kvh = 0; kvh < 2; ++kvh)
#pragma unroll
                    for (int q4 = 0; q4 < 4; ++q4) {
                        const f32x16& x = t == 0 ? s0[kvh] : s1[kvh];
                        const float last = x[4 * q4 + 3], s4 = (x[4 * q4] + x[4 * q4 + 1]) + (x[4 * q4 + 2] + last);
                        const float os4 = from_hi(s4), olast = from_hi(last);
                        const int ge = 16 * t + 8 * kvh + 2 * q4;
                        if (hi == 0) { mine[ge] = carry + s4; mine[ge + 1] = os4 + last; }
                        carry = olast;
                    }
            if (hi == 0) mine[32] = carry;
        }
        f32x16 oc[2];
#pragma unroll
        for (int r = 0; r < 16; ++r) { oc[0][r] = 0.f; oc[1][r] = 0.f; }
        bf16x8 pf[4];
        { bf16x8 vfc[8]; v_frags(vfc, lds + 8192, lane); pack_p(pf, s0); pv_regs(oc, vfc, pf); v_frags(vfc, lds + P_SLOT + 8192, lane); pack_p(pf, s1); pv_regs(oc, vfc, pf); }
#pragma unroll
        for (int r = 0; r < 16; ++r) { out[0][r] += g_c * oc[0][r]; out[1][r] += g_c * oc[1][r]; }
    }
    __syncthreads();
    {
        const int j = lane & 31, sub = lane >> 5;
#pragma unroll 2
        for (int it = 0; it < 4; ++it) {
            const int pidx = 8 * w + 2 * it + sub, php = pidx >> 5, qq = pidx & 31, qpp = 64 * qt + pidx;
            float v = 0.f;
#pragma unroll
            for (int x = 0; x < 4; ++x) v += impW[(size_t)((php * 4 + x) * 32 + qq) * 33 + j];
            const int cur = qpp >> 6; const bool valid = 64 * j <= qpp, forced = j == 0 || j == cur || j == cur - 1;
            v = valid ? (forced ? INFINITY : v) : -INFINITY;
            tmpv[w * 64 + lane] = v;
            int rank = 0;
            { f32x4 q8[8];
#pragma unroll
              for (int k8 = 0; k8 < 8; ++k8) q8[k8] = *(const LAS f32x4*)(tmpv + w * 64 + sub * 32 + 4 * k8);
#pragma unroll
              for (int i2 = 0; i2 < 32; ++i2) { const float vi = q8[i2 >> 2][i2 & 3]; rank += (vi > v || (vi == v && i2 < j)) ? 1 : 0; } }
            const unsigned long long bal = __ballot(rank < 16);
            const unsigned mk = sub ? (unsigned)(bal >> 32) : (unsigned)bal;
            if (j == 0) selm[pidx] = mk;
        }
    }
    __syncthreads();
    unsigned um = selm[lane];
#pragma unroll
    for (int o = 32; o > 0; o >>= 1) um |= __shfl_xor(um, o);
    um = __builtin_amdgcn_readfirstlane(um);
    um &= (qt >= 31 ? 0xffffffffu : ((1u << (qt + 1)) - 1u));
    const unsigned mysel = selm[qoff];
    const int nsel = __builtin_popcount(um), nt = nsel + (qt < 8 ? qt + 1 : 9);
    if (tid < 32) { if ((um >> tid) & 1u) tlist[__builtin_popcount(um & ((1u << tid) - 1u))] = (1 << 8) | tid; }
    else if (tid < 41) { const int k = tid - 32; if (qt - k >= 0) tlist[nsel + k] = (2 << 8) | (qt - k); }
    __syncthreads();
    auto slot = [&](int j) -> LAS unsigned char* { return lds + (j % 3) * P_SLOT; };
    auto le = [&](int j) -> int { return tlist[j < nt ? j : nt - 1]; };
    const unsigned kvo = (unsigned)(lane * 256 + w * 8) * 2u, vvo = (unsigned)((16 * (w & 3) + (lane >> 2)) * 256 + (w >> 2) * 32 + (lane & 3) * 8) * 2u;
    auto tile_base = [&](int e_) -> const bf16* { const int e = __builtin_amdgcn_readfirstlane(e_); return ((e >> 8) == 1 ? F_SKV : F_WKV) + ((size_t)u.b * TP + 64 * (e & 255)) * 256 + u.g * 64; };
    auto dmaK = [&](int e_, LAS unsigned char* kslot) { glds16s(kvo, tile_base(e_), (unsigned)__builtin_amdgcn_readfirstlane((int)((unsigned)(__UINTPTR_TYPE__)kslot + (unsigned)w * 1024u))); };
    auto dmaV = [&](int e_, LAS unsigned char* vslot) { glds16s(vvo, tile_base(e_) + 128, (unsigned)__builtin_amdgcn_readfirstlane((int)((unsigned)(__UINTPTR_TYPE__)vslot + (unsigned)w * 1024u))); };
    dmaK(le(0), slot(0)); dmaV(le(0), slot(0) + 8192);
    dmaK(le(1), slot(1)); dmaV(le(1), slot(1) + 8192);
    dmaK(le(2), slot(2));
    float m_run = 0.f, l_run = 0.f; f32x16 ot[2];
#pragma unroll
    for (int r = 0; r < 16; ++r) { ot[0][r] = 0.f; ot[1][r] = 0.f; }
    int cur_type = 1; bool first = true;
    ATT_WAIT_BAR(0);
    bf16x8 kf[8];
    kfrags(kf, slot(0), r32, hi);
    int eA = __builtin_amdgcn_readfirstlane(le(0)), eB = __builtin_amdgcn_readfirstlane(le(1)), eC = __builtin_amdgcn_readfirstlane(le(2)), eD = __builtin_amdgcn_readfirstlane(le(3));
    LAS unsigned char* sl0 = lds; LAS unsigned char* sl1 = lds + P_SLOT; LAS unsigned char* sl2 = lds + 2 * P_SLOT;
#pragma unroll 1
    for (int t = 0; t < nt; ++t) {
        const int e = eA, type = e >> 8, idx = e & 255;
        const int eNv = le(t + 4);
        dmaK(eD, sl0); dmaV(eC, sl2 + 8192);
        if (type != cur_type) {
            const float lt = xsum_f(l_run), scl = g_s / lt;
#pragma unroll
            for (int r = 0; r < 16; ++r) { out[0][r] += scl * ot[0][r]; out[1][r] += scl * ot[1][r]; ot[0][r] = 0.f; ot[1][r] = 0.f; }
            m_run = 0.f; l_run = 0.f; cur_type = type; first = true;
        }
        float cinit = -m_run; int mode = 0;
        if (type == 1) { if (!((mysel >> (idx & 31)) & 1u)) cinit = NEG; mode = idx == qt ? 1 : 0; }
        else mode = idx == qt ? 1 : (idx == qt - 8 ? 2 : 0);
        f32x16 s[2];
        qk_regs(s, kf, qf, cinit);
        bf16x8 vf[8]; v_frags(vf, sl0 + 8192, lane);
        __builtin_amdgcn_sched_barrier(0);
        if (mode) { int qo_ = qoff; asm volatile("" : "+v"(qo_)); edge_mask(s, mode, qo_, hi); }
        float tm;
        if (first) {
            tm = fmaxf(s[0][0], s[1][0]);
#pragma unroll
            for (int r = 1; r < 16; ++r) tm = fmaxf(tm, fmaxf(s[0][r], s[1][r]));
            tm = fmaxf(tm, xhalf(tm));
        } else {
            int ti = max(__float_as_int(s[0][0]), __float_as_int(s[1][0])), tj = max(__float_as_int(s[0][8]), __float_as_int(s[1][8]));
#pragma unroll
            for (int r = 1; r < 8; ++r) { ti = max(ti, max(__float_as_int(s[0][r]), __float_as_int(s[1][r]))); tj = max(tj, max(__float_as_int(s[0][r + 8]), __float_as_int(s[1][r + 8]))); }
            ti = xmax_i(max(ti, tj));
            tm = __int_as_float(ti);
        }
        if (first || __any(tm > 8.f)) {
            const float dl = first ? (tm > -1e29f ? tm : 0.f) : fmaxf(tm, 0.f), alpha = first ? 1.f : __builtin_amdgcn_exp2f(-dl);
            m_run += dl; l_run *= alpha; first = false;
#pragma unroll
            for (int r = 0; r < 16; ++r) { s[0][r] -= dl; s[1][r] -= dl; ot[0][r] *= alpha; ot[1][r] *= alpha; }
        }
#pragma unroll
        for (int r = 0; r < 16; ++r) { s[0][r] = __builtin_amdgcn_exp2f(s[0][r]); s[1][r] = __builtin_amdgcn_exp2f(s[1][r]); }
        { typedef float f32x2_ __attribute__((ext_vector_type(2)));
          f32x2_ r2 = {0.f, 0.f}, r3 = {0.f, 0.f};
#pragma unroll
          for (int r = 0; r < 16; r += 2) { r2 += (f32x2_){s[0][r], s[0][r + 1]}; r3 += (f32x2_){s[1][r], s[1][r + 1]}; }
          r2 += r3; l_run += r2[0] + r2[1]; }
        bf16x8 pf[4]; pack_p(pf, s);
        if (t + 1 < nt) kfrags(kf, sl1, r32, hi);
        pv_regs(ot, vf, pf);
        eA = eB; eB = eC; eC = eD; eD = __builtin_amdgcn_readfirstlane(eNv);
        { LAS unsigned char* t_ = sl0; sl0 = sl1; sl1 = sl2; sl2 = t_; }
        ATT_WAIT_BAR(2);
    }
    asm volatile("s_waitcnt vmcnt(0)" ::: "memory");
    __builtin_amdgcn_s_barrier(); asm volatile("" ::: "memory");
    {
        const float lt = xsum_f(l_run), scl = g_w / lt;
#pragma unroll
        for (int r = 0; r < 16; ++r) { out[0][r] += scl * ot[0][r]; out[1][r] += scl * ot[1][r]; }
        int qrow_ = qrow; asm volatile("" : "+v"(qrow_));
        bf16* op = F_O + (size_t)qrow_ * 512 + h * 64;
#pragma unroll
        for (int dh = 0; dh < 2; ++dh)
#pragma unroll
            for (int q4 = 0; q4 < 4; ++q4) { const u32x2 wv = {cvtpk(out[dh][4 * q4], out[dh][4 * q4 + 1]), cvtpk(out[dh][4 * q4 + 2], out[dh][4 * q4 + 3])};
                *(u32x2*)(op + 32 * dh + 8 * q4 + 4 * hi) = wv; }
    }
}
DEV void attn_phase(const Frame& F, const int l) {
    const int vcu = (F.G % 8 == 0) ? (F.bid % 8) * (F.G / 8) + F.bid / 8 : F.bid;
    for (int pi = vcu; pi < 256; pi += F.G) {
        const int bg = pi >> 4, sidx = pi & 15, where = pi % 3;
#pragma unroll 1
        for (int k = 0; k < 3; ++k) {
            const Frame Fu = launder(F);
            if (k == where) { Unit us; us.samp = 1; us.b = pi >> 1; us.g = pi & 1; us.qt = 0; attn_unit(Fu, l, us); }
            else { const int which = k < where ? k : k - 1; Unit u; u.samp = 0; u.b = bg >> 1; u.g = bg & 1; u.qt = which == 0 ? 31 - sidx : sidx; attn_unit_p(Fu, l, u); }
        }
    }
}
}
DEV void ph_win_copy(const Frame& F, const int l, const int part, const int nparts) {
    constexpr unsigned per = 508u * 256u / 4u, n = (unsigned)BS * per; const unsigned stride = (unsigned)nparts * NTHREADS;
    const f32x4* src0 = (const f32x4*)(F.a->state_win + ((size_t)l * BS * 512 + 4) * 256); f32x4* dst0 = (f32x4*)(F.a->out + OUT_WIN_S + (size_t)l * BS * 512 * 256);
    for (unsigned i0 = (unsigned)part * NTHREADS + (unsigned)F.tid; i0 < n; i0 += 4u * stride) { f32x4 v[4];
#pragma unroll
        for (int q = 0; q < 4; ++q) { const unsigned i = i0 + q * stride; if (i < n) { const unsigned b = i / per, o = i - b * per; v[q] = __builtin_nontemporal_load(src0 + (size_t)b * (512 * 256 / 4) + o); } }
#pragma unroll
        for (int q = 0; q < 4; ++q) { const unsigned i = i0 + q * stride; if (i < n) { const unsigned b = i / per, o = i - b * per; __builtin_nontemporal_store(v[q], dst0 + (size_t)b * (512 * 256 / 4) + o); } } }
}
#define GRID_BAR() do { Frame Fb = launder(F0); int xq_ = xcc; asm volatile("" : "+s"(xq_)); XcdBarrier b_; b_.bar = (unsigned*)(Fb.a->ws + WS_CTL) + CW_BAR; b_.x = (unsigned)xq_; b_.st = (volatile LAS unsigned*)(Fb.lds + LDSCTL_OFF + 64); b_.t0 = Fb.tid == 0; xcd_barrier(b_); } while (0)
template <int l> DEV void run_layer(const Frame& F0, const int xcc, const int lo, const int hi) {
#define IN(k) (lo <= (k) && (k) < hi)
#define SEAM(k) do { if (IN(k) && IN((k) + 1)) GRID_BAR(); } while (0)
        constexpr int P = 1 + 7 * l;
        if (IN(P + 0)) {   Frame F = launder(F0);
            pg8::Gemm g{F_XB, (F_w1 + l * F_wstr), NT, N1, D}; pg8::StaticOrder S; S.init(NT, N1, F.G, F.bid);
            pg8::EpiProj E{l, F.a->ws, F.a->out, (LAS float*)(F.lds + RING_BYTES)};
            pg8::gemm_phase<pg8::EpiProj, pg8::StaticOrder, true, true>(F.lds, g, S, E, F.wave);
#ifdef DUP_G1
            pg8::gemm_phase<pg8::EpiProj, pg8::StaticOrder, true, true>(F.lds, g, S, E, F.wave);
#endif
            { const int nwg = (NT / 256) * (N1 / 256), full = nwg % F.G;
              if (full != 0 && F.bid >= full) ph_win_copy(F, l, F.bid - full, F.G - full);
              else if (full == 0) ph_win_copy(F, l, F.bid, F.G); }
        }
        SEAM(P + 0);
        if (IN(P + 1)) {
#ifdef CONVCMP_SIMPLE
        { Frame F = launder(F0); ph_conv_simple(F, l); }
        { Frame F = launder(F0); ph_compress_simple(F, l); }
#else
        { Frame F = launder(F0); ph_compress(F, l); }
        { Frame F = launder(F0); ph_conv(F, l); }
#ifdef DUP_CC
        __syncthreads();
        { Frame F = launder(F0); ph_compress(F, l); }
        { Frame F = launder(F0); ph_conv(F, l); }
#endif
#endif
        }
        SEAM(P + 1);
#ifdef ATTN_SIMPLE
        if (IN(P + 2)) { Frame F = launder(F0); ph_attn_simple(F, l); }
#else
        if (IN(P + 2)) { Frame F = launder(F0); att::attn_phase(F, l); }
#ifdef DUP_ATTN
        if (IN(P + 2)) { __syncthreads(); Frame F = launder(F0); att::attn_phase(F, l); }
#endif
#endif
        SEAM(P + 2);
        if (IN(P + 3)) {   Frame F = launder(F0);
            pg8::StaticOrder S; S.init(NP, D, F.G, F.bid);
            const bool early = (F.bid >> 3) & 1;
            if (early) { { mini::EpiGate<0> E{F_GM, F_T}; mini::gemm<8, 1>(F, F_CACT, (F_wc + l * F_wstr), DC, E); } { mini::EpiGate<1> E{F_GM, F_T}; mini::gemm<8, 1>(F, F_O, (F_wn + l * F_wstr), 512, E); } __syncthreads(); }
            { pg8::Gemm g{F_CACT, (F_wc + l * F_wstr), NP, D, DC}; pg8::EpiGate<0> E{F_GM, F_T}; pg8::gemm_phase<pg8::EpiGate<0>, pg8::StaticOrder, true, true>(F.lds, g, S, E, F.wave); }
            { pg8::Gemm g{F_O, (F_wn + l * F_wstr), NP, D, 512}; pg8::EpiGate<1> E{F_GM, F_T}; pg8::gemm_phase<pg8::EpiGate<1>, pg8::StaticOrder, true, true>(F.lds, g, S, E, F.wave); }
            if (!early) { { mini::EpiGate<0> E{F_GM, F_T}; mini::gemm<8, 1>(F, F_CACT, (F_wc + l * F_wstr), DC, E); } { mini::EpiGate<1> E{F_GM, F_T}; mini::gemm<8, 1>(F, F_O, (F_wn + l * F_wstr), 512, E); } }
        }
        SEAM(P + 3);
        if (IN(P + 4)) {   Frame F = launder(F0);
            pg8::Gemm g{F_T, (F_wo + l * F_wstr), NP, D, D}; pg8::StaticOrder S; S.init(NP, D, F.G, F.bid);
            const bool early = (F.bid >> 3) & 1;
            if (early) { mini::EpiRes E2{F_X, F_XB, (F_ss + (size_t)(2 * l + 1) * NT * 16), (l == 0 ? F.a->x_sample - (size_t)NP * D : (const float*)F_X), true}; mini::gemm<8, 1>(F, F_T, (F_wo + l * F_wstr), D, E2); __syncthreads(); }
            pg8::EpiRes E{F_X, F_XB, (F_ss + (size_t)(2 * l + 1) * NT * 16), (l == 0 ? F.a->x_prompt : (const float*)F_X), true}; pg8::gemm_phase<pg8::EpiRes, pg8::StaticOrder, true, true>(F.lds, g, S, E, F.wave);
            if (!early) { mini::EpiRes E2{F_X, F_XB, (F_ss + (size_t)(2 * l + 1) * NT * 16), (l == 0 ? F.a->x_sample - (size_t)NP * D : (const float*)F_X), true}; mini::gemm<8, 1>(F, F_T, (F_wo + l * F_wstr), D, E2); }
        }
        SEAM(P + 4);
        if (IN(P + 5)) {   Frame F = launder(F0);
            pg8::Gemm g{F_XB, (F_wup + l * F_wstr), NP, DFF, D}; pg8::StaticOrder S; S.init(NP, DFF, F.G, F.bid);
            const bool early = (F.bid >> 3) & 1;
            if (early) { mini::EpiRelu2 E2{(F_ss + (size_t)(2 * l + 1) * NT * 16), F_HID}; mini::gemm<2, 4>(F, F_XB, (F_wup + l * F_wstr), D, E2); __syncthreads(); }
            pg8::EpiRelu2 E{(F_ss + (size_t)(2 * l + 1) * NT * 16), F_HID, (LAS float*)(F.lds + RING_BYTES)}; pg8::gemm_phase<pg8::EpiRelu2, pg8::StaticOrder, true, true>(F.lds, g, S, E, F.wave);
            if (!early) { mini::EpiRelu2 E2{(F_ss + (size_t)(2 * l + 1) * NT * 16), F_HID}; mini::gemm<2, 4>(F, F_XB, (F_wup + l * F_wstr), D, E2); }
        }
        SEAM(P + 5);
        if (IN(P + 6)) {   Frame F = launder(F0);
            pg8::Gemm g{F_HID, (F_wdn + l * F_wstr), NP, D, DFF}; pg8::StaticOrder S; S.init(NP, D, F.G, F.bid);
            const bool early = (F.bid >> 3) & 1;
            if (early) { mini::EpiRes E2{F_X, F_XB, (F_ss + (size_t)(2 * l + 2) * NT * 16), (const float*)F_X, l == 0}; mini::gemm<8, 1>(F, F_HID, (F_wdn + l * F_wstr), DFF, E2); __syncthreads(); }
            pg8::EpiRes E{F_X, F_XB, (F_ss + (size_t)(2 * l + 2) * NT * 16), (const float*)F_X, l == 0}; pg8::gemm_phase<pg8::EpiRes, pg8::StaticOrder, true, true>(F.lds, g, S, E, F.wave);
            if (!early) { mini::EpiRes E2{F_X, F_XB, (F_ss + (size_t)(2 * l + 2) * NT * 16), (const float*)F_X, l == 0}; mini::gemm<8, 1>(F, F_HID, (F_wdn + l * F_wstr), DFF, E2); }
        }
        SEAM(P + 6);
}
__global__ void __launch_bounds__(NTHREADS, 2) mk_fwd(Args args) {
    extern __shared__ __attribute__((aligned(16))) unsigned char lds[];
    Frame F0; F0.a = (const __attribute__((address_space(4))) Args*)__builtin_amdgcn_kernarg_segment_ptr(); (void)args;
    F0.lds = (LAS unsigned char*)lds; F0.tid = threadIdx.x; F0.lane = F0.tid & 63; F0.wave = __builtin_amdgcn_readfirstlane(F0.tid >> 6); F0.G = gridDim.x; F0.bid = blockIdx.x;
    for (int u = F0.tid; u < (LDS_BYTES - LDSCTL_OFF) / 4; u += NTHREADS) ((LAS unsigned*)(F0.lds + LDSCTL_OFF))[u] = 0u;
    __syncthreads();
    const int lo = args.ph_lo, hi = args.ph_hi;
    int xcc = 0;
    if (hi - lo > 1) { XcdBarrier b0 = xcd_barrier_post((unsigned*)(args.ws + WS_CTL) + CW_BAR, (volatile LAS unsigned*)(F0.lds + LDSCTL_OFF + 64), F0.tid == 0); xcc = __builtin_amdgcn_readfirstlane((int)b0.x); }
    if (IN(0)) { Frame F = launder(F0); p0_prologue(F); }
#ifdef DUP_PRO
    if (IN(0)) { __syncthreads(); Frame F = launder(F0); p0_prologue(F); }
#endif
    SEAM(0);
    run_layer<0>(F0, xcc, lo, hi);
    run_layer<1>(F0, xcc, lo, hi);
#ifdef DBG_STOP
    if (IN(15)) { Frame F = launder(F0);
        if (DBG_STOP == 1) ph_dump(F, F_XB, D, F_XB + 512, D);
        if (DBG_STOP == 2) ph_dump(F, F_U, DC, F_Q, 512);
        if (DBG_STOP == 3) ph_dump(F, F_CACT, DC, F_SKV, 256);
        if (DBG_STOP == 4) ph_dump(F, F_O, 512, F_O, 512);
        if (DBG_STOP == 5) ph_dump(F, F_T, D, F_T + 512, D);
        if (DBG_STOP == 6) ph_dump(F, F_XB, D, F_XB + 512, D);
        if (DBG_STOP == 7) ph_dump(F, F_HID, DFF, F_HID + 2048, DFF);
        if (DBG_STOP == 8) ph_dump(F, F_XB, D, F_XB + 512, D); }
#else
    if (IN(15)) { Frame F = launder(F0); ph_final(F); }
#ifdef DUP_FIN
    if (IN(15)) { Frame F = launder(F0); ph_final(F); }
#endif
#endif
}

extern "C" void kernel_launch(void* const* d_in, const int* in_sizes, int n_in, void* d_out, int out_size, void* d_ws, size_t ws_size, hipStream_t stream) {
    (void)in_sizes; (void)n_in; (void)out_size;
    static int grid = 0;
    if (grid == 0) {
        if (ws_size < WM.end) { fprintf(stderr, "kernel_launch: workspace too small (%zu < %zu)\n", ws_size, (size_t)WM.end); grid = -1; return; }
        int dev = 0, cus = 0, per_cu = 0;
        if (hipGetDevice(&dev) != hipSuccess || hipDeviceGetAttribute(&cus, hipDeviceAttributeMultiprocessorCount, dev) != hipSuccess) { grid = -1; return; }
        if (hipFuncSetAttribute((const void*)mk_fwd, hipFuncAttributeMaxDynamicSharedMemorySize, LDS_BYTES) != hipSuccess) { fprintf(stderr, "kernel_launch: hipFuncSetAttribute failed\n"); grid = -1; return; }
        if (hipOccupancyMaxActiveBlocksPerMultiprocessor(&per_cu, (const void*)mk_fwd, NTHREADS, LDS_BYTES) != hipSuccess || per_cu < 1) { fprintf(stderr, "kernel_launch: occupancy query says %d\n", per_cu); }
        (void)hipGetLastError();
        grid = cus;
    }
    if (grid < 0) return;
    (void)hipMemsetAsync((char*)d_ws + WS_CTL, 0, CTL_ZERO_BYTES, stream);
    Args a{};
    a.x_prompt = (const float*)d_in[0]; a.x_sample = (const float*)d_in[1]; a.cache_cmp = (const float*)d_in[2]; a.cache_sel = (const float*)d_in[3];
    a.state_win = (const float*)d_in[4]; a.state_conv = (const float*)d_in[5]; a.page_table = (const int*)d_in[6];
    a.norm_mix_g = (const float*)d_in[7]; a.w_in = (const float*)d_in[8]; a.dw_w = (const float*)d_in[9]; a.dw_b = (const float*)d_in[10];
    a.ln_g = (const float*)d_in[11]; a.ln_b = (const float*)d_in[12]; a.w_conv_out = (const float*)d_in[13]; a.cmp_pos = (const float*)d_in[14];
    a.w_cmp = (const float*)d_in[15]; a.w_nsa_out = (const float*)d_in[16]; a.w_out = (const float*)d_in[17]; a.norm_mlp_g = (const float*)d_in[18];
    a.w_up = (const float*)d_in[19]; a.w_down = (const float*)d_in[20]; a.norm_final_g = (const float*)d_in[21];
    a.out = (float*)d_out; a.ws = (unsigned char*)d_ws;
#ifndef MK_PER_PHASE
    a.ph_lo = 0; a.ph_hi = 16;
    hipLaunchKernelGGL(mk_fwd, dim3(grid), dim3(NTHREADS), LDS_BYTES, stream, a);
#else
#ifdef DBG_STOP
    for (int ph = 0; ph < 16; ++ph) { if (ph >= DBG_STOP && ph != 15) continue; a.ph_lo = ph; a.ph_hi = ph + 1; hipLaunchKernelGGL(mk_fwd, dim3(grid), dim3(NTHREADS), LDS_BYTES, stream, a); }
    if (0)
#endif
    for (int ph = 0; ph < 16; ++ph) { a.ph_lo = ph; a.ph_hi = ph + 1; hipLaunchKernelGGL(mk_fwd, dim3(grid), dim3(NTHREADS), LDS_BYTES, stream, a); }
#endif
}
```

```cpp
#include <hip/hip_runtime.h>
#include <stdint.h>
#include <math.h>
#include <cstdio>

#define DEV __device__ __forceinline__
#define LAS __attribute__((address_space(3)))
#define GAS __attribute__((address_space(1)))

namespace cfg {
constexpr int D = 1024, BP = 8, TP = 2048, BS = 128, TS = 4, NPAGES = 16, NPOOL = 2560;
constexpr int DC = 512, CK = 31, DFF = 4096, INC = 4376, N1 = 4608;
constexpr int NP = BP * TP, NS = BS * TS, NT = NP + NS, NB = BP + BS, NCMP = 127;
constexpr float EPS = 1e-6f;
constexpr size_t OUT_Y = 0;
constexpr size_t OUT_CMP_P = (size_t)NT * D;
constexpr size_t OUT_CMP_S = OUT_CMP_P + (size_t)2 * NP * 256;
constexpr size_t OUT_SEL_P = OUT_CMP_S + (size_t)2 * NS * 256;
constexpr size_t OUT_SEL_S = OUT_SEL_P + (size_t)2 * NP * 256;
constexpr size_t OUT_WIN_P = OUT_SEL_S + (size_t)2 * NS * 256;
constexpr size_t OUT_WIN_S = OUT_WIN_P + (size_t)2 * BP * 512 * 256;
constexpr size_t OUT_CONV_P = OUT_WIN_S + (size_t)2 * BS * 512 * 256;
constexpr size_t OUT_CONV_S = OUT_CONV_P + (size_t)2 * BP * 30 * 512;
constexpr size_t OUT_TOTAL = OUT_CONV_S + (size_t)2 * BS * 30 * 512;
}
using namespace cfg;
constexpr size_t MiB = 1u << 20;
constexpr size_t WS_CTL = 0, CTL_ZERO_BYTES = 64 * 1024, CTL_BYTES = 8 * MiB;
constexpr int CW_BAR = 4096, CW_SS = 16384;
static_assert((size_t)(CW_SS + 5 * NT * 16) * 4 <= 8 * (size_t)(1u << 20), "ss region");
struct WsMap {
    size_t w1, wc, wn, wo, wup, wdn, wstride, wcmp, cbias, rope, X, XB, U, Q, CKV, SKV, WKV, GN, GM, CACT, KC, VC, KCB, VCB, O, T, HID, end;
};
constexpr size_t al256(size_t b) { return (b + 255) & ~(size_t)255; }
constexpr WsMap ws_map() {
    WsMap m{}; size_t o = CTL_BYTES;
    m.w1 = o; o += al256((size_t)N1 * D * 2); m.wc = o; o += al256((size_t)D * DC * 2); m.wn = o; o += al256((size_t)D * 512 * 2); m.wo = o; o += al256((size_t)D * D * 2);
    m.wup = o; o += al256((size_t)DFF * D * 2); m.wdn = o; o += al256((size_t)D * DFF * 2); m.wstride = o - m.w1; o += m.wstride;
    m.wcmp = o; o += al256((size_t)4 * 128 * 1024 * 2); m.cbias = o; o += al256(4 * 64 * 4); m.rope = o; o += al256((size_t)2052 * 64 * 4);
    m.X = o; o += al256((size_t)NT * D * 4); m.XB = o; o += al256((size_t)NT * D * 2); m.U = o; o += al256((size_t)NT * DC * 2); m.Q = o; o += al256((size_t)NT * 512 * 2);
    m.CKV = o; o += al256((size_t)NT * 256 * 2); m.SKV = o; o += al256((size_t)NT * 256 * 2); m.WKV = o; o += al256((size_t)NT * 256 * 2); m.GN = o; o += al256((size_t)NT * 24 * 4);
    m.GM = o; o += al256((size_t)NT * 2048 * 2); m.CACT = o; o += al256((size_t)NT * DC * 2); m.KC = o; o += al256((size_t)NB * 2 * NCMP * 64 * 4); m.VC = o; o += al256((size_t)NB * 2 * NCMP * 64 * 4); m.KCB = o; o += al256((size_t)NB * 2 * 128 * 64 * 2); m.VCB = o; o += al256((size_t)NB * 2 * 128 * 64 * 2);
    m.O = o; o += al256((size_t)NT * 512 * 2); m.T = o; o += al256((size_t)NT * D * 2); m.HID = o; o += al256((size_t)NT * DFF * 2); m.end = o; return m;
}
constexpr WsMap WM = ws_map();
namespace pg8 {
#define PG8_LAS __attribute__((address_space(3)))
typedef unsigned short bf16_t;
typedef short bf16x8 __attribute__((ext_vector_type(8)));
typedef float f32x4 __attribute__((ext_vector_type(4)));
typedef unsigned u32x4 __attribute__((ext_vector_type(4)));
constexpr int BM = 256, BK = 64, HALF = 128, HTB = HALF * BK * 2  , STAGE_BYTES = 8 * HTB, NXCD = 8, WGM = 8;

__host__ __device__ __forceinline__ int lds_byte(int r, int c) { const int st = (r >> 4) * 2 + (c >> 5), rr = r & 15, cc = c & 31, ob = rr * 64 + cc * 2; return st * 1024 + (ob ^ (((ob >> 9) & 1) << 5)); }
__host__ __device__ __forceinline__ void stage_rc(int b, int& R, int& C) { const int st = b / 1024, sb = b % 1024, swz = sb ^ (((sb >> 9) & 1) << 5); R = (st >> 1) * 16 + swz / 64; C = (st & 1) * 32 + (swz % 64) / 2; }
__host__ __device__ __forceinline__ int perm32(int rho) { const int n = rho >> 4, i = rho & 15; return 8 * (i >> 2) + 4 * n + (i & 3); }

struct Unit { int pm, pn; };
struct Gemm { const bf16_t* A; const bf16_t* Bt; int M, N, K; };

struct StaticOrder {
    int nM, nN, nwg, G, c;
    __host__ __device__ void init(int M, int N, int G_, int c_) { nM = M / BM; nN = N / BM; nwg = nM * nN; G = G_; c = c_; }
    __host__ __device__ bool next(int i, Unit& u) const {
        const long L = (long)i * G + c; if (L >= nwg) return false;
        int wgid = (int)L; { const int q = nwg / NXCD, r = nwg % NXCD, xcd = wgid % NXCD, off = wgid / NXCD; wgid = (xcd < r ? xcd * (q + 1) : r * (q + 1) + (xcd - r) * q) + off; }
        const int nig = WGM * nN, gid = wgid / nig, fm = gid * WGM, gsz = (nM - fm) < WGM ? (nM - fm) : WGM;
        u.pm = fm + ((wgid % nig) % gsz); u.pn = (wgid % nig) / gsz; return true;
    }
    __device__ __forceinline__ void a_ready(const Unit&) const {}
    __device__ __forceinline__ void done(const Unit&) const {}
};
typedef float f32x2_t __attribute__((ext_vector_type(2))); typedef __bf16 bf16x2_t __attribute__((ext_vector_type(2)));
__device__ __forceinline__ unsigned cvt_pk_bf16(float lo, float hi) { const f32x2_t v = {lo, hi}; const bf16x2_t b = __builtin_convertvector(v, bf16x2_t); return __builtin_bit_cast(unsigned, b); }
__device__ __forceinline__ float fsigmoid(float x) { return __builtin_amdgcn_rcpf(1.0f + __builtin_amdgcn_exp2f(-1.4426950408889634f * x)); }
__device__ __forceinline__ u32x4 pack8(f32x4 a, f32x4 b) { u32x4 w; w.x = cvt_pk_bf16(a[0], a[1]); w.y = cvt_pk_bf16(a[2], a[3]); w.z = cvt_pk_bf16(b[0], b[1]); w.w = cvt_pk_bf16(b[2], b[3]); return w; }
__device__ __forceinline__ void unpack8(u32x4 w, f32x4& a, f32x4& b) {
    a[0] = __uint_as_float(w.x << 16); a[1] = __uint_as_float(w.x & 0xffff0000u); a[2] = __uint_as_float(w.y << 16); a[3] = __uint_as_float(w.y & 0xffff0000u);
    b[0] = __uint_as_float(w.z << 16); b[1] = __uint_as_float(w.z & 0xffff0000u); b[2] = __uint_as_float(w.w << 16); b[3] = __uint_as_float(w.w & 0xffff0000u); }
__device__ __forceinline__ float row_rs(const float* ss, int row) {
    const f32x4 a = *(const f32x4*)(ss + (size_t)row * 16), b = *(const f32x4*)(ss + (size_t)row * 16 + 4), c = *(const f32x4*)(ss + (size_t)row * 16 + 8), d = *(const f32x4*)(ss + (size_t)row * 16 + 12);
    const float s = (((a[0] + a[1]) + (a[2] + a[3])) + ((b[0] + b[1]) + (b[2] + b[3]))) + (((c[0] + c[1]) + (c[2] + c[3])) + ((d[0] + d[1]) + (d[2] + d[3])));
    return 1.0f / sqrtf(s * (1.0f / D) + EPS); }

struct EpiProj {
    static constexpr bool PERM = true, AFTER_DRAIN = false;
    int layer; unsigned char* ws; float* out; PG8_LAS float* rsl;
    __device__ __forceinline__ void operator()(const f32x4 (&acc)[2][2][4][2], const Unit& u, int wr, int wc, int fr, int fq) const {
        const int pn = u.pn;
        const float* ss = (const float*)((const unsigned*)(ws + WS_CTL) + CW_SS) + (size_t)(2 * layer) * NT * 16;
        { const int t_ = (wr * 4 + wc) * 64 + fq * 16 + fr;
          if (t_ < BM) rsl[t_] = row_rs(ss, u.pm * BM + t_);
          asm volatile("s_waitcnt lgkmcnt(0)" ::: "memory"); __builtin_amdgcn_s_barrier(); asm volatile("" ::: "memory"); }
#define EP_ROW() const int row = u.pm * BM + ai * HALF + wr * 64 + m * 16 + fr; const float rs = rsl[ai * HALF + wr * 64 + m * 16 + fr]; const bool prompt = row < NP; \
                 const int b = prompt ? (row >> 11) : ((row - NP) >> 2), t = prompt ? (row & 2047) : ((row - NP) & 3), pos = prompt ? t : TP + t; (void)b; (void)pos;
#define EP_LOOP _Pragma("unroll") for (int ai = 0; ai < 2; ++ai) _Pragma("unroll") for (int m = 0; m < 4; ++m)
#define EP_FENCE() do { if (m & 1) asm volatile("" ::: "memory"); } while (0)
        if (pn < 4) {
            bf16_t* U = (bf16_t*)(ws + WM.U);
            EP_LOOP { EP_ROW();
                f32x4 uu[2];
#pragma unroll
                for (int n = 0; n < 2; ++n) { const f32x4 a = acc[ai][0][m][n] * rs, bb = acc[ai][1][m][n] * rs;
#pragma unroll
                    for (int i = 0; i < 4; ++i) uu[n][i] = a[i] * fsigmoid(bb[i]); }
                const int col = 128 * pn + 32 * wc + 8 * fq;
                *(u32x4*)(U + (size_t)row * DC + col) = pack8(uu[0], uu[1]);
                if (prompt) { if (t >= TP - 30) { float* o = out + OUT_CONV_P + ((size_t)(layer * BP + b) * 30 + (t - (TP - 30))) * DC + col; *(f32x4*)o = uu[0]; *(f32x4*)(o + 4) = uu[1]; } }
                else { float* o = out + OUT_CONV_S + ((size_t)(layer * BS + b) * 30 + 26 + t) * DC + col; *(f32x4*)o = uu[0]; *(f32x4*)(o + 4) = uu[1]; }
                EP_FENCE(); }
        } else if (pn < 6 || pn == 7 || pn == 8) {
            const bool isq = pn < 6; const int kv = wc >> 1, g = wc & 1, d0 = 8 * fq; const bool rot = isq || kv == 0;
            const float* rope = (const float*)(ws + WM.rope);
            EP_LOOP { EP_ROW();
                f32x4 o1[2], o2[2];
                const float* rp = rope + (size_t)pos * 64 + d0;
#pragma unroll
                for (int n = 0; n < 2; ++n) { const f32x4 x1 = acc[ai][0][m][n] * rs, x2 = acc[ai][1][m][n] * rs;
                    if (rot) { const f32x4 c = *(const f32x4*)(rp + 4 * n), s = *(const f32x4*)(rp + 32 + 4 * n); o1[n] = x1 * c - x2 * s; o2[n] = x2 * c + x1 * s; }
                    else { o1[n] = x1; o2[n] = x2; } }
                if (isq) { const int h = 4 * (pn - 4) + wc; bf16_t* qp = (bf16_t*)(ws + WM.Q) + (size_t)row * 512 + h * 64 + d0; const float c2 = 0.125f * 1.4426950408889634f;
                    *(u32x4*)qp = pack8(o1[0] * c2, o1[1] * c2); *(u32x4*)(qp + 32) = pack8(o2[0] * c2, o2[1] * c2); }
                else { const int col = kv * 128 + g * 64 + d0; bf16_t* kp = (bf16_t*)(ws + (pn == 7 ? WM.SKV : WM.WKV)) + (size_t)row * 256 + col;
                    *(u32x4*)kp = pack8(o1[0], o1[1]); *(u32x4*)(kp + 32) = pack8(o2[0], o2[1]);
                    float* o = nullptr;
                    if (pn == 7) o = prompt ? out + OUT_SEL_P + ((size_t)layer * NP + row) * 256 + col : out + OUT_SEL_S + ((size_t)layer * NS + (row - NP)) * 256 + col;
                    else if (prompt) { if (t >= TP - 512) o = out + OUT_WIN_P + ((size_t)(layer * BP + b) * 512 + (t - (TP - 512))) * 256 + col; }
                    else o = out + OUT_WIN_S + ((size_t)(layer * BS + b) * 512 + 508 + t) * 256 + col;
                    if (o) { __builtin_nontemporal_store(o1[0], (f32x4*)o); __builtin_nontemporal_store(o1[1], (f32x4*)(o + 4)); __builtin_nontemporal_store(o2[0], (f32x4*)(o + 32)); __builtin_nontemporal_store(o2[1], (f32x4*)(o + 36)); } }
                EP_FENCE(); }
        } else if (pn == 6) {
            bf16_t* CKV = (bf16_t*)(ws + WM.CKV);
            EP_LOOP { EP_ROW();
#pragma unroll
                for (int bj = 0; bj < 2; ++bj) { const int col = 128 * bj + 32 * wc + 8 * fq; const f32x4 v0 = acc[ai][bj][m][0] * rs, v1 = acc[ai][bj][m][1] * rs;
                    *(u32x4*)(CKV + (size_t)row * 256 + col) = pack8(v0, v1);
                    float* o = prompt ? out + OUT_CMP_P + ((size_t)layer * NP + row) * 256 + col : out + OUT_CMP_S + ((size_t)layer * NS + (row - NP)) * 256 + col;
                    __builtin_nontemporal_store(v0, (f32x4*)o); __builtin_nontemporal_store(v1, (f32x4*)(o + 4)); }
                EP_FENCE(); }
        } else if (pn < 17) {
            bf16_t* GM = (bf16_t*)(ws + WM.GM);
            EP_LOOP { EP_ROW();
#pragma unroll
                for (int bj = 0; bj < 2; ++bj) { const int col = (pn - 9) * 256 + 128 * bj + 32 * wc + 8 * fq; f32x4 v0 = acc[ai][bj][m][0] * rs, v1 = acc[ai][bj][m][1] * rs;
#pragma unroll
                    for (int i = 0; i < 4; ++i) { v0[i] = fsigmoid(v0[i]); v1[i] = fsigmoid(v1[i]); }
                    *(u32x4*)(GM + (size_t)row * 2048 + col) = pack8(v0, v1); }
                EP_FENCE(); }
        } else {
            float* GN = (float*)(ws + WM.GN);
            if (wc == 0 && fq < 3) {
                EP_LOOP { EP_ROW();
#pragma unroll
                    for (int n = 0; n < 2; ++n) { f32x4 v = acc[ai][0][m][n] * rs;
#pragma unroll
                        for (int i = 0; i < 4; ++i) v[i] = fsigmoid(v[i]);
                        *(f32x4*)(GN + (size_t)row * 24 + 8 * fq + 4 * n) = v; }
                    EP_FENCE(); }
            }
        }
#undef EP_ROW
#undef EP_LOOP
#undef EP_FENCE
    }
};
struct EpiRelu2 {
    static constexpr bool PERM = true, AFTER_DRAIN = false;
    const float* ss; bf16_t* H; PG8_LAS float* rsl;
    __device__ __forceinline__ void operator()(const f32x4 (&acc)[2][2][4][2], const Unit& u, int wr, int wc, int fr, int fq) const {
        { const int t_ = (wr * 4 + wc) * 64 + fq * 16 + fr;
          if (t_ < BM) rsl[t_] = row_rs(ss, u.pm * BM + t_);
          asm volatile("s_waitcnt lgkmcnt(0)" ::: "memory"); __builtin_amdgcn_s_barrier(); asm volatile("" ::: "memory"); }
#pragma unroll
        for (int ai = 0; ai < 2; ++ai)
#pragma unroll
            for (int m = 0; m < 4; ++m) {
                const int row = u.pm * BM + ai * HALF + wr * 64 + m * 16 + fr; const float rs = rsl[ai * HALF + wr * 64 + m * 16 + fr];
#pragma unroll
                for (int bj = 0; bj < 2; ++bj) { const int col = u.pn * BM + 128 * bj + 32 * wc + 8 * fq; f32x4 v0 = acc[ai][bj][m][0] * rs, v1 = acc[ai][bj][m][1] * rs;
#pragma unroll
                    for (int i = 0; i < 4; ++i) { float a = fmaxf(v0[i], 0.f), c = fmaxf(v1[i], 0.f); v0[i] = a * a; v1[i] = c * c; }
                    *(u32x4*)(H + (size_t)row * DFF + col) = pack8(v0, v1); }
            }
    }
};
template <int MODE> struct EpiGate {
    static constexpr bool PERM = true, AFTER_DRAIN = false;
    const bf16_t* GM; bf16_t* T;
    __device__ __forceinline__ void operator()(const f32x4 (&acc)[2][2][4][2], const Unit& u, int wr, int wc, int fr, int fq) const {
#pragma unroll
        for (int ai = 0; ai < 2; ++ai) {
            u32x4 gq[4][2], tq[4][2];
#pragma unroll
            for (int m = 0; m < 4; ++m)
#pragma unroll
                for (int bj = 0; bj < 2; ++bj) { const int row = u.pm * BM + ai * HALF + wr * 64 + m * 16 + fr, col = u.pn * BM + 128 * bj + 32 * wc + 8 * fq;
                    gq[m][bj] = *(const u32x4*)(GM + (size_t)row * 2048 + MODE * 1024 + col);
                    if (MODE == 1) tq[m][bj] = *(const u32x4*)(T + (size_t)row * D + col); }
#pragma unroll
            for (int m = 0; m < 4; ++m) {
                const int row = u.pm * BM + ai * HALF + wr * 64 + m * 16 + fr;
#pragma unroll
                for (int bj = 0; bj < 2; ++bj) { const int col = u.pn * BM + 128 * bj + 32 * wc + 8 * fq;
                    f32x4 g0, g1; unpack8(gq[m][bj], g0, g1);
                    f32x4 v0 = acc[ai][bj][m][0] * g0, v1 = acc[ai][bj][m][1] * g1;
                    if (MODE == 1) { f32x4 t0, t1; unpack8(tq[m][bj], t0, t1); v0 += t0; v1 += t1; }
                    *(u32x4*)(T + (size_t)row * D + col) = pack8(v0, v1); }
            }
        }
    }
};
struct EpiRes {
    static constexpr bool PERM = true, AFTER_DRAIN = false;
    float* X; bf16_t* XB; float* ssn; const float* Xs; bool wxb;
    __device__ __forceinline__ void operator()(const f32x4 (&acc)[2][2][4][2], const Unit& u, int wr, int wc, int fr, int fq) const {
#pragma unroll
        for (int ai = 0; ai < 2; ++ai) {
            f32x4 xr[4][2][2];
#pragma unroll
            for (int m = 0; m < 4; ++m)
#pragma unroll
                for (int bj = 0; bj < 2; ++bj) { const int row = u.pm * BM + ai * HALF + wr * 64 + m * 16 + fr, col = u.pn * BM + 128 * bj + 32 * wc + 8 * fq; const float* xs = Xs + (size_t)row * D + col;
                    xr[m][bj][0] = *(const f32x4*)xs; xr[m][bj][1] = *(const f32x4*)(xs + 4); }
#pragma unroll
            for (int m = 0; m < 4; ++m) {
                const int row = u.pm * BM + ai * HALF + wr * 64 + m * 16 + fr; float q = 0.f;
#pragma unroll
                for (int bj = 0; bj < 2; ++bj) { const int col = u.pn * BM + 128 * bj + 32 * wc + 8 * fq; float* xp = X + (size_t)row * D + col;
                    const f32x4 x0 = xr[m][bj][0] + acc[ai][bj][m][0], x1 = xr[m][bj][1] + acc[ai][bj][m][1];
                    *(f32x4*)xp = x0; *(f32x4*)(xp + 4) = x1; if (wxb) *(u32x4*)(XB + (size_t)row * D + col) = pack8(x0, x1);
                    q += (x0[0] * x0[0] + x0[1] * x0[1]) + (x0[2] * x0[2] + x0[3] * x0[3]) + (x1[0] * x1[0] + x1[1] * x1[1]) + (x1[2] * x1[2] + x1[3] * x1[3]); }
                q += __shfl_xor(q, 16); q += __shfl_xor(q, 32);
                if (fq == 0) ssn[(size_t)row * 16 + u.pn * 4 + wc] = q;
            }
        }
    }
};
template <class Epi, class Sched, bool ALIGN_EPI = false, bool SP2 = false>
__device__ __forceinline__ void gemm_phase(PG8_LAS unsigned char* lds, const Gemm g, const Sched& S, const Epi& E, const int wave_id) {
    int tid_ = wave_id * 64 + (int)__builtin_amdgcn_mbcnt_hi(~0u, __builtin_amdgcn_mbcnt_lo(~0u, 0u)); asm volatile("" : "+v"(tid_));
    const int tid = tid_, wid = __builtin_amdgcn_readfirstlane(tid >> 6), lane = tid & 63, wr = wid >> 2, wc = wid & 3, fr = lane & 15, fq = lane >> 4;
    const int K = g.K, nt = K / BK;
    unsigned voffA[2], voffB[2];
#pragma unroll
    for (int i = 0; i < 2; ++i) { int R, C; stage_rc(tid * 16 + i * 8192, R, C); const int Rb = Epi::PERM ? ((R & ~31) + perm32(R & 31)) : R;
        voffA[i] = (unsigned)(R * K + C) * 2u; voffB[i] = (unsigned)(Rb * K + C) * 2u; }
    const size_t kstep = (size_t)(BK * 2);
    const size_t hstep = (size_t)HALF * K * 2;
    const size_t tstep = 2 * hstep;
    const unsigned ldsw = (unsigned)wid * 1024u;
    const int aoff = lds_byte(wr * 64 + fr, fq * 8), boff = lds_byte(wc * 32 + fr, fq * 8);
#define PG8_SA(b, h) (((b) * 2 + (h)) * HTB)
#define PG8_SB(b, h) ((4 + (b) * 2 + (h)) * HTB)
#define PG8_STAGE(bufoff, gbase, voff) do { _Pragma("unroll") for (int _i = 0; _i < 2; ++_i) \
        __builtin_amdgcn_global_load_lds((const unsigned*)((const char*)(gbase) + (voff)[_i]), (PG8_LAS unsigned*)(lds + (bufoff) + ldsw + _i * 8192), 16, 0, 0); } while (0)
#define PG8_LDA(dst, b, h) do { _Pragma("unroll") for (int m = 0; m < 4; ++m) _Pragma("unroll") for (int k = 0; k < 2; ++k) dst[m][k] = *(const PG8_LAS bf16x8*)(lds + PG8_SA(b, h) + aoff + m * 2048 + k * 1024); } while (0)
#define PG8_LDB(dst, b, h) do { _Pragma("unroll") for (int n = 0; n < 2; ++n) _Pragma("unroll") for (int k = 0; k < 2; ++k) dst[n][k] = *(const PG8_LAS bf16x8*)(lds + PG8_SB(b, h) + boff + n * 2048 + k * 1024); } while (0)
#define PG8_MMA(ai, bj, At, Bt) do { __builtin_amdgcn_s_setprio(1); _Pragma("unroll") for (int m = 0; m < 4; ++m) _Pragma("unroll") for (int n = 0; n < 2; ++n) _Pragma("unroll") for (int k = 0; k < 2; ++k) \
        acc[ai][bj][m][n] = __builtin_amdgcn_mfma_f32_16x16x32_bf16(Bt[n][k], At[m][k], acc[ai][bj][m][n], 0, 0, 0); __builtin_amdgcn_s_setprio(0); } while (0)
#define PG8_WAIT_V(n) asm volatile("s_waitcnt vmcnt(" #n ")" ::: "memory")
#define PG8_WAIT_L(n) asm volatile("s_waitcnt lgkmcnt(" #n ")" ::: "memory")
#define PG8_BAR __builtin_amdgcn_s_barrier()
#define PG8_SCHED __builtin_amdgcn_sched_barrier(0)
    Unit cur, nxt; int ui = 0;
    if (!S.next(0, cur)) return;
    f32x4 acc[2][2][4][2];
#pragma unroll
    for (int a = 0; a < 2; ++a)
#pragma unroll
        for (int b = 0; b < 2; ++b)
#pragma unroll
            for (int m = 0; m < 4; ++m)
#pragma unroll
                for (int n = 0; n < 2; ++n) acc[a][b][m][n] = (f32x4){0.f, 0.f, 0.f, 0.f};
    bf16x8 At[4][2], B0[2][2], B1[2][2];
    const char* cA = (const char*)g.A + (size_t)cur.pm * tstep; const char* cB = (const char*)g.Bt + (size_t)cur.pn * tstep;
    S.a_ready(cur);
    if constexpr (SP2) {
        PG8_STAGE(PG8_SB(0, 0), cB, voffB); PG8_STAGE(PG8_SB(0, 1), cB + hstep, voffB); PG8_STAGE(PG8_SA(0, 0), cA, voffA); PG8_STAGE(PG8_SA(0, 1), cA + hstep, voffA);
        if (wr == 1) PG8_BAR;
        PG8_WAIT_V(2); PG8_BAR;
        PG8_STAGE(PG8_SB(1, 0), cB + kstep, voffB); PG8_STAGE(PG8_SA(1, 0), cA + kstep, voffA); PG8_STAGE(PG8_SB(1, 1), cB + hstep + kstep, voffB);
        PG8_WAIT_V(6); PG8_BAR;
    } else {
        PG8_STAGE(PG8_SB(0, 0), cB, voffB); PG8_STAGE(PG8_SA(0, 0), cA, voffA); PG8_STAGE(PG8_SB(0, 1), cB + hstep, voffB); PG8_STAGE(PG8_SA(0, 1), cA + hstep, voffA);
        if (wr == 1) PG8_BAR;
        PG8_WAIT_V(4); PG8_BAR;
        PG8_STAGE(PG8_SB(1, 0), cB + kstep, voffB); PG8_STAGE(PG8_SA(1, 0), cA + kstep, voffA); PG8_STAGE(PG8_SB(1, 1), cB + hstep + kstep, voffB);
        PG8_WAIT_V(6); PG8_BAR;
    }
    for (;;) {
        const bool has_next = S.next(ui + 1, nxt);
        const char* nA = has_next ? (const char*)g.A + (size_t)nxt.pm * tstep : cA; const char* nB = has_next ? (const char*)g.Bt + (size_t)nxt.pn * tstep : cB;
        for (int t = 0; t < nt; t += 2) {
            const bool last = (t == nt - 2);
            const char* a1 = cA + (size_t)(t + 1) * kstep;
            const char* a2 = last ? nA : cA + (size_t)(t + 2) * kstep; const char* b2 = last ? nB : cB + (size_t)(t + 2) * kstep;
            const char* a3 = a2 + kstep; const char* b3 = b2 + kstep;
            if (last && has_next) S.a_ready(nxt);
            if constexpr (SP2) {
            PG8_LDB(B0, 0, 0); PG8_LDB(B1, 0, 1); PG8_SCHED; PG8_LDA(At, 0, 0); PG8_STAGE(PG8_SA(1, 1), a1 + hstep, voffA);
            PG8_WAIT_V(8); PG8_WAIT_L(0); PG8_BAR; PG8_MMA(0, 0, At, B0); PG8_MMA(0, 1, At, B1); PG8_BAR; PG8_SCHED;
            PG8_LDA(At, 0, 1); PG8_STAGE(PG8_SB(0, 0), b2, voffB); PG8_STAGE(PG8_SB(0, 1), b2 + hstep, voffB); PG8_STAGE(PG8_SA(0, 0), a2, voffA);
            PG8_WAIT_V(8); PG8_WAIT_L(0); PG8_BAR; PG8_MMA(1, 0, At, B0); PG8_MMA(1, 1, At, B1); PG8_BAR; PG8_SCHED;
            PG8_LDB(B0, 1, 0); PG8_LDB(B1, 1, 1); PG8_SCHED; PG8_LDA(At, 1, 0); PG8_STAGE(PG8_SA(0, 1), a2 + hstep, voffA);
            PG8_WAIT_V(8); PG8_WAIT_L(0); PG8_BAR; PG8_MMA(0, 0, At, B0); PG8_MMA(0, 1, At, B1); PG8_BAR; PG8_SCHED;
            PG8_LDA(At, 1, 1); PG8_STAGE(PG8_SB(1, 0), b3, voffB); PG8_STAGE(PG8_SB(1, 1), b3 + hstep, voffB); PG8_STAGE(PG8_SA(1, 0), a3, voffA);
            PG8_WAIT_V(8); PG8_WAIT_L(0); PG8_BAR; PG8_MMA(1, 0, At, B0); PG8_MMA(1, 1, At, B1); PG8_BAR; PG8_SCHED;
            } else {
            PG8_LDB(B0, 0, 0); PG8_SCHED; PG8_LDA(At, 0, 0); PG8_STAGE(PG8_SA(1, 1), a1 + hstep, voffA);
            PG8_WAIT_L(8); PG8_BAR; PG8_WAIT_L(0); PG8_MMA(0, 0, At, B0); PG8_BAR; PG8_SCHED;
            PG8_LDB(B1, 0, 1); PG8_STAGE(PG8_SB(0, 0), b2, voffB);
            PG8_BAR; PG8_WAIT_L(0); PG8_MMA(0, 1, At, B1); PG8_BAR;
            PG8_LDA(At, 0, 1); PG8_STAGE(PG8_SA(0, 0), a2, voffA);
            PG8_BAR; PG8_WAIT_L(0); PG8_MMA(1, 0, At, B0); PG8_BAR; PG8_SCHED;
            PG8_STAGE(PG8_SB(0, 1), b2 + hstep, voffB);
            PG8_WAIT_V(6); PG8_BAR; PG8_MMA(1, 1, At, B1); PG8_BAR;
            PG8_LDB(B0, 1, 0); PG8_SCHED; PG8_LDA(At, 1, 0); PG8_STAGE(PG8_SA(0, 1), a2 + hstep, voffA);
            PG8_WAIT_L(8); PG8_BAR; PG8_WAIT_L(0); PG8_MMA(0, 0, At, B0); PG8_BAR; PG8_SCHED;
            PG8_LDB(B1, 1, 1); PG8_STAGE(PG8_SB(1, 0), b3, voffB);
            PG8_BAR; PG8_WAIT_L(0); PG8_MMA(0, 1, At, B1); PG8_BAR;
            PG8_LDA(At, 1, 1); PG8_STAGE(PG8_SA(1, 0), a3, voffA);
            PG8_BAR; PG8_WAIT_L(0); PG8_MMA(1, 0, At, B0); PG8_BAR; PG8_SCHED;
            PG8_STAGE(PG8_SB(1, 1), b3 + hstep, voffB);
            PG8_WAIT_V(6); PG8_BAR; PG8_MMA(1, 1, At, B1); PG8_BAR;
            }
        }
        if constexpr (ALIGN_EPI) { if (wr == 0) PG8_BAR; }
        if constexpr (!Epi::AFTER_DRAIN) { E(acc, cur, wr, wc, fr, fq); S.done(cur); }
        if (!has_next) break;
#pragma unroll
        for (int a = 0; a < 2; ++a)
#pragma unroll
            for (int b = 0; b < 2; ++b)
#pragma unroll
                for (int m = 0; m < 4; ++m)
#pragma unroll
                    for (int n = 0; n < 2; ++n) acc[a][b][m][n] = (f32x4){0.f, 0.f, 0.f, 0.f};
        cur = nxt; cA = nA; cB = nB; ++ui;
        if constexpr (ALIGN_EPI) { if (wr == 1) PG8_BAR; }
    }
    PG8_WAIT_V(0);
    if constexpr (!ALIGN_EPI) { if (wr == 0) PG8_BAR; }
    PG8_BAR;
    if constexpr (Epi::AFTER_DRAIN) { E.fused(acc, cur, wr, wc, fr, fq, lds, wid, lane); S.done(cur); }
#undef PG8_SA
#undef PG8_SB
#undef PG8_STAGE
#undef PG8_LDA
#undef PG8_LDB
#undef PG8_MMA
#undef PG8_WAIT_V
#undef PG8_WAIT_L
#undef PG8_BAR
#undef PG8_SCHED
}
}
#define XB_TMO      128
#define XB_XCNT(j)  (256  + 64 * (j))
#define XB_XSUB(j)  (1280 + 64 * (j))
#define XB_XGEN(j)  (2304 + 64 * (j))
#define XB_TOP      3328
#define XB_TOPGEN   3392
#define XCD_BAR_WORDS 3456
#define XB_SPIN_CAP (1u << 22)

__device__ __forceinline__ unsigned xb_ld(unsigned* p)              { return __hip_atomic_load(p, __ATOMIC_RELAXED, __HIP_MEMORY_SCOPE_AGENT); }
__device__ __forceinline__ unsigned xb_add(unsigned* p, unsigned v) { return __hip_atomic_fetch_add(p, v, __ATOMIC_RELAXED, __HIP_MEMORY_SCOPE_AGENT); }
__device__ __forceinline__ unsigned xb_xcc_id() { return (unsigned)__builtin_amdgcn_s_getreg((3 << 11) | 20) & 0xFu; }
#define XB_SPIN(cond, bar) do { unsigned _sp = 0; while (cond) { __builtin_amdgcn_s_sleep(1); \
    if ((++_sp & 255u) == 0u) { if (xb_ld(&(bar)[XB_TMO])) break; if (_sp > XB_SPIN_CAP) { atomicAdd(&(bar)[XB_TMO], 1u); break; } } } } while (0)

struct XcdBarrier {
    unsigned* bar; unsigned x;
    volatile LAS unsigned* st;
    bool t0;
};

__device__ __forceinline__ XcdBarrier xcd_barrier_post(unsigned* bar, volatile LAS unsigned* st, bool t0) {
    XcdBarrier b; b.bar = bar; b.x = xb_xcc_id(); b.st = st; b.t0 = t0;
    if (t0) (void)xb_add(&bar[XB_XCNT(b.x)], 1u);
    return b;
}
__device__ __forceinline__ void xcd_barrier_complete(unsigned* bar, unsigned x, unsigned& nloc, unsigned& nx) {
    const unsigned G = gridDim.x * gridDim.y * gridDim.z;
    unsigned sum, cnt, mine, sp = 0u;
    for (;;) {
        sum = 0u; cnt = 0u; mine = 0u;
#pragma unroll
        for (unsigned j = 0; j < 16; ++j) { const unsigned c = xb_ld(&bar[XB_XCNT(j)]); sum += c; cnt += (c > 0u) ? 1u : 0u; mine = (j == x) ? c : mine; }
        if (sum == G) break;
        __builtin_amdgcn_s_sleep(1);
        if ((++sp & 255u) == 0u) { if (xb_ld(&bar[XB_TMO])) break; if (sp > XB_SPIN_CAP) { atomicAdd(&bar[XB_TMO], 1u); break; } }
    }
    nloc = mine > 0u ? mine : 1u; nx = cnt > 0u ? cnt : 1u;
}

__device__ __forceinline__ void xcd_barrier(const XcdBarrier& b) {
    asm volatile("s_waitcnt vmcnt(0)" ::: "memory");
    __syncthreads();
    if (b.t0) {
        unsigned* bar = b.bar;
        __builtin_amdgcn_s_waitcnt(0);
        unsigned nloc = b.st[0], nx = b.st[1];
        if (nloc == 0u) { xcd_barrier_complete(bar, b.x, nloc, nx); b.st[0] = nloc; b.st[1] = nx; }
        const unsigned old = xb_add(&bar[XB_XSUB(b.x)], 1u);
        const unsigned gen = old / nloc;
        if (old + 1u == (gen + 1u) * nloc) {
            __builtin_amdgcn_fence(__ATOMIC_RELEASE, "agent");
            asm volatile("s_waitcnt vmcnt(0)" ::: "memory");
            const unsigned og = xb_add(&bar[XB_TOP], 1u);
            const unsigned tg = og / nx;
            if (og + 1u == (tg + 1u) * nx) xb_add(&bar[XB_TOPGEN], 1u);
            else XB_SPIN(xb_ld(&bar[XB_TOPGEN]) == tg, bar);
            __builtin_amdgcn_fence(__ATOMIC_ACQUIRE, "agent");
            xb_add(&bar[XB_XGEN(b.x)], 1u);
            asm volatile("s_waitcnt vmcnt(0)" ::: "memory");
        } else {
            XB_SPIN(xb_ld(&bar[XB_XGEN(b.x)]) == gen, bar);
            __builtin_amdgcn_fence(__ATOMIC_ACQUIRE, "agent");
            asm volatile("s_waitcnt vmcnt(0)" ::: "memory");
        }
    }
    __syncthreads();
}
typedef unsigned short bf16;
typedef unsigned v4u __attribute__((ext_vector_type(4)));
typedef float f32x4 __attribute__((ext_vector_type(4)));
constexpr int NWAVES = 8, NTHREADS = 512;
constexpr int LDS_BYTES = 147456, RING_BYTES = 131072, LDSCTL_OFF = LDS_BYTES - 1024;
struct Args {
    const float *x_prompt, *x_sample, *cache_cmp, *cache_sel, *state_win, *state_conv; const int* page_table;
    const float *norm_mix_g, *w_in, *dw_w, *dw_b, *ln_g, *ln_b, *w_conv_out, *cmp_pos, *w_cmp, *w_nsa_out, *w_out, *norm_mlp_g, *w_up, *w_down, *norm_final_g;
    float* out; unsigned char* ws; int ph_lo, ph_hi;
};
struct Frame {
    LAS unsigned char* lds; int tid, lane, wave, G, bid;
    const __attribute__((address_space(4))) Args* a;
};
#define WSP(T, off) ((T*)(F.a->ws + (off)))
#define F_ctl   WSP(unsigned, WS_CTL)
#define F_ss    ((float*)(WSP(unsigned, WS_CTL) + CW_SS))
#define F_w1    WSP(bf16, WM.w1)
#define F_wc    WSP(bf16, WM.wc)
#define F_wn    WSP(bf16, WM.wn)
#define F_wo    WSP(bf16, WM.wo)
#define F_wup   WSP(bf16, WM.wup)
#define F_wdn   WSP(bf16, WM.wdn)
#define F_wstr  (WM.wstride / 2)
#define F_wcmp  WSP(bf16, WM.wcmp)
#define F_cbias WSP(float, WM.cbias)
#define F_rope  WSP(float, WM.rope)
#define F_X     WSP(float, WM.X)
#define F_XB    WSP(bf16, WM.XB)
#define F_U     WSP(bf16, WM.U)
#define F_Q     WSP(bf16, WM.Q)
#define F_CKV   WSP(bf16, WM.CKV)
#define F_SKV   WSP(bf16, WM.SKV)
#define F_WKV   WSP(bf16, WM.WKV)
#define F_GN    WSP(float, WM.GN)
#define F_GM    WSP(bf16, WM.GM)
#define F_CACT  WSP(bf16, WM.CACT)
#define F_KC    WSP(float, WM.KC)
#define F_VC    WSP(float, WM.VC)
#define F_KCB   WSP(bf16, WM.KCB)
#define F_VCB   WSP(bf16, WM.VCB)
#define F_O     WSP(bf16, WM.O)
#define F_T     WSP(bf16, WM.T)
#define F_HID   WSP(bf16, WM.HID)
DEV float bf2f(bf16 v) { return __uint_as_float((unsigned)v << 16); }
DEV unsigned f2bf(float f) { unsigned u = __builtin_bit_cast(unsigned, f); return (u + 0x7fffu + ((u >> 16) & 1u)) >> 16; }
DEV unsigned pk2(float lo, float hi) { return f2bf(lo) | (f2bf(hi) << 16); }
template <int CTRL> DEV float dpp_mov(float v) { return __int_as_float(__builtin_amdgcn_update_dpp(0, __float_as_int(v), CTRL, 0xf, 0xf, false)); }
DEV float wave_sum(float v) {
    { const auto r = __builtin_amdgcn_permlane32_swap(__float_as_uint(v), __float_as_uint(v), false, false); v = __uint_as_float(r[0]) + __uint_as_float(r[1]); }
    v += __shfl_xor(v, 16);
    v += dpp_mov<0x140>(v);
    v += dpp_mov<0x141>(v);
    v += dpp_mov<0x4E>(v);
    v += dpp_mov<0xB1>(v);
    return v;
}
DEV float wave_max(float v) {
#pragma unroll
    for (int o = 32; o > 0; o >>= 1) v = fmaxf(v, __shfl_xor(v, o));
    return v;
}
DEV float sigm(float x) { return 1.0f / (1.0f + expf(-x)); }

DEV void tr_item(const float* W, int K, int N, bf16* WT, int dst_row0, int src_col0, int cnt, const float* ksc, LAS float* scr, int k0, int lane) {
    const int kk8 = lane >> 3, c4 = (lane & 7) * 4;
    f32x4 v[8];
#pragma unroll
    for (int i = 0; i < 8; ++i) { v[i] = (f32x4){0.f, 0.f, 0.f, 0.f}; if (c4 < cnt) v[i] = *(const f32x4*)(W + (size_t)(k0 + 8 * i + kk8) * N + src_col0 + c4); }
#pragma unroll
    for (int i = 0; i < 8; ++i) { const int kk = 8 * i + kk8; f32x4 x = v[i]; if (ksc) x = x * ksc[k0 + kk];
        scr[kk * 33 + c4] = x[0]; scr[kk * 33 + c4 + 1] = x[1]; scr[kk * 33 + c4 + 2] = x[2]; scr[kk * 33 + c4 + 3] = x[3]; }
    asm volatile("s_waitcnt lgkmcnt(0)" ::: "memory");
    const int c8 = lane & 7;
#pragma unroll
    for (int j = 0; j < 4; ++j) { const int n = (lane >> 3) + 8 * j; const LAS float* s = scr + (8 * c8) * 33 + n;
        v4u o; o.x = pk2(s[0 * 33], s[1 * 33]); o.y = pk2(s[2 * 33], s[3 * 33]); o.z = pk2(s[4 * 33], s[5 * 33]); o.w = pk2(s[6 * 33], s[7 * 33]);
        *(v4u*)(WT + (size_t)(dst_row0 + n) * K + k0 + 8 * c8) = o; }
    asm volatile("s_waitcnt lgkmcnt(0)" ::: "memory");
}
DEV void w1_map(int ng, int& src, int& cnt) {
    const int t = ng >> 3, j0 = (ng & 7) * 32, bj = j0 >> 7, jj = j0 & 127; cnt = 32;
    if (t < 4) src = 128 * t + jj + 512 * bj;
    else if (t < 6) src = 1024 + (4 * (t - 4) + (jj >> 5)) * 64 + 32 * bj;
    else if (t == 6) src = 1536 + j0;
    else if (t < 9) { const int seg = jj >> 5; src = 1792 + 256 * (t - 7) + (seg >> 1) * 128 + (seg & 1) * 64 + 32 * bj; }
    else if (t < 17) src = 2328 + (t - 9) * 256 + j0;
    else { src = 2304; cnt = (j0 == 0) ? 24 : 0; }
}
DEV void p0_prologue(Frame& F) {
    LAS float* scr = (LAS float*)(F.lds + F.wave * 16384);
    const int gw = F.bid * NWAVES + F.wave, NGW = F.G * NWAVES, lane = F.lane;
    constexpr int I_W1 = 16 * 144, I_WC = 8 * 32, I_WO = 16 * 32, I_WUP = 16 * 128, I_WDN = 64 * 32, I_L = I_W1 + 2 * I_WC + I_WO + I_WUP + I_WDN, I_CMP = 256;
    for (int it = gw; it < 2 * I_L + I_CMP; it += NGW) {
        if (it >= 2 * I_L) {
            const int r = it - 2 * I_L, lk = r >> 6, lh = (r >> 5) & 1, q = r & 31, kb = q >> 1, nb = q & 1;
            tr_item(F.a->w_cmp + ((size_t)lk * 32 + 16 * lh) * 4096, 1024, 64, F_wcmp + (size_t)lk * 128 * 1024, lh * 64 + nb * 32, nb * 32, 32, nullptr, scr, kb * 64, lane);
            continue;
        }
        const int l = it / I_L; int r = it % I_L;
        if (r < I_W1) { const int kb = r / 144, ng = r % 144; int src, cnt; w1_map(ng, src, cnt);
            tr_item(F.a->w_in + (size_t)l * D * INC, D, INC, (F_w1 + l * F_wstr), ng * 32, src, cnt, F.a->norm_mix_g + l * D, scr, kb * 64, lane); continue; } r -= I_W1;
        if (r < I_WC) { tr_item(F.a->w_conv_out + (size_t)l * DC * D, DC, D, (F_wc + l * F_wstr), (r % 32) * 32, (r % 32) * 32, 32, nullptr, scr, (r / 32) * 64, lane); continue; } r -= I_WC;
        if (r < I_WC) { tr_item(F.a->w_nsa_out + (size_t)l * 512 * D, 512, D, (F_wn + l * F_wstr), (r % 32) * 32, (r % 32) * 32, 32, nullptr, scr, (r / 32) * 64, lane); continue; } r -= I_WC;
        if (r < I_WO) { tr_item(F.a->w_out + (size_t)l * D * D, D, D, (F_wo + l * F_wstr), (r % 32) * 32, (r % 32) * 32, 32, nullptr, scr, (r / 32) * 64, lane); continue; } r -= I_WO;
        if (r < I_WUP) { tr_item(F.a->w_up + (size_t)l * D * DFF, D, DFF, (F_wup + l * F_wstr), (r % 128) * 32, (r % 128) * 32, 32, F.a->norm_mlp_g + l * D, scr, (r / 128) * 64, lane); continue; } r -= I_WUP;
        tr_item(F.a->w_down + (size_t)l * DFF * D, DFF, D, (F_wdn + l * F_wstr), (r % 32) * 32, (r % 32) * 32, 32, nullptr, scr, (r / 32) * 64, lane);
    }
    __syncthreads();
    if (F.bid < 4) { const float* W = F.a->w_cmp + (size_t)F.bid * 32 * 4096; const float* PE = F.a->cmp_pos + (size_t)F.bid * 2048; LAS float* part = (LAS float*)F.lds;
        float a0 = 0.f, a1 = 0.f, a2 = 0.f, a3 = 0.f;
#pragma unroll 4
        for (int k = 256 * F.wave; k < 256 * F.wave + 256; k += 4) { a0 += PE[k] * W[(size_t)k * 64 + lane]; a1 += PE[k + 1] * W[(size_t)(k + 1) * 64 + lane]; a2 += PE[k + 2] * W[(size_t)(k + 2) * 64 + lane]; a3 += PE[k + 3] * W[(size_t)(k + 3) * 64 + lane]; }
        part[F.wave * 64 + lane] = (a0 + a1) + (a2 + a3);
        __syncthreads();
        if (F.wave == 0) { float s = 0.f;
#pragma unroll
            for (int w2 = 0; w2 < 8; ++w2) s += part[w2 * 64 + lane];
            F_cbias[F.bid * 64 + lane] = s; } }
    for (int idx = F.bid * NTHREADS + F.tid; idx < 2052 * 32; idx += F.G * NTHREADS) { const int pos = idx >> 5, i = idx & 31;
        const double ang = (double)pos * pow(10000.0, -(double)i / 32.0);
        F_rope[pos * 64 + i] = (float)cos(ang); F_rope[pos * 64 + 32 + i] = (float)sin(ang); }
    for (int r = (F.G > 4 ? gw - 4 * NWAVES : gw); r < NT && (F.G <= 4 || F.bid >= 4); r += (F.G > 4 ? NGW - 4 * NWAVES : NGW)) {
        const float* src = r < NP ? F.a->x_prompt + (size_t)r * D : F.a->x_sample + (size_t)(r - NP) * D; float q = 0.f;
#pragma unroll
        for (int j = 0; j < 4; ++j) { const f32x4 v = *(const f32x4*)(src + j * 256 + lane * 4);
            unsigned long long w = (unsigned long long)pk2(v[0], v[1]) | ((unsigned long long)pk2(v[2], v[3]) << 32); *(unsigned long long*)(F_XB + (size_t)r * D + j * 256 + lane * 4) = w;
            q += (v[0] * v[0] + v[1] * v[1]) + (v[2] * v[2] + v[3] * v[3]); }
        q = wave_sum(q); if (lane < 16) F_ss[(size_t)r * 16 + lane] = lane == 0 ? q : 0.f;
    }
    { const unsigned stride = (unsigned)F.G * NTHREADS;
      constexpr unsigned per2 = 26u * DC / 4u, n2 = 2u * BS * per2;
      for (unsigned i = (unsigned)F.bid * NTHREADS + (unsigned)F.tid; i < n2; i += stride) { const unsigned lb = i / per2, o = i - lb * per2;
          ((f32x4*)(F.a->out + OUT_CONV_S + (size_t)lb * 30 * DC))[o] = ((const f32x4*)(F.a->state_conv + ((size_t)lb * 30 + 4) * DC))[o]; } }
}

DEV void ph_conv_simple(Frame& F, int l) {
    LAS float* red = (LAS float*)F.lds;
    const int c = F.tid;
    for (int r = F.bid; r < NT; r += F.G) {
        const bool prompt = r < NP; const int b = prompt ? r / TP : (r - NP) / TS, t = prompt ? r % TP : (r - NP) % TS;
        float a = F.a->dw_b[l * DC + c];
        for (int k = 0; k < CK; ++k) { float v;
            if (prompt) { const int tt = t + k - 30; v = tt >= 0 ? bf2f(F_U[((size_t)b * TP + tt) * DC + c]) : 0.f; }
            else { const int j = t + k; v = j < 30 ? F.a->state_conv[((size_t)(l * BS + b) * 30 + j) * DC + c] : bf2f(F_U[((size_t)NP + b * TS + (j - 30)) * DC + c]); }
            a += v * F.a->dw_w[((size_t)l * CK + k) * DC + c]; }
        float s = wave_sum(a);
        __syncthreads();
        if (F.lane == 0) red[F.wave] = s;
        __syncthreads();
        float mean = 0.f;
#pragma unroll
        for (int w = 0; w < 8; ++w) mean += red[w];
        mean *= (1.0f / DC);
        const float d = a - mean; float q = wave_sum(d * d);
        if (F.lane == 0) red[8 + F.wave] = q;
        __syncthreads();
        float var = 0.f;
#pragma unroll
        for (int w = 0; w < 8; ++w) var += red[8 + w];
        var *= (1.0f / DC);
        const float y = d * (1.0f / sqrtf(var + EPS)) * F.a->ln_g[l * DC + c] + F.a->ln_b[l * DC + c];
        F_CACT[(size_t)r * DC + c] = (bf16)f2bf(y * sigm(y));
    }
}
DEV void ph_compress_simple(Frame& F, int l) {
    LAS float* R = (LAS float*)F.lds;
    const int e = F.lane, j = F.wave;
    for (int blk = F.bid; blk < NB * 2 * 2 * 16; blk += F.G) {
        const int i = blk & 15, kv = (blk >> 4) & 1, g = (blk >> 5) & 1, bi = blk >> 6; const bool prompt = bi < BP;
        __syncthreads();
        for (int row = j; row < 144; row += NWAVES) { const int pos = 128 * i + row; float v = 0.f;
            if (pos < 2048) { if (prompt) v = bf2f(F_CKV[((size_t)bi * TP + pos) * 256 + kv * 128 + g * 64 + e]);
                else { const int b = bi - BP, page = F.a->page_table[b * NPAGES + (pos >> 7)]; v = F.a->cache_cmp[(((size_t)l * NPOOL + page) * 128 + (pos & 127)) * 256 + kv * 128 + g * 64 + e]; } }
            R[row * 64 + e] = v; }
        __syncthreads();
        const float* W = F.a->w_cmp + (size_t)(l * 2 + kv) * 32 * 4096;
        float acc = F_cbias[(l * 2 + kv) * 64 + e];
        for (int ll = 0; ll < 16; ++ll)
            for (int d = 0; d < 64; ++d) acc += R[(j * 16 + ll) * 64 + d] * W[(size_t)(ll * 64 + d) * 64 + e] + R[((j + 1) * 16 + ll) * 64 + d] * W[(size_t)((16 + ll) * 64 + d) * 64 + e];
        const int n = 8 * i + j;
        if (kv == 0) { int cpos = 16 * n + 31; if (cpos > 2051) cpos = 2051; const int dd = e & 31; const float c = F_rope[cpos * 64 + dd], s = F_rope[cpos * 64 + 32 + dd];
            const float other = __shfl_xor(acc, 32); acc = e < 32 ? acc * c - other * s : acc * c + other * s; }
        if (n < NCMP) (kv == 0 ? F_KC : F_VC)[((size_t)(bi * 2 + g) * NCMP + n) * 64 + e] = acc;
        (kv == 0 ? F_KCB : F_VCB)[((size_t)(bi * 2 + g) * 128 + n) * 64 + e] = (bf16)(n < NCMP ? f2bf(acc) : 0u);
    }
}
struct RowSrc { const void* p; int isbf; };
DEV RowSrc row_src(const Frame& F, int mode, int l, bool prompt, int b, int bi, int g, int qp, int blkj, int t, int ln, int kv, bool& ok) {
    RowSrc r; r.isbf = 1;
    if (mode == 0) { int n = t * 64 + ln; ok = n < NCMP && 16 * n + 31 <= qp; if (n > 126) n = 126; r.p = (kv ? F_VCB : F_KCB) + ((size_t)(bi * 2 + g) * 128 + n) * 64; return r; }
    if (mode == 1) { const int kpos = 64 * blkj + ln; ok = kpos <= qp;
        if (prompt) { r.p = F_SKV + ((size_t)b * TP + kpos) * 256 + kv * 128 + g * 64; return r; }
        if (blkj < 32) { const int page = F.a->page_table[b * NPAGES + (kpos >> 7)]; r.isbf = 0; r.p = F.a->cache_sel + (((size_t)l * NPOOL + page) * 128 + (kpos & 127)) * 256 + kv * 128 + g * 64; return r; }
        int ii = kpos - TP; if (ii > 3) ii = 3; r.p = F_SKV + ((size_t)NP + b * TS + ii) * 256 + kv * 128 + g * 64; return r; }
    int kpos = qp - 511 + 64 * t + ln; ok = kpos >= 0; if (kpos < 0) kpos = 0;
    if (prompt) { r.p = F_WKV + ((size_t)b * TP + kpos) * 256 + kv * 128 + g * 64; return r; }
    if (kpos < TP) { r.isbf = 0; r.p = F.a->state_win + ((size_t)(l * BS + b) * 512 + (kpos - (TP - 512))) * 256 + kv * 128 + g * 64; return r; }
    r.p = F_WKV + ((size_t)NP + b * TS + (kpos - TP)) * 256 + kv * 128 + g * 64; return r;
}
DEV float row_elem(RowSrc s, int src_lane, int lane) {
    const unsigned long long v = (unsigned long long)s.p; const unsigned lo = __shfl((unsigned)v, src_lane), hi = __shfl((unsigned)(v >> 32), src_lane); const int isbf = __shfl(s.isbf, src_lane);
    const void* p = (const void*)(((unsigned long long)hi << 32) | lo);
    return isbf ? bf2f(((const bf16*)p)[lane]) : ((const float*)p)[lane];
}
DEV void ph_attn_simple(Frame& F, int l) {
    const int lane = F.lane, w = F.wave;
    if (w >= 4) return;
    LAS float* base = (LAS float*)(F.lds + w * 34816);
    LAS float* Ks = base;
    LAS float* qs = base + 64 * 65;
    LAS float* pcs = qs + 256;
    LAS float* sS = pcs + 128;
    LAS int* sel = (LAS int*)(sS + 4096);
    for (int item = F.bid * 4 + w; item < NT * 2; item += F.G * 4) {
        const int r = item >> 1, g = item & 1; const bool prompt = r < NP;
        const int b = prompt ? r / TP : (r - NP) / TS, tq = prompt ? r % TP : (r - NP) % TS, qp = prompt ? tq : TP + tq, bi = prompt ? b : BP + b;
#pragma unroll
        for (int hh = 0; hh < 4; ++hh) qs[hh * 64 + lane] = bf2f(F_Q[(size_t)r * 512 + (g * 4 + hh) * 64 + lane]);
        float ofin[4] = {0.f, 0.f, 0.f, 0.f}; const float* gn = F_GN + (size_t)r * 24;
        for (int mode = 0; mode < 3; ++mode) {
            const int T = mode == 0 ? 2 : (mode == 1 ? 16 : 8); unsigned okm = 0;
            for (int t = 0; t < T; ++t) {
                bool ok; const int bj = mode == 1 ? sel[t] : 0;
                const RowSrc kp = row_src(F, mode, l, prompt, b, bi, g, qp, bj, t, lane, 0, ok); if (ok) okm |= 1u << t;
                for (int i = 0; i < 64; ++i) Ks[i * 65 + lane] = row_elem(kp, i, lane);
                for (int hh = 0; hh < 4; ++hh) { float a = 0.f; for (int d = 0; d < 64; ++d) a += qs[hh * 64 + d] * Ks[lane * 65 + d]; sS[(t * 4 + hh) * 64 + lane] = ok ? a : -1e30f; }
            }
            for (int hh = 0; hh < 4; ++hh) {
                float m = -1e30f; for (int t = 0; t < T; ++t) m = fmaxf(m, sS[(t * 4 + hh) * 64 + lane]);
                m = wave_max(m); float sum = 0.f;
                for (int t = 0; t < T; ++t) { const float pv = ((okm >> t) & 1u) ? exp2f(sS[(t * 4 + hh) * 64 + lane] - m) : 0.f; sS[(t * 4 + hh) * 64 + lane] = pv; sum += pv; }
                sum = wave_sum(sum); const float inv = 1.0f / fmaxf(sum, 1e-30f);
                for (int t = 0; t < T; ++t) sS[(t * 4 + hh) * 64 + lane] *= inv;
            }
            float o[4] = {0.f, 0.f, 0.f, 0.f};
            for (int t = 0; t < T; ++t) {
                bool ok; const int bj = mode == 1 ? sel[t] : 0;
                const RowSrc vp = row_src(F, mode, l, prompt, b, bi, g, qp, bj, t, lane, 1, ok);
                for (int i = 0; i < 64; ++i) { const float v = row_elem(vp, i, lane);
#pragma unroll
                    for (int hh = 0; hh < 4; ++hh) o[hh] += sS[(t * 4 + hh) * 64 + i] * v; }
            }
#pragma unroll
            for (int hh = 0; hh < 4; ++hh) ofin[hh] += gn[mode * 8 + g * 4 + hh] * o[hh];
            if (mode == 0) {
                pcs[lane] = sS[lane] + sS[64 + lane] + sS[128 + lane] + sS[192 + lane];
                pcs[64 + lane] = sS[256 + lane] + sS[320 + lane] + sS[384 + lane] + sS[448 + lane];
                const int nsel = prompt ? 32 : 33, cur = qp >> 6; float imp = 0.f;
                for (int n = 4 * lane - 1; n <= 4 * lane + 3; ++n) if (n >= 0 && n < NCMP && lane < nsel) imp += pcs[n];
                const bool valid = lane < nsel && 64 * lane <= qp, forced = lane == 0 || lane == cur || lane == cur - 1;
                imp = valid ? (forced ? INFINITY : imp) : -INFINITY;
                bool cand = lane < nsel;
                for (int k = 0; k < 16; ++k) { const float m = wave_max(cand ? imp : -INFINITY); const unsigned long long bal = __ballot(cand && imp == m); const int jj = __ffsll((long long)bal) - 1;
                    if (lane == 0) sel[k] = jj; if (lane == jj) cand = false; }
            }
        }
#pragma unroll
        for (int hh = 0; hh < 4; ++hh) { const int h = g * 4 + hh; F_O[(size_t)r * 512 + h * 64 + lane] = (bf16)f2bf(ofin[hh]); }
    }
}
DEV void ph_dump(Frame& F, const bf16* A, int lda, const bf16* B, int ldb) {
    const int gw = F.bid * NWAVES + F.wave, NGW = F.G * NWAVES, lane = F.lane;
    for (int r = gw; r < NT; r += NGW) for (int c = lane; c < 512; c += 64) { F.a->out[OUT_Y + (size_t)r * D + c] = bf2f(A[(size_t)r * lda + c]); F.a->out[OUT_Y + (size_t)r * D + 512 + c] = bf2f(B[(size_t)r * ldb + c]); }
}
DEV void ph_final(Frame& F) {
    const int gw = F.bid * NWAVES + F.wave, NGW = F.G * NWAVES, lane = F.lane; const float* ss = F_ss + (size_t)4 * NT * 16;
    const bool poison = __hip_atomic_load(F_ctl + CW_BAR + XB_TMO, __ATOMIC_RELAXED, __HIP_MEMORY_SCOPE_AGENT) != 0u;
    for (int r = gw; r < NT; r += NGW) { const float rs = poison ? __builtin_nanf("") : pg8::row_rs(ss, r);
#pragma unroll
        for (int j = 0; j < 4; ++j) { const f32x4 v = *(const f32x4*)(F_X + (size_t)r * D + j * 256 + lane * 4), gv = *(const f32x4*)(F.a->norm_final_g + j * 256 + lane * 4);
            __builtin_nontemporal_store(v * rs * gv, (f32x4*)(F.a->out + OUT_Y + (size_t)r * D + j * 256 + lane * 4)); } }
}

DEV Frame launder(const Frame& F0) {
    Frame F; int z = 0; asm volatile("s_mov_b32 %0, 0" : "=s"(z));
    F.wave = F0.wave; F.lane = (int)__builtin_amdgcn_mbcnt_hi(~0u, __builtin_amdgcn_mbcnt_lo(~0u, 0u)) + z; F.tid = F.wave * 64 + F.lane; F.G = F0.G; F.bid = F0.bid; F.lds = F0.lds + z;
    F.a = (const __attribute__((address_space(4))) Args*)((const __attribute__((address_space(4))) char*)__builtin_amdgcn_kernarg_segment_ptr() + z);
    return F;
}
namespace mini {
typedef short bf16x8 __attribute__((ext_vector_type(8)));
template <int KS, int NS, class Epi>
DEV void gemm(const Frame& F, const bf16* A, const bf16* Bt, const int K, const Epi& epi) {
    static_assert(KS * NS == 8, "eight waves");
    constexpr int NC = 64 * NS;
    constexpr int NCG = (NS == 1) ? 16 : 16;
    LAS float* part = (LAS float*)F.lds;
    const int lane = F.lane, w = F.wave, kq = w % KS, nq = w / KS, m = lane & 15, kg = lane >> 4;
    for (int slab = F.bid; slab < 16 * NCG; slab += F.G) {
        const int mi = slab / NCG, ni = slab % NCG, row0 = NP + 32 * mi, col0 = NC * ni;
        f32x4 acc[2][4];
#pragma unroll
        for (int rt = 0; rt < 2; ++rt)
#pragma unroll
            for (int ct = 0; ct < 4; ++ct) acc[rt][ct] = (f32x4){0.f, 0.f, 0.f, 0.f};
        const int klen = K / KS, kbeg = kq * klen;
        const bf16* ap = A + (size_t)(row0 + m) * K + kbeg + 8 * kg; const bf16* bp = Bt + (size_t)(col0 + 64 * nq + m) * K + kbeg + 8 * kg;
#pragma unroll 4
        for (int k = 0; k < klen; k += 32) {
            bf16x8 a[2], b[4];
#pragma unroll
            for (int rt = 0; rt < 2; ++rt) a[rt] = *(const bf16x8*)(ap + (size_t)(16 * rt) * K + k);
#pragma unroll
            for (int ct = 0; ct < 4; ++ct) b[ct] = *(const bf16x8*)(bp + (size_t)(16 * ct) * K + k);
#pragma unroll
            for (int rt = 0; rt < 2; ++rt)
#pragma unroll
                for (int ct = 0; ct < 4; ++ct) acc[rt][ct] = __builtin_amdgcn_mfma_f32_16x16x32_bf16(a[rt], b[ct], acc[rt][ct], 0, 0, 0);
        }
        __syncthreads();
#pragma unroll
        for (int rt = 0; rt < 2; ++rt)
#pragma unroll
            for (int ct = 0; ct < 4; ++ct)
#pragma unroll
                for (int rg = 0; rg < 4; ++rg) part[(size_t)(kq * 32 + 16 * rt + 4 * kg + rg) * NC + 64 * nq + 16 * ct + m] = acc[rt][ct][rg];
        __syncthreads();
        for (int o = F.tid; o < 32 * NC / 4; o += NTHREADS) { const int row = o / (NC / 4), c4 = (o % (NC / 4)) * 4; f32x4 v = *(const LAS f32x4*)(part + (size_t)row * NC + c4);
#pragma unroll
            for (int q = 1; q < KS; ++q) v += *(const LAS f32x4*)(part + (size_t)(q * 32 + row) * NC + c4);
            epi(row0 + row, col0 + c4, v, o); }
    }
}
DEV unsigned long long pack4(f32x4 v) { return (unsigned long long)pg8::cvt_pk_bf16(v[0], v[1]) | ((unsigned long long)pg8::cvt_pk_bf16(v[2], v[3]) << 32); }
DEV f32x4 unpack4(unsigned long long w) { f32x4 v; v[0] = __uint_as_float((unsigned)w << 16); v[1] = __uint_as_float((unsigned)w & 0xffff0000u); v[2] = __uint_as_float((unsigned)(w >> 32) << 16); v[3] = __uint_as_float((unsigned)(w >> 32) & 0xffff0000u); return v; }
template <int MODE> struct EpiGate { const bf16* GM; bf16* T;
    DEV void operator()(int row, int col, f32x4 v, int) const { const f32x4 g = unpack4(*(const unsigned long long*)(GM + (size_t)row * 2048 + MODE * 1024 + col)); f32x4 o = v * g;
        if (MODE == 1) o += unpack4(*(const unsigned long long*)(T + (size_t)row * D + col));
        *(unsigned long long*)(T + (size_t)row * D + col) = pack4(o); } };
struct EpiRes { float* X; bf16* XB; float* ssn; const float* Xs; bool wxb;
    DEV void operator()(int row, int col, f32x4 v, int) const { float* xp = X + (size_t)row * D + col; const f32x4 x = *(const f32x4*)(Xs + (size_t)row * D + col) + v; *(f32x4*)xp = x; if (wxb) *(unsigned long long*)(XB + (size_t)row * D + col) = pack4(x);
        float q = (x[0] * x[0] + x[1] * x[1]) + (x[2] * x[2] + x[3] * x[3]);
        q += __shfl_xor(q, 1); q += __shfl_xor(q, 2); q += __shfl_xor(q, 4); q += __shfl_xor(q, 8);
        if ((col & 63) == 0) ssn[(size_t)row * 16 + (col >> 6)] = q; } };
struct EpiRelu2 { const float* ss; bf16* H;
    DEV void operator()(int row, int col, f32x4 v, int) const { const float rs = pg8::row_rs(ss, row); f32x4 o;
#pragma unroll
        for (int i = 0; i < 4; ++i) { const float a = fmaxf(v[i] * rs, 0.f); o[i] = a * a; }
        *(unsigned long long*)(H + (size_t)row * DFF + col) = pack4(o); } };
}
DEV int queue_next(const Frame& F, unsigned* ctr) {
    LAS int* slot = (LAS int*)(F.lds + LDSCTL_OFF + 128);
    __syncthreads();
    if (F.tid == 0) *slot = (int)__hip_atomic_fetch_add(ctr, 1u, __ATOMIC_RELAXED, __HIP_MEMORY_SCOPE_AGENT);
    __syncthreads();
    return *slot;
}
DEV void ph_conv(const Frame& F, const int l) {
    typedef unsigned u32x4v __attribute__((ext_vector_type(4)));
    LAS bf16* us = (LAS bf16*)F.lds;
    LAS float* os = (LAS float*)(F.lds + 63488);
    const int c = F.tid, lane = F.lane, wv = F.wave;
    float w[CK];
#pragma unroll
    for (int k = 0; k < CK; ++k) w[k] = F.a->dw_w[((size_t)l * CK + k) * DC + c];
    const float bias = F.a->dw_b[l * DC + c];
    const f32x4 g0 = *(const f32x4*)(F.a->ln_g + l * DC + lane * 8), g1 = *(const f32x4*)(F.a->ln_g + l * DC + lane * 8 + 4), b0v = *(const f32x4*)(F.a->ln_b + l * DC + lane * 8), b1v = *(const f32x4*)(F.a->ln_b + l * DC + lane * 8 + 4);
    unsigned* qctr = F_ctl + 8192 + (l * 2 + 1) * 64;
    for (int item = queue_next(F, qctr); item < NP / 32 + BS / 2; item = queue_next(F, qctr)) {
        const bool prompt = item < NP / 32;
        const int r0 = prompt ? item * 32 : NP + (item - NP / 32) * 8, ntok = prompt ? 32 : 8;
        __syncthreads();
        if (prompt) {
            const int b = r0 >> 11, t0 = r0 & 2047;
            u32x4v stg[8];
#pragma unroll
            for (int q = 0; q < 8; ++q) { const int i = F.tid + q * NTHREADS, row = i >> 6, ch = i & 63, tt = t0 - 30 + row; stg[q] = (u32x4v){0u, 0u, 0u, 0u};
                if (i < 62 * 64 && tt >= 0) stg[q] = *(const u32x4v*)(F_U + ((size_t)b * TP + tt) * DC + ch * 8); }
#pragma unroll
            for (int q = 0; q < 8; ++q) { const int i = F.tid + q * NTHREADS, row = i >> 6, ch = i & 63; if (i < 62 * 64) *(LAS u32x4v*)(us + row * 512 + ch * 8) = stg[q]; }
            __syncthreads();
#pragma unroll 1
            for (int tc = 0; tc < 4; ++tc) {
                float a8[8];
#pragma unroll
                for (int t = 0; t < 8; ++t) a8[t] = bias;
#pragma unroll
                for (int i = 0; i < 38; ++i) { const float x = bf2f(us[(8 * tc + i) * 512 + c]);
#pragma unroll
                    for (int t = 0; t < 8; ++t) if (i - t >= 0 && i - t <= 30) a8[t] += x * w[i - t]; }
#pragma unroll
                for (int t = 0; t < 8; ++t) os[(8 * tc + t) * 512 + c] = a8[t];
            }
        } else {
            const int b0 = (r0 - NP) >> 2;
#pragma unroll 1
            for (int bb = 0; bb < 2; ++bb) { const int b = b0 + bb; float x[34];
#pragma unroll
                for (int j = 0; j < 30; ++j) x[j] = F.a->state_conv[((size_t)(l * BS + b) * 30 + j) * DC + c];
#pragma unroll
                for (int j = 0; j < 4; ++j) x[30 + j] = bf2f(F_U[((size_t)NP + b * TS + j) * DC + c]);
#pragma unroll
                for (int t = 0; t < 4; ++t) { float o = bias;
#pragma unroll
                    for (int k = 0; k < CK; ++k) o += x[t + k] * w[k];
                    os[(4 * bb + t) * 512 + c] = o; } }
        }
        __syncthreads();
        for (int t = wv; t < ntok; t += NWAVES) {
            const f32x4 v0 = *(const LAS f32x4*)(os + t * 512 + lane * 8), v1 = *(const LAS f32x4*)(os + t * 512 + lane * 8 + 4);
            const float mean = wave_sum((v0[0] + v0[1]) + (v0[2] + v0[3]) + (v1[0] + v1[1]) + (v1[2] + v1[3])) * (1.0f / DC);
            const f32x4 d0 = v0 - mean, d1 = v1 - mean;
            const float var = wave_sum((d0[0] * d0[0] + d0[1] * d0[1]) + (d0[2] * d0[2] + d0[3] * d0[3]) + (d1[0] * d1[0] + d1[1] * d1[1]) + (d1[2] * d1[2] + d1[3] * d1[3])) * (1.0f / DC);
            const float rs = 1.0f / sqrtf(var + EPS);
            f32x4 y0 = d0 * rs * g0 + b0v, y1 = d1 * rs * g1 + b1v;
#pragma unroll
            for (int i = 0; i < 4; ++i) { y0[i] = y0[i] * pg8::fsigmoid(y0[i]); y1[i] = y1[i] * pg8::fsigmoid(y1[i]); }
            *(u32x4v*)(F_CACT + (size_t)(r0 + t) * DC + lane * 8) = pg8::pack8(y0, y1); }
    }
}
DEV void ph_compress(const Frame& F, const int l) {
    typedef short bf16x8 __attribute__((ext_vector_type(8)));
    typedef unsigned u32x4v __attribute__((ext_vector_type(4)));
    constexpr int BROW = 272, BBUF = 128 * BROW;
    LAS unsigned char* bs = F.lds;
    LAS float* p1s = (LAS float*)(F.lds + 2 * BBUF);
    const int tid = F.tid, lane = F.lane, wv = F.wave, m = lane & 15, kg = lane >> 4;
    const int chunk = 16 * wv + m;
    unsigned* qctr = F_ctl + 8192 + (l * 2 + 0) * 64;
    for (int it = queue_next(F, qctr); it < NB * 4; it = queue_next(F, qctr)) {
        const int item = it < BS * 4 ? it + BP * 4 : it - BS * 4;
        const int kv = item & 1, g = (item >> 1) & 1, bi = item >> 2; const bool prompt = bi < BP;
        const bf16* Wt = F_wcmp + (size_t)(l * 2 + kv) * 128 * 1024;
        f32x4 acc[8];
#pragma unroll
        for (int q = 0; q < 8; ++q) acc[q] = (f32x4){0.f, 0.f, 0.f, 0.f};
        u32x4v ra[3][4][2];
        const bf16* pa = nullptr; const float* sa = nullptr;
        if (prompt) pa = F_CKV + ((size_t)bi * TP + 16 * chunk) * 256 + kv * 128 + g * 64 + 8 * kg;
        else { const int b = bi - BP, page = F.a->page_table[b * NPAGES + (chunk >> 3)]; sa = F.a->cache_cmp + (((size_t)l * NPOOL + page) * 128 + 16 * (chunk & 7)) * 256 + kv * 128 + g * 64 + 8 * kg; }
        auto load_a = [&](int st, int ks) {
#pragma unroll
            for (int q = 0; q < 4; ++q) { const int ll = 2 * ks + (q >> 1), d0 = (q & 1) * 32;
                if (prompt) ra[st][q][0] = *(const u32x4v*)(pa + (size_t)ll * 256 + d0);
                else { ra[st][q][0] = __builtin_nontemporal_load((const u32x4v*)(sa + (size_t)ll * 256 + d0)); ra[st][q][1] = __builtin_nontemporal_load((const u32x4v*)(sa + (size_t)ll * 256 + d0 + 4)); } }
        };
        auto frag_a = [&](int st, int q) -> bf16x8 {
            u32x4v x = ra[st][q][0];
            if (!prompt) { const u32x4v a = ra[st][q][0], b2 = ra[st][q][1];
                x.x = pg8::cvt_pk_bf16(__uint_as_float(a.x), __uint_as_float(a.y)); x.y = pg8::cvt_pk_bf16(__uint_as_float(a.z), __uint_as_float(a.w));
                x.z = pg8::cvt_pk_bf16(__uint_as_float(b2.x), __uint_as_float(b2.y)); x.w = pg8::cvt_pk_bf16(__uint_as_float(b2.z), __uint_as_float(b2.w)); }
            return __builtin_bit_cast(bf16x8, x);
        };
        u32x4v rb[4];
        auto load_b = [&](int ks) {
#pragma unroll
            for (int i = 0; i < 4; ++i) { const int q = tid + i * NTHREADS, e = q >> 4, ch = q & 15; rb[i] = *(const u32x4v*)(Wt + (size_t)e * 1024 + ks * 128 + ch * 8); }
        };
        auto store_b = [&](int buf) {
#pragma unroll
            for (int i = 0; i < 4; ++i) { const int q = tid + i * NTHREADS, e = q >> 4, ch = q & 15; *(LAS u32x4v*)(bs + buf * BBUF + e * BROW + ch * 16) = rb[i]; }
        };
        __syncthreads();
        load_b(0); load_a(0, 0); load_a(1, 1); load_a(2, 2); store_b(0);
        __syncthreads();
#pragma unroll
        for (int ks = 0; ks < 8; ++ks) { const int st = ks % 3;
            if (ks + 1 < 8) load_b(ks + 1);
            const LAS unsigned char* bb = bs + (ks & 1) * BBUF;
            bf16x8 af[4];
#pragma unroll
            for (int q = 0; q < 4; ++q) af[q] = frag_a(st, q);
            if (ks + 3 < 8) load_a(st, ks + 3);
#pragma unroll
            for (int q = 0; q < 4; ++q)
#pragma unroll
                for (int nt = 0; nt < 8; ++nt) { const bf16x8 bf = *(const LAS bf16x8*)(bb + (16 * nt + m) * BROW + (q * 32 + 8 * kg) * 2);
                    acc[nt] = __builtin_amdgcn_mfma_f32_16x16x32_bf16(af[q], bf, acc[nt], 0, 0, 0); }
            if (ks + 1 < 8) store_b((ks + 1) & 1);
            __syncthreads();
        }
#pragma unroll
        for (int rg = 0; rg < 4; ++rg)
#pragma unroll
            for (int nt = 0; nt < 4; ++nt) p1s[(size_t)(16 * wv + 4 * kg + rg) * 64 + 16 * nt + m] = acc[4 + nt][rg];
        __syncthreads();
        bf16* dst = (kv == 0 ? F_KCB : F_VCB) + (size_t)(bi * 2 + g) * 128 * 64;
#pragma unroll
        for (int rg = 0; rg < 4; ++rg) { const int nn = 16 * wv + 4 * kg + rg; float v[4];
#pragma unroll
            for (int nt = 0; nt < 4; ++nt) v[nt] = acc[nt][rg] + (nn < NCMP ? p1s[(size_t)(nn + 1) * 64 + 16 * nt + m] : 0.f) + F_cbias[(l * 2 + kv) * 64 + 16 * nt + m];
            if (kv == 0) { const int pos = 16 * nn + 31 < 2052 ? 16 * nn + 31 : 2051;
#pragma unroll
                for (int nt = 0; nt < 2; ++nt) { const float cs = F_rope[(size_t)pos * 64 + 16 * nt + m], sn = F_rope[(size_t)pos * 64 + 32 + 16 * nt + m]; const float x1 = v[nt], x2 = v[nt + 2]; v[nt] = x1 * cs - x2 * sn; v[nt + 2] = x2 * cs + x1 * sn; } }
#pragma unroll
            for (int nt = 0; nt < 4; ++nt) dst[(size_t)nn * 64 + 16 * nt + m] = (bf16)(nn < NCMP ? f2bf(v[nt]) : 0u); }
    }
}
namespace att {
typedef short bf16x8 __attribute__((ext_vector_type(8)));
typedef short s16x4 __attribute__((ext_vector_type(4)));
typedef float f32x16 __attribute__((ext_vector_type(16)));
typedef unsigned u32x4 __attribute__((ext_vector_type(4)));
typedef unsigned u32x2 __attribute__((ext_vector_type(2)));
constexpr int KROW = 144, KBUF = 64 * KROW, VBUF = 8192, TBUF = KBUF + VBUF;
constexpr int L_BUF0 = 0, L_BUF1 = TBUF, L_IMP = 2 * TBUF, L_SELM = L_IMP + 8 * 32 * 33 * 4, L_TMP = L_SELM + 64 * 4, L_LIST = L_TMP + 8 * 64 * 4, L_TBASE = L_LIST + 64 * 4, L_END = L_TBASE + 64 * 4,
              L_RAW0 = L_END, L_RAW1 = L_RAW0 + 32768, L_RAW2 = L_IMP, L_NEW = L_RAW1 + 32768, L_END2 = L_NEW + 2048;
constexpr float NEG = -1e30f;
constexpr float C2 = 0.125f * 1.4426950408889634f;
DEV int crow(int r, int hi) { return (r & 3) + 8 * (r >> 2) + 4 * hi; }
DEV unsigned cvtpk(float lo, float hi) { return pg8::cvt_pk_bf16(lo, hi); }
DEV float xhalf(float v) { return __shfl_xor(v, 32); }
DEV float from_hi(float v) { const auto r = __builtin_amdgcn_permlane32_swap(__float_as_uint(v), __float_as_uint(v), false, false); return __uint_as_float(r[1]); }
DEV int xmax_i(int v) { const auto r = __builtin_amdgcn_permlane32_swap((unsigned)v, (unsigned)v, false, false); return max((int)r[0], (int)r[1]); }
DEV float xsum_f(float v) { const auto r = __builtin_amdgcn_permlane32_swap(__float_as_uint(v), __float_as_uint(v), false, false); return __uint_as_float(r[0]) + __uint_as_float(r[1]); }

struct Unit { int samp, b, g, qt; };
struct TileRegs { u32x4 k0, k1, v0, v1; int isf32; };

DEV void tile_load(TileRegs& R, const Frame& F, int l, const Unit& u, int type, int idx, int key, int chunk, int rowbase = -1) {
    R.isf32 = 0; const u32x4 z = {0u, 0u, 0u, 0u}; R.k0 = z; R.k1 = z; R.v0 = z; R.v1 = z;
    const int bi = u.samp ? BP + u.b : u.b;
    if (type == 0) {
        const bf16* kp = F_KCB + ((size_t)(bi * 2 + u.g) * 128 + 64 * idx + key) * 64 + chunk * 8; const bf16* vp = F_VCB + ((size_t)(bi * 2 + u.g) * 128 + 64 * idx + key) * 64 + chunk * 8;
        R.k0 = *(const u32x4*)kp; R.v0 = *(const u32x4*)vp; return;
    }
    if (!u.samp) {
        const bf16* p = (type == 1 ? F_SKV : F_WKV) + ((size_t)u.b * TP + 64 * idx + key) * 256 + u.g * 64 + chunk * 8;
        R.k0 = *(const u32x4*)p; R.v0 = *(const u32x4*)(p + 128); return;
    }
    if (idx == 32) {
        if (key < TS) { const bf16* p = (type == 1 ? F_SKV : F_WKV) + ((size_t)NP + u.b * TS + key) * 256 + u.g * 64 + chunk * 8; R.k0 = *(const u32x4*)p; R.v0 = *(const u32x4*)(p + 128); }
        return;
    }
    const float* p;
    if (type == 1) { int rb = rowbase; if (rb < 0) { const int page = F.a->page_table[u.b * NPAGES + (idx >> 1)]; rb = (l * NPOOL + page) * 128 + (idx & 1) * 64; }
        p = F.a->cache_sel + ((size_t)rb + key) * 256 + u.g * 64 + chunk * 8; }
    else p = F.a->state_win + ((size_t)(l * BS + u.b) * 512 + 64 * (idx - 24) + key) * 256 + u.g * 64 + chunk * 8;
    R.isf32 = 1; R.k0 = *(const u32x4*)p; R.k1 = *(const u32x4*)(p + 4); R.v0 = *(const u32x4*)(p + 128); R.v1 = *(const u32x4*)(p + 132);
}
DEV u32x4 f8_to_bf8(u32x4 a, u32x4 b) { u32x4 o; o.x = cvtpk(__uint_as_float(a.x), __uint_as_float(a.y)); o.y = cvtpk(__uint_as_float(a.z), __uint_as_float(a.w)); o.z = cvtpk(__uint_as_float(b.x), __uint_as_float(b.y)); o.w = cvtpk(__uint_as_float(b.z), __uint_as_float(b.w)); return o; }
DEV void tile_store(const TileRegs& R, LAS unsigned char* buf, int key, int chunk) {
    u32x4 k = R.k0, v = R.v0;
    if (R.isf32) { k = f8_to_bf8(R.k0, R.k1); v = f8_to_bf8(R.v0, R.v1); }
    *(LAS u32x4*)(buf + key * KROW + chunk * 16) = k;
    *(LAS u32x4*)(buf + KBUF + (chunk >> 2) * 4096 + key * 64 + (chunk & 3) * 16) = v;
}
DEV void qk_tile(f32x16 (&s)[2], const LAS unsigned char* kb, const bf16x8 (&qf)[4], float cinit, int r32, int hi) {
#pragma unroll
    for (int kvh = 0; kvh < 2; ++kvh) {
        f32x16 a;
#pragma unroll
        for (int r = 0; r < 16; ++r) a[r] = cinit;
#pragma unroll
        for (int st = 0; st < 4; ++st) { const bf16x8 kf = *(const LAS bf16x8*)(kb + (32 * kvh + r32) * KROW + (16 * st + 8 * hi) * 2); a = __builtin_amdgcn_mfma_f32_32x32x16_bf16(kf, qf[st], a, 0, 0, 0); }
        s[kvh] = a;
    }
}
typedef short v4i16_t __attribute__((ext_vector_type(4)));
DEV s16x4 vtr(const LAS unsigned char* p) { return __builtin_bit_cast(s16x4, __builtin_amdgcn_ds_read_tr16_b64_v4i16((LAS v4i16_t*)p)); }
DEV void pv_tile(f32x16 (&o)[2], const LAS unsigned char* vb, const bf16x8 (&pf)[4], int lane) {
    const int g16 = lane >> 4, i = lane & 15, q_ = i >> 2, p_ = i & 3, hi = g16 >> 1, dsub = 16 * (g16 & 1);
    const LAS unsigned char* base = vb + (4 * hi + q_) * 64 + (dsub + 4 * p_) * 2;
#pragma unroll
    for (int dh = 0; dh < 2; ++dh)
#pragma unroll
        for (int st = 0; st < 4; ++st) { const s16x4 lo = vtr(base + dh * 4096 + (16 * st) * 64), hh = vtr(base + dh * 4096 + (16 * st + 8) * 64);
            const bf16x8 vf = {lo[0], lo[1], lo[2], lo[3], hh[0], hh[1], hh[2], hh[3]};
            o[dh] = __builtin_amdgcn_mfma_f32_32x32x16_bf16(vf, pf[st], o[dh], 0, 0, 0); }
}
DEV void pack_p(bf16x8 (&pf)[4], const f32x16 (&p)[2]) {
#pragma unroll
    for (int st = 0; st < 4; ++st) { const f32x16& x = p[st >> 1]; const int r0 = 8 * (st & 1);
        const u32x4 w = {cvtpk(x[r0], x[r0 + 1]), cvtpk(x[r0 + 2], x[r0 + 3]), cvtpk(x[r0 + 4], x[r0 + 5]), cvtpk(x[r0 + 6], x[r0 + 7])};
        pf[st] = __builtin_bit_cast(bf16x8, w); }
}
DEV void edge_mask(f32x16 (&s)[2], int mode, int qoff, int hi) {
    const int qs = qoff - 4 * hi;
#pragma unroll
    for (int kvh = 0; kvh < 2; ++kvh)
#pragma unroll
        for (int r = 0; r < 16; ++r) { const int c = 32 * kvh + (r & 3) + 8 * (r >> 2); const bool keep = mode == 1 ? (c <= qs) : (c > qs); if (!keep) s[kvh][r] = NEG; }
}

DEV void kfrags_row(bf16x8 (&kf)[8], const LAS unsigned char* kb, int r32, int hi) {
#pragma unroll
    for (int st = 0; st < 4; ++st)
#pragma unroll
        for (int kvh = 0; kvh < 2; ++kvh) kf[2 * st + kvh] = *(const LAS bf16x8*)(kb + (32 * kvh + r32) * KROW + 32 * st + 16 * hi);
}
DEV void qk_regs(f32x16 (&s)[2], const bf16x8 (&kf)[8], const bf16x8 (&qf)[4], float cinit);
DEV void v_frags(bf16x8 (&vf)[8], const LAS unsigned char* vb, int lane);
DEV void pv_regs(f32x16 (&o)[2], const bf16x8 (&vf)[8], const bf16x8 (&pf)[4]);
DEV void glds16(const void* gsrc, unsigned lds_dst) { unsigned keep;
    asm volatile("s_mov_b32 %0, m0\n\ts_mov_b32 m0, %2\n\ts_nop 0\n\tglobal_load_lds_dwordx4 %1, off\n\ts_mov_b32 m0, %0" : "=&s"(keep) : "v"(gsrc), "s"(lds_dst) : "memory"); }
DEV void glds16s(unsigned voff, const void* sbase, unsigned lds_dst) { unsigned keep;
    asm volatile("s_mov_b32 %0, m0\n\ts_mov_b32 m0, %3\n\ts_nop 0\n\tglobal_load_lds_dwordx4 %1, %2\n\ts_mov_b32 m0, %0" : "=&s"(keep) : "v"(voff), "s"(sbase), "s"(lds_dst) : "memory"); }
static_assert(L_END2 <= LDSCTL_OFF, "sample-unit LDS");
DEV void attn_unit(const Frame& F, const int l, const Unit u) {
    const int tid = F.tid, lane = F.lane, w = F.wave, hh = w & 3, ph = w >> 2, r32 = lane & 31, hi = lane >> 5;
    const int key = tid >> 3, chunk = tid & 7;
    LAS unsigned char* lds = F.lds;
    LAS float* impW = (LAS float*)(lds + L_IMP); LAS unsigned* selm = (LAS unsigned*)(lds + L_SELM); LAS float* tmpv = (LAS float*)(lds + L_TMP); LAS int* tlist = (LAS int*)(lds + L_LIST);
    const int samp = u.samp, qt = u.qt, h = u.g * 4 + hh;
    const int qoff = 32 * ph + r32;
    const int qi = samp ? (r32 < TS ? r32 : TS - 1) : qoff;
    const int qrow = samp ? NP + u.b * TS + qi : u.b * TP + 64 * qt + qi;
    const int qp = samp ? TP + qi : 64 * qt + qi;
    const int qo = samp ? qi : qoff;
    const bool active = !(samp && ph == 1);
    const bool qvalid = samp ? (ph == 0 && r32 < TS) : true;
    bf16x8 qf[4];
#pragma unroll
    for (int st = 0; st < 4; ++st) qf[st] = *(const bf16x8*)(F_Q + (size_t)qrow * 512 + h * 64 + 16 * st + 8 * hi);
    const float* gn = F_GN + (size_t)qrow * 24;
    const float g_c = gn[h], g_s = gn[8 + h], g_w = gn[16 + h];
    f32x16 out[2];
#pragma unroll
    for (int r = 0; r < 16; ++r) { out[0][r] = 0.f; out[1][r] = 0.f; }
    TileRegs R, R2;
    tile_load(R, F, l, u, 0, 0, key, chunk); tile_load(R2, F, l, u, 0, 1, key, chunk);
    if (tid >= 128 && tid < 144) ((LAS int*)(lds + L_TBASE))[48 + tid - 128] = F.a->page_table[u.b * NPAGES + tid - 128];
    if (tid >= 64 && tid < 128) { const int t2 = tid - 64, ty = t2 >> 5, k4 = (t2 >> 3) & 3, ch = t2 & 7;
        const bf16* p = (ty == 0 ? F_SKV : F_WKV) + ((size_t)NP + u.b * TS + k4) * 256 + u.g * 64 + ch * 8;
        *(LAS u32x4*)(lds + L_NEW + ty * 1024 + k4 * 128 + ch * 16) = *(const u32x4*)p;
        *(LAS u32x4*)(lds + L_NEW + ty * 1024 + 512 + k4 * 128 + ch * 16) = *(const u32x4*)(p + 128); }
    tile_store(R, lds + L_BUF0, key, chunk); tile_store(R2, lds + L_BUF1, key, chunk);
    __syncthreads();
    if (active) {
        f32x16 s0[2], s1[2];
        { bf16x8 kfc[8]; kfrags_row(kfc, lds + L_BUF0, r32, hi); qk_regs(s0, kfc, qf, 0.f); kfrags_row(kfc, lds + L_BUF1, r32, hi); qk_regs(s1, kfc, qf, 0.f); }
        int nlim = qp >= 31 ? ((qp - 31) >> 4) : -1; if (nlim > NCMP - 1) nlim = NCMP - 1;
        const int nl = nlim - 4 * hi;
        float m = NEG;
#pragma unroll
        for (int kvh = 0; kvh < 2; ++kvh)
#pragma unroll
            for (int r = 0; r < 16; ++r) { const int c = 32 * kvh + (r & 3) + 8 * (r >> 2); if (c > nl) s0[kvh][r] = NEG; if (c + 64 > nl) s1[kvh][r] = NEG; m = fmaxf(m, fmaxf(s0[kvh][r], s1[kvh][r])); }
        m = fmaxf(m, xhalf(m));
        float sum = 0.f;
#pragma unroll
        for (int kvh = 0; kvh < 2; ++kvh)
#pragma unroll
            for (int r = 0; r < 16; ++r) { const int c = 32 * kvh + (r & 3) + 8 * (r >> 2);
                const float p0 = c <= nl ? __builtin_amdgcn_exp2f(s0[kvh][r] - m) : 0.f, p1 = c + 64 <= nl ? __builtin_amdgcn_exp2f(s1[kvh][r] - m) : 0.f;
                s0[kvh][r] = p0; s1[kvh][r] = p1; sum += p0 + p1; }
        sum += xhalf(sum);
        const float inv = sum > 0.f ? 1.0f / sum : 0.f;
#pragma unroll
        for (int kvh = 0; kvh < 2; ++kvh)
#pragma unroll
            for (int r = 0; r < 16; ++r) { s0[kvh][r] *= inv; s1[kvh][r] *= inv; }
        {
            LAS float* mine = impW + (size_t)(w * 32 + r32) * 33;
            float carry = 0.f;
#pragma unroll
            for (int t = 0; t < 2; ++t)
#pragma unroll
                for (int kvh = 0; kvh < 2; ++kvh)
#pragma unroll
                    for (int q4 = 0; q4 < 4; ++q4) {
                        const f32x16& x = t == 0 ? s0[kvh] : s1[kvh];
                        const float last = x[4 * q4 + 3], s4 = (x[4 * q4] + x[4 * q4 + 1]) + (x[4 * q4 + 2] + last);
                        const float os4 = from_hi(s4), olast = from_hi(last);
                        const int ge = 16 * t + 8 * kvh + 2 * q4;
                        if (hi == 0) { mine[ge] = carry + s4; mine[ge + 1] = os4 + last; }
                        carry = olast;
                    }
            if (hi == 0) mine[32] = carry;
        }
        f32x16 oc[2];
#pragma unroll
        for (int r = 0; r < 16; ++r) { oc[0][r] = 0.f; oc[1][r] = 0.f; }
        bf16x8 pf[4];
        { bf16x8 vfc[8]; v_frags(vfc, lds + L_BUF0 + KBUF, lane); pack_p(pf, s0); pv_regs(oc, vfc, pf); v_frags(vfc, lds + L_BUF1 + KBUF, lane); pack_p(pf, s1); pv_regs(oc, vfc, pf); }
#pragma unroll
        for (int r = 0; r < 16; ++r) { out[0][r] += g_c * oc[0][r]; out[1][r] += g_c * oc[1][r]; }
    }
    __syncthreads();
    {
        const int j = lane & 31, sub = lane >> 5;
#pragma unroll 2
        for (int it = 0; it < 4; ++it) {
            const int pidx = 8 * w + 2 * it + sub, php = pidx >> 5, qq = pidx & 31;
            const int qpp = samp ? TP + pidx : 64 * qt + pidx;
            float v = 0.f;
            if (!(samp && php == 1)) {
#pragma unroll
                for (int x = 0; x < 4; ++x) v += impW[(size_t)((php * 4 + x) * 32 + qq) * 33 + j];
            }
            const int cur = qpp >> 6; const bool valid = 64 * j <= qpp, forced = j == 0 || j == cur || j == cur - 1;
            v = valid ? (forced ? INFINITY : v) : -INFINITY;
            tmpv[w * 64 + lane] = v;
            int rank = 0;
            { f32x4 q8[8];
#pragma unroll
              for (int k8 = 0; k8 < 8; ++k8) q8[k8] = *(const LAS f32x4*)(tmpv + w * 64 + sub * 32 + 4 * k8);
#pragma unroll
              for (int i2 = 0; i2 < 32; ++i2) { const float vi = q8[i2 >> 2][i2 & 3]; rank += (vi > v || (vi == v && i2 < j)) ? 1 : 0; } }
            const unsigned long long bal = __ballot(rank < (samp ? 15 : 16));
            unsigned mk = sub ? (unsigned)(bal >> 32) : (unsigned)bal;
            if (samp && pidx >= TS) mk = 0u;
            if (j == 0) selm[pidx] = mk;
        }
    }
    __syncthreads();
    unsigned um = selm[lane];
#pragma unroll
    for (int o = 32; o > 0; o >>= 1) um |= __shfl_xor(um, o);
    um = __builtin_amdgcn_readfirstlane(um);
    if (!samp) um &= (qt >= 31 ? 0xffffffffu : ((1u << (qt + 1)) - 1u));
    const unsigned mysel = selm[samp ? qi : qoff];
    LAS int* tbase = (LAS int*)(lds + L_TBASE);
    LAS unsigned char* newkv = lds + L_NEW;
    const int nsel = __builtin_popcount(um), nt = nsel + 10;
    if (tid < 32) { if ((um >> tid) & 1u) { const int pos = __builtin_popcount(um & ((1u << tid) - 1u)); tlist[pos] = (1 << 8) | tid; tbase[pos] = (l * NPOOL + tbase[48 + (tid >> 1)]) * 128 + (tid & 1) * 64; } }
    else if (tid < 42) { const int k = tid - 32;
        if (k == 0) { tlist[nsel] = (1 << 8) | 32; tbase[nsel] = -1; }
        else { const int idx = 33 - k; tlist[nsel + k] = (2 << 8) | idx; tbase[nsel + k] = idx == 32 ? -1 : (l * BS + u.b) * 512 + 64 * (idx - 24); } }
    __syncthreads();
    float m_run = 0.f, l_run = 0.f; f32x16 ot[2];
#pragma unroll
    for (int r = 0; r < 16; ++r) { ot[0][r] = 0.f; ot[1][r] = 0.f; }
    int cur_type = 1;
    const int pw = w & 3, kl = lane >> 3, pch = lane & 7;
    const int roff = pw * 8192 + (kl >> 2) * 1024 + (kl & 3) * 256 + pch * 32;
    const unsigned pvo = (unsigned)((lane >> 4) * 256 + (lane & 15) * 4) * 4u;
    auto lent = [&](int j, int& e, int& rb) { const int jj = j < 63 ? j : 63; e = __builtin_amdgcn_readfirstlane(tlist[jj]); rb = __builtin_amdgcn_readfirstlane(tbase[jj]); };
    auto dma_tile = [&](int e, int rb, LAS unsigned char* raw) {
        if (rb < 0) return;
        const int ty = e >> 8;
        const float* base = (ty == 1 ? F.a->cache_sel : F.a->state_win) + ((size_t)(rb + 16 * pw)) * 256 + u.g * 64;
        const unsigned dst = (unsigned)__builtin_amdgcn_readfirstlane((int)((unsigned)(__UINTPTR_TYPE__)raw + (unsigned)pw * 8192u));
#pragma unroll
        for (int q = 0; q < 8; ++q) glds16s(pvo, base + (q & 3) * 4 * 256 + (q >> 2) * 128, dst + 1024u * q);
    };
    struct Staged { u32x4 ka, va, kb, vb; };
    auto fetch = [&](int e, const LAS unsigned char* raw, Staged& S) {
        if ((e & 255) == 32) { const u32x4 z = {0u, 0u, 0u, 0u}; S.ka = z; S.va = z; S.kb = z; S.vb = z;
            if (pw == 0 && kl < TS) { const LAS unsigned char* np = newkv + ((e >> 8) == 1 ? 0 : 1024) + kl * 128 + pch * 16; S.ka = *(const LAS u32x4*)np; S.va = *(const LAS u32x4*)(np + 512); } }
        else { const LAS unsigned char* rp = raw + roff;
            const u32x4 a0 = *(const LAS u32x4*)rp, a1 = *(const LAS u32x4*)(rp + 16), b0 = *(const LAS u32x4*)(rp + 2048), b1 = *(const LAS u32x4*)(rp + 2064);
            const u32x4 c0 = *(const LAS u32x4*)(rp + 4096), c1 = *(const LAS u32x4*)(rp + 4112), d0 = *(const LAS u32x4*)(rp + 6144), d1 = *(const LAS u32x4*)(rp + 6160);
            S.ka = f8_to_bf8(a0, a1); S.kb = f8_to_bf8(b0, b1); S.va = f8_to_bf8(c0, c1); S.vb = f8_to_bf8(d0, d1); }
    };
    auto put = [&](LAS unsigned char* buf, const Staged& S) {
        const int k0 = 16 * pw + kl, k1 = k0 + 8;
        *(LAS u32x4*)(buf + k0 * KROW + pch * 16) = S.ka; *(LAS u32x4*)(buf + k1 * KROW + pch * 16) = S.kb;
        *(LAS u32x4*)(buf + KBUF + (pch >> 2) * 4096 + k0 * 64 + (pch & 3) * 16) = S.va; *(LAS u32x4*)(buf + KBUF + (pch >> 2) * 4096 + k1 * 64 + (pch & 3) * 16) = S.vb; };
    static_assert(8 * 32 * 33 * 4 >= 32768, "third raw slot overlays the importance table (dead after the block selection)");
    auto rawslot = [&](int k3) -> LAS unsigned char* { return lds + (k3 == 0 ? L_RAW0 : (k3 == 1 ? L_RAW1 : L_RAW2)); };
#define SAMP_WAIT(N) do { const int n_ = (N); if (n_ == 2) asm volatile("s_waitcnt vmcnt(16)" ::: "memory"); else if (n_ == 1) asm volatile("s_waitcnt vmcnt(8)" ::: "memory"); else asm volatile("s_waitcnt vmcnt(0)" ::: "memory"); } while (0)
    int e0, b0, e1, b1, e2, b2, e3, b3;
    lent(0, e0, b0); lent(1, e1, b1); lent(2, e2, b2); lent(3, e3, b3);
    if (ph == 1) {
        dma_tile(e0, b0, rawslot(0)); if (nt > 1) dma_tile(e1, b1, rawslot(1)); if (nt > 2) dma_tile(e2, b2, rawslot(2));
        SAMP_WAIT((nt > 1 && b1 >= 0 ? 1 : 0) + (nt > 2 && b2 >= 0 ? 1 : 0));
        Staged S; fetch(e0, rawslot(0), S); put(lds + L_BUF0, S);
        asm volatile("s_waitcnt lgkmcnt(0)" ::: "memory");
    }
    __syncthreads();
    int s1 = 1;
#pragma unroll 1
    for (int i = 0; i < nt; ++i) {
        const int e = e0, type = e >> 8, idx = e & 255;
        const int j4 = i + 4 < 63 ? i + 4 : 63; const int e4v = tlist[j4], b4v = tbase[j4];
        if (ph == 1) {
            const int s0 = s1 == 0 ? 2 : s1 - 1;
            if (i + 3 < nt) dma_tile(e3, b3, rawslot(s0));
            if (i + 1 < nt) {
                SAMP_WAIT((i + 2 < nt && b2 >= 0 ? 1 : 0) + (i + 3 < nt && b3 >= 0 ? 1 : 0));
                Staged S; fetch(e1, rawslot(s1), S);
                put(lds + ((i & 1) ? L_BUF0 : L_BUF1), S);
                asm volatile("s_waitcnt lgkmcnt(0)" ::: "memory"); }
            s1 = s1 == 2 ? 0 : s1 + 1;
        }
        if (active) {
            if (type != cur_type) {
                const float lt = xsum_f(l_run), sc = g_s / lt;
#pragma unroll
                for (int r = 0; r < 16; ++r) { out[0][r] += sc * ot[0][r]; out[1][r] += sc * ot[1][r]; ot[0][r] = 0.f; ot[1][r] = 0.f; }
                m_run = 0.f; l_run = 0.f; cur_type = type;
            }
            const LAS unsigned char* buf = lds + ((i & 1) ? L_BUF1 : L_BUF0);
            bf16x8 kf[8], vf[8];
            kfrags_row(kf, buf, r32, hi); asm volatile("" ::: "memory");
            v_frags(vf, buf + KBUF, lane); asm volatile("" ::: "memory");
            f32x16 s[2];
            float cinit = -m_run; int mode = 0;
            if (type == 1) { if (!(((mysel >> (idx & 31)) & 1u) || idx == 32)) cinit = NEG; mode = idx == 32 ? 1 : 0; }
            else mode = idx == 32 ? 1 : (idx == 24 ? 2 : 0);
            qk_regs(s, kf, qf, cinit);
            if (mode) { int qo_ = qo; asm volatile("" : "+v"(qo_)); edge_mask(s, mode, qo_, hi); }
            int ti = max(__float_as_int(s[0][0]), __float_as_int(s[1][0]));
#pragma unroll
            for (int r = 1; r < 16; ++r) ti = max(ti, max(__float_as_int(s[0][r]), __float_as_int(s[1][r])));
            ti = xmax_i(ti);
            const float tm = __int_as_float(ti);
            if (__any(ti > 0)) {
                const float dl = fmaxf(tm, 0.f), alpha = __builtin_amdgcn_exp2f(-dl);
                m_run += dl; l_run *= alpha;
#pragma unroll
                for (int r = 0; r < 16; ++r) { s[0][r] -= dl; s[1][r] -= dl; ot[0][r] *= alpha; ot[1][r] *= alpha; }
            }
#pragma unroll
            for (int r = 0; r < 16; ++r) { s[0][r] = __builtin_amdgcn_exp2f(s[0][r]); s[1][r] = __builtin_amdgcn_exp2f(s[1][r]); }
            { typedef float f32x2_ __attribute__((ext_vector_type(2)));
              f32x2_ r2 = {0.f, 0.f};
#pragma unroll
              for (int r = 0; r < 16; r += 2) { r2 += (f32x2_){s[0][r], s[0][r + 1]}; r2 += (f32x2_){s[1][r], s[1][r + 1]}; }
              l_run += r2[0] + r2[1]; }
            bf16x8 pf[4]; pack_p(pf, s); pv_regs(ot, vf, pf);
        }
        e0 = e1; b0 = b1; e1 = e2; b1 = b2; e2 = e3; b2 = b3; e3 = __builtin_amdgcn_readfirstlane(e4v); b3 = __builtin_amdgcn_readfirstlane(b4v);
        __syncthreads();
    }
#undef SAMP_WAIT
    if (active) {
        const float lt = xsum_f(l_run), sc = g_w / lt;
#pragma unroll
        for (int r = 0; r < 16; ++r) { out[0][r] += sc * ot[0][r]; out[1][r] += sc * ot[1][r]; }
        if (qvalid) {
            int qrow_ = qrow; asm volatile("" : "+v"(qrow_));
            bf16* op = F_O + (size_t)qrow_ * 512 + h * 64;
#pragma unroll
            for (int dh = 0; dh < 2; ++dh)
#pragma unroll
                for (int q4 = 0; q4 < 4; ++q4) { const u32x2 wv = {cvtpk(out[dh][4 * q4], out[dh][4 * q4 + 1]), cvtpk(out[dh][4 * q4 + 2], out[dh][4 * q4 + 3])};
                    *(u32x2*)(op + 32 * dh + 8 * q4 + 4 * hi) = wv; }
        }
    }
}
constexpr int P_SLOT = 16384, P_IMP = 3 * P_SLOT, P_SELM = P_IMP + 8 * 32 * 33 * 4, P_TMP = P_SELM + 64 * 4, P_LIST = P_TMP + 8 * 64 * 4, P_END = P_LIST + 64 * 4;
DEV void kfrags(bf16x8 (&kf)[8], const LAS unsigned char* kslot, int r32, int hi) {
#pragma unroll
    for (int st = 0; st < 4; ++st)
#pragma unroll
        for (int kvh = 0; kvh < 2; ++kvh) kf[2 * st + kvh] = *(const LAS bf16x8*)(kslot + (2 * st + hi) * 1024 + (32 * kvh + r32) * 16);
}
DEV void qk_regs(f32x16 (&s)[2], const bf16x8 (&kf)[8], const bf16x8 (&qf)[4], float cinit) {
    f32x16 cv, a0, a1;
#pragma unroll
    for (int r = 0; r < 16; ++r) cv[r] = cinit;
    a0 = __builtin_amdgcn_mfma_f32_32x32x16_bf16(kf[0], qf[0], cv, 0, 0, 0); a1 = __builtin_amdgcn_mfma_f32_32x32x16_bf16(kf[1], qf[0], cv, 0, 0, 0);
#pragma unroll
    for (int st = 1; st < 4; ++st) { a0 = __builtin_amdgcn_mfma_f32_32x32x16_bf16(kf[2 * st], qf[st], a0, 0, 0, 0); a1 = __builtin_amdgcn_mfma_f32_32x32x16_bf16(kf[2 * st + 1], qf[st], a1, 0, 0, 0); }
    s[0] = a0; s[1] = a1;
}
DEV void v_frags(bf16x8 (&vf)[8], const LAS unsigned char* vb, int lane) {
    const int g16 = lane >> 4, i = lane & 15, q_ = i >> 2, p_ = i & 3, hi = g16 >> 1, dsub = 16 * (g16 & 1);
    const LAS unsigned char* base = vb + (4 * hi + q_) * 64 + (dsub + 4 * p_) * 2;
#pragma unroll
    for (int dh = 0; dh < 2; ++dh)
#pragma unroll
        for (int st = 0; st < 4; ++st) { const s16x4 lo = vtr(base + dh * 4096 + (16 * st) * 64), hh = vtr(base + dh * 4096 + (16 * st + 8) * 64);
            vf[4 * dh + st] = (bf16x8){lo[0], lo[1], lo[2], lo[3], hh[0], hh[1], hh[2], hh[3]}; }
}
DEV void pv_regs(f32x16 (&o)[2], const bf16x8 (&vf)[8], const bf16x8 (&pf)[4]) {
#pragma unroll
    for (int st = 0; st < 4; ++st)
#pragma unroll
        for (int dh = 0; dh < 2; ++dh) o[dh] = __builtin_amdgcn_mfma_f32_32x32x16_bf16(vf[4 * dh + st], pf[st], o[dh], 0, 0, 0);
}
DEV void dma_k(const Frame& F, const Unit& u, int e, LAS unsigned char* kslot, int w, int lane) {
    const int type = e >> 8, idx = e & 255; const bf16* src;
    if (type == 0) src = F_KCB + ((size_t)(u.b * 2 + u.g) * 128 + 64 * idx + lane) * 64 + w * 8;
    else src = (type == 1 ? F_SKV : F_WKV) + ((size_t)u.b * TP + 64 * idx + lane) * 256 + u.g * 64 + w * 8;
    glds16(src, (unsigned)__builtin_amdgcn_readfirstlane((int)((unsigned)(__UINTPTR_TYPE__)kslot + (unsigned)w * 1024u)));
}
DEV void dma_v(const Frame& F, const Unit& u, int e, LAS unsigned char* vslot, int w, int lane) {
    const int type = e >> 8, idx = e & 255, row = 16 * (w & 3) + (lane >> 2), col = (w >> 2) * 32 + (lane & 3) * 8; const bf16* src;
    if (type == 0) src = F_VCB + ((size_t)(u.b * 2 + u.g) * 128 + 64 * idx + row) * 64 + col;
    else src = (type == 1 ? F_SKV : F_WKV) + ((size_t)u.b * TP + 64 * idx + row) * 256 + 128 + u.g * 64 + col;
    glds16(src, (unsigned)__builtin_amdgcn_readfirstlane((int)((unsigned)(__UINTPTR_TYPE__)vslot + (unsigned)w * 1024u)));
}
#define ATT_WAIT_BAR(N) do { asm volatile("s_waitcnt vmcnt(" #N ") lgkmcnt(0)" ::: "memory"); __builtin_amdgcn_s_barrier(); asm volatile("" ::: "memory"); } while (0)
DEV void attn_unit_p(const Frame& F, const int l, const Unit u) {
    const int tid = F.tid, lane = F.lane, w = F.wave, hh = w & 3, ph = w >> 2, r32 = lane & 31, hi = lane >> 5;
    LAS unsigned char* lds = F.lds;
    LAS float* impW = (LAS float*)(lds + P_IMP); LAS unsigned* selm = (LAS unsigned*)(lds + P_SELM); LAS float* tmpv = (LAS float*)(lds + P_TMP); LAS int* tlist = (LAS int*)(lds + P_LIST);
    const int qt = u.qt, h = u.g * 4 + hh, qoff = 32 * ph + r32, qrow = u.b * TP + 64 * qt + qoff, qp = 64 * qt + qoff;
    dma_k(F, u, 0, lds, w, lane); dma_v(F, u, 0, lds + 8192, w, lane); dma_k(F, u, 1, lds + P_SLOT, w, lane); dma_v(F, u, 1, lds + P_SLOT + 8192, w, lane);
    bf16x8 qf[4];
#pragma unroll
    for (int st = 0; st < 4; ++st) qf[st] = *(const bf16x8*)(F_Q + (size_t)qrow * 512 + h * 64 + 16 * st + 8 * hi);
    const float* gn = F_GN + (size_t)qrow * 24;
    const float g_c = gn[h], g_s = gn[8 + h], g_w = gn[16 + h];
    f32x16 out[2];
#pragma unroll
    for (int r = 0; r < 16; ++r) { out[0][r] = 0.f; out[1][r] = 0.f; }
    ATT_WAIT_BAR(0);
    {
        f32x16 s0[2], s1[2]; bf16x8 kf[8];
        kfrags(kf, lds, r32, hi); qk_regs(s0, kf, qf, 0.f); kfrags(kf, lds + P_SLOT, r32, hi); qk_regs(s1, kf, qf, 0.f);
        int nlim = qp >= 31 ? ((qp - 31) >> 4) : -1; if (nlim > NCMP - 1) nlim = NCMP - 1;
        const int nl = nlim - 4 * hi;
        float m = NEG;
#pragma unroll
        for (int kvh = 0; kvh < 2; ++kvh)
#pragma unroll
            for (int r = 0; r < 16; ++r) { const int c = 32 * kvh + (r & 3) + 8 * (r >> 2); if (c > nl) s0[kvh][r] = NEG; if (c + 64 > nl) s1[kvh][r] = NEG; m = fmaxf(m, fmaxf(s0[kvh][r], s1[kvh][r])); }
        m = fmaxf(m, xhalf(m));
        float sum = 0.f;
#pragma unroll
        for (int kvh = 0; kvh < 2; ++kvh)
#pragma unroll
            for (int r = 0; r < 16; ++r) { const int c = 32 * kvh + (r & 3) + 8 * (r >> 2);
                const float p0 = c <= nl ? __builtin_amdgcn_exp2f(s0[kvh][r] - m) : 0.f, p1 = c + 64 <= nl ? __builtin_amdgcn_exp2f(s1[kvh][r] - m) : 0.f;
                s0[kvh][r] = p0; s1[kvh][r] = p1; sum += p0 + p1; }
        sum += xhalf(sum);
        const float inv = sum > 0.f ? 1.0f / sum : 0.f;
#pragma unroll
        for (int kvh = 0; kvh < 2; ++kvh)
#pragma unroll
            for (int r = 0; r < 16; ++r) { s0[kvh][r] *= inv; s1[kvh][r] *= inv; }
        {
            LAS float* mine = impW + (size_t)(w * 32 + r32) * 33;
            float carry = 0.f;
#pragma unroll
            for (int t = 0; t < 2; ++t)
#pragma unroll
                for (int kvh = 0; kvh < 2; ++kvh)
#pragma unroll
                    for (int q4 = 0; q4 < 4; ++q4) {
                        const f32x16& x = t == 0 ? s0[kvh] : s1[kvh];
                        const float last = x[4 * q4 + 3], s4 = (x[4 * q4] + x[4 * q4 + 1]) + (x[4 * q4 + 2] + last);
                        const float os4 = from_hi(s4), olast = from_hi(last);
                        const int ge = 16 * t + 8 * kvh + 2 * q4;
                        if (hi == 0) { mine[ge] = carry + s4; mine[ge + 1] = os4 + last; }
                        carry = olast;
                    }
            if (hi == 0) mine[32] = carry;
        }
        f32x16 oc[2];
#pragma unroll
        for (int r = 0; r < 16; ++r) { oc[0][r] = 0.f; oc[1][r] = 0.f; }
        bf16x8 pf[4];
        { bf16x8 vfc[8]; v_frags(vfc, lds + 8192, lane); pack_p(pf, s0); pv_regs(oc, vfc, pf); v_frags(vfc, lds + P_SLOT + 8192, lane); pack_p(pf, s1); pv_regs(oc, vfc, pf); }
#pragma unroll
        for (int r = 0; r < 16; ++r) { out[0][r] += g_c * oc[0][r]; out[1][r] += g_c * oc[1][r]; }
    }
    __syncthreads();
    {
        const int j = lane & 31, sub = lane >> 5;
#pragma unroll 2
        for (int it = 0; it < 4; ++it) {
            const int pidx = 8 * w + 2 * it + sub, php = pidx >> 5, qq = pidx & 31, qpp = 64 * qt + pidx;
            float v = 0.f;
#pragma unroll
            for (int x = 0; x < 4; ++x) v += impW[(size_t)((php * 4 + x) * 32 + qq) * 33 + j];
            const int cur = qpp >> 6; const bool valid = 64 * j <= qpp, forced = j == 0 || j == cur || j == cur - 1;
            v = valid ? (forced ? INFINITY : v) : -INFINITY;
            tmpv[w * 64 + lane] = v;
            int rank = 0;
            { f32x4 q8[8];
#pragma unroll
              for (int k8 = 0; k8 < 8; ++k8) q8[k8] = *(const LAS f32x4*)(tmpv + w * 64 + sub * 32 + 4 * k8);
#pragma unroll
              for (int i2 = 0; i2 < 32; ++i2) { const float vi = q8[i2 >> 2][i2 & 3]; rank += (vi > v || (vi == v && i2 < j)) ? 1 : 0; } }
            const unsigned long long bal = __ballot(rank < 16);
            const unsigned mk = sub ? (unsigned)(bal >> 32) : (unsigned)bal;
            if (j == 0) selm[pidx] = mk;
        }
    }
    __syncthreads();
    unsigned um = selm[lane];
#pragma unroll
    for (int o = 32; o > 0; o >>= 1) um |= __shfl_xor(um, o);
    um = __builtin_amdgcn_readfirstlane(um);
    um &= (qt >= 31 ? 0xffffffffu : ((1u << (qt + 1)) - 1u));
    const unsigned mysel = selm[qoff];
    const int nsel = __builtin_popcount(um), nt = nsel + (qt < 8 ? qt + 1 : 9);
    if (tid < 32) { if ((um >> tid) & 1u) tlist[__builtin_popcount(um & ((1u << tid) - 1u))] = (1 << 8) | tid; }
    else if (tid < 41) { const int k = tid - 32; if (qt - k >= 0) tlist[nsel + k] = (2 << 8) | (qt - k); }
    __syncthreads();
    auto slot = [&](int j) -> LAS unsigned char* { return lds + (j % 3) * P_SLOT; };
    auto le = [&](int j) -> int { return tlist[j < nt ? j : nt - 1]; };
    const unsigned kvo = (unsigned)(lane * 256 + w * 8) * 2u, vvo = (unsigned)((16 * (w & 3) + (lane >> 2)) * 256 + (w >> 2) * 32 + (lane & 3) * 8) * 2u;
    auto tile_base = [&](int e_) -> const bf16* { const int e = __builtin_amdgcn_readfirstlane(e_); return ((e >> 8) == 1 ? F_SKV : F_WKV) + ((size_t)u.b * TP + 64 * (e & 255)) * 256 + u.g * 64; };
    auto dmaK = [&](int e_, LAS unsigned char* kslot) { glds16s(kvo, tile_base(e_), (unsigned)__builtin_amdgcn_readfirstlane((int)((unsigned)(__UINTPTR_TYPE__)kslot + (unsigned)w * 1024u))); };
    auto dmaV = [&](int e_, LAS unsigned char* vslot) { glds16s(vvo, tile_base(e_) + 128, (unsigned)__builtin_amdgcn_readfirstlane((int)((unsigned)(__UINTPTR_TYPE__)vslot + (unsigned)w * 1024u))); };
    dmaK(le(0), slot(0)); dmaV(le(0), slot(0) + 8192);
    dmaK(le(1), slot(1)); dmaV(le(1), slot(1) + 8192);
    dmaK(le(2), slot(2));
    float m_run = 0.f, l_run = 0.f; f32x16 ot[2];
#pragma unroll
    for (int r = 0; r < 16; ++r) { ot[0][r] = 0.f; ot[1][r] = 0.f; }
    int cur_type = 1; bool first = true;
    ATT_WAIT_BAR(0);
    bf16x8 kf[8];
    kfrags(kf, slot(0), r32, hi);
    int eA = __builtin_amdgcn_readfirstlane(le(0)), eB = __builtin_amdgcn_readfirstlane(le(1)), eC = __builtin_amdgcn_readfirstlane(le(2)), eD = __builtin_amdgcn_readfirstlane(le(3));
    LAS unsigned char* sl0 = lds; LAS unsigned char* sl1 = lds + P_SLOT; LAS unsigned char* sl2 = lds + 2 * P_SLOT;
#pragma unroll 1
    for (int t = 0; t < nt; ++t) {
        const int e = eA, type = e >> 8, idx = e & 255;
        const int eNv = le(t + 4);
        dmaK(eD, sl0); dmaV(eC, sl2 + 8192);
        if (type != cur_type) {
            const float lt = xsum_f(l_run), scl = g_s / lt;
#pragma unroll
            for (int r = 0; r < 16; ++r) { out[0][r] += scl * ot[0][r]; out[1][r] += scl * ot[1][r]; ot[0][r] = 0.f; ot[1][r] = 0.f; }
            m_run = 0.f; l_run = 0.f; cur_type = type; first = true;
        }
        float cinit = -m_run; int mode = 0;
        if (type == 1) { if (!((mysel >> (idx & 31)) & 1u)) cinit = NEG; mode = idx == qt ? 1 : 0; }
        else mode = idx == qt ? 1 : (idx == qt - 8 ? 2 : 0);
        f32x16 s[2];
        qk_regs(s, kf, qf, cinit);
        bf16x8 vf[8]; v_frags(vf, sl0 + 8192, lane);
        __builtin_amdgcn_sched_barrier(0);
        if (mode) { int qo_ = qoff; asm volatile("" : "+v"(qo_)); edge_mask(s, mode, qo_, hi); }
        float tm;
        if (first) {
            tm = fmaxf(s[0][0], s[1][0]);
#pragma unroll
            for (int r = 1; r < 16; ++r) tm = fmaxf(tm, fmaxf(s[0][r], s[1][r]));
            tm = fmaxf(tm, xhalf(tm));
        } else {
            int ti = max(__float_as_int(s[0][0]), __float_as_int(s[1][0])), tj = max(__float_as_int(s[0][8]), __float_as_int(s[1][8]));
#pragma unroll
            for (int r = 1; r < 8; ++r) { ti = max(ti, max(__float_as_int(s[0][r]), __float_as_int(s[1][r]))); tj = max(tj, max(__float_as_int(s[0][r + 8]), __float_as_int(s[1][r + 8]))); }
            ti = xmax_i(max(ti, tj));
            tm = __int_as_float(ti);
        }
        if (first || __any(tm > 8.f)) {
            const float dl = first ? (tm > -1e29f ? tm : 0.f) : fmaxf(tm, 0.f), alpha = first ? 1.f : __builtin_amdgcn_exp2f(-dl);
            m_run += dl; l_run *= alpha; first = false;
#pragma unroll
            for (int r = 0; r < 16; ++r) { s[0][r] -= dl; s[1][r] -= dl; ot[0][r] *= alpha; ot[1][r] *= alpha; }
        }
#pragma unroll
        for (int r = 0; r < 16; ++r) { s[0][r] = __builtin_amdgcn_exp2f(s[0][r]); s[1][r] = __builtin_amdgcn_exp2f(s[1][r]); }
        { typedef float f32x2_ __attribute__((ext_vector_type(2)));
          f32x2_ r2 = {0.f, 0.f}, r3 = {0.f, 0.f};
#pragma unroll
          for (int r = 0; r < 16; r += 2) { r2 += (f32x2_){s[0][r], s[0][r + 1]}; r3 += (f32x2_){s[1][r], s[1][r + 1]}; }
          r2 += r3; l_run += r2[0] + r2[1]; }
        bf16x8 pf[4]; pack_p(pf, s);
        if (t + 1 < nt) kfrags(kf, sl1, r32, hi);
        pv_regs(ot, vf, pf);
        eA = eB; eB = eC; eC = eD; eD = __builtin_amdgcn_readfirstlane(eNv);
        { LAS unsigned char* t_ = sl0; sl0 = sl1; sl1 = sl2; sl2 = t_; }
        ATT_WAIT_BAR(2);
    }
    asm volatile("s_waitcnt vmcnt(0)" ::: "memory");
    __builtin_amdgcn_s_barrier(); asm volatile("" ::: "memory");
    {
        const float lt = xsum_f(l_run), scl = g_w / lt;
#pragma unroll
        for (int r = 0; r < 16; ++r) { out[0][r] += scl * ot[0][r]; out[1][r] += scl * ot[1][r]; }
        int qrow_ = qrow; asm volatile("" : "+v"(qrow_));
        bf16* op = F_O + (size_t)qrow_ * 512 + h * 64;
#pragma unroll
        for (int dh = 0; dh < 2; ++dh)
#pragma unroll
            for (int q4 = 0; q4 < 4; ++q4) { const u32x2 wv = {cvtpk(out[dh][4 * q4], out[dh][4 * q4 + 1]), cvtpk(out[dh][4 * q4 + 2], out[dh][4 * q4 + 3])};
                *(u32x2*)(op + 32 * dh + 8 * q4 + 4 * hi) = wv; }
    }
}
DEV void attn_phase(const Frame& F, const int l) {
    const int vcu = (F.G % 8 == 0) ? (F.bid % 8) * (F.G / 8) + F.bid / 8 : F.bid;
    for (int pi = vcu; pi < 256; pi += F.G) {
        const int bg = pi >> 4, sidx = pi & 15, where = pi % 3;
#pragma unroll 1
        for (int k = 0; k < 3; ++k) {
            const Frame Fu = launder(F);
            if (k == where) { Unit us; us.samp = 1; us.b = pi >> 1; us.g = pi & 1; us.qt = 0; attn_unit(Fu, l, us); }
            else { const int which = k < where ? k : k - 1; Unit u; u.samp = 0; u.b = bg >> 1; u.g = bg & 1; u.qt = which == 0 ? 31 - sidx : sidx; attn_unit_p(Fu, l, u); }
        }
    }
}
}
DEV void ph_win_copy(const Frame& F, const int l, const int part, const int nparts) {
    constexpr unsigned per = 508u * 256u / 4u, n = (unsigned)BS * per; const unsigned stride = (unsigned)nparts * NTHREADS;
    const f32x4* src0 = (const f32x4*)(F.a->state_win + ((size_t)l * BS * 512 + 4) * 256); f32x4* dst0 = (f32x4*)(F.a->out + OUT_WIN_S + (size_t)l * BS * 512 * 256);
    for (unsigned i0 = (unsigned)part * NTHREADS + (unsigned)F.tid; i0 < n; i0 += 4u * stride) { f32x4 v[4];
#pragma unroll
        for (int q = 0; q < 4; ++q) { const unsigned i = i0 + q * stride; if (i < n) { const unsigned b = i / per, o = i - b * per; v[q] = __builtin_nontemporal_load(src0 + (size_t)b * (512 * 256 / 4) + o); } }
#pragma unroll
        for (int q = 0; q < 4; ++q) { const unsigned i = i0 + q * stride; if (i < n) { const unsigned b = i / per, o = i - b * per; __builtin_nontemporal_store(v[q], dst0 + (size_t)b * (512 * 256 / 4) + o); } } }
}
#define GRID_BAR() do { Frame Fb = launder(F0); int xq_ = xcc; asm volatile("" : "+s"(xq_)); XcdBarrier b_; b_.bar = (unsigned*)(Fb.a->ws + WS_CTL) + CW_BAR; b_.x = (unsigned)xq_; b_.st = (volatile LAS unsigned*)(Fb.lds + LDSCTL_OFF + 64); b_.t0 = Fb.tid == 0; xcd_barrier(b_); } while (0)
template <int l> DEV void run_layer(const Frame& F0, const int xcc, const int lo, const int hi) {
#define IN(k) (lo <= (k) && (k) < hi)
#define SEAM(k) do { if (IN(k) && IN((k) + 1)) GRID_BAR(); } while (0)
        constexpr int P = 1 + 7 * l;
        if (IN(P + 0)) {   Frame F = launder(F0);
            pg8::Gemm g{F_XB, (F_w1 + l * F_wstr), NT, N1, D}; pg8::StaticOrder S; S.init(NT, N1, F.G, F.bid);
            pg8::EpiProj E{l, F.a->ws, F.a->out, (LAS float*)(F.lds + RING_BYTES)};
            pg8::gemm_phase<pg8::EpiProj, pg8::StaticOrder, true, true>(F.lds, g, S, E, F.wave);
#ifdef DUP_G1
            pg8::gemm_phase<pg8::EpiProj, pg8::StaticOrder, true, true>(F.lds, g, S, E, F.wave);
#endif
            { const int nwg = (NT / 256) * (N1 / 256), full = nwg % F.G;
              if (full != 0 && F.bid >= full) ph_win_copy(F, l, F.bid - full, F.G - full);
              else if (full == 0) ph_win_copy(F, l, F.bid, F.G); }
        }
        SEAM(P + 0);
        if (IN(P + 1)) {
#ifdef CONVCMP_SIMPLE
        { Frame F = launder(F0); ph_conv_simple(F, l); }
        { Frame F = launder(F0); ph_compress_simple(F, l); }
#else
        { Frame F = launder(F0); ph_compress(F, l); }
        { Frame F = launder(F0); ph_conv(F, l); }
#ifdef DUP_CC
        __syncthreads();
        { Frame F = launder(F0); ph_compress(F, l); }
        { Frame F = launder(F0); ph_conv(F, l); }
#endif
#endif
        }
        SEAM(P + 1);
#ifdef ATTN_SIMPLE
        if (IN(P + 2)) { Frame F = launder(F0); ph_attn_simple(F, l); }
#else
        if (IN(P + 2)) { Frame F = launder(F0); att::attn_phase(F, l); }
#ifdef DUP_ATTN
        if (IN(P + 2)) { __syncthreads(); Frame F = launder(F0); att::attn_phase(F, l); }
#endif
#endif
        SEAM(P + 2);
        if (IN(P + 3)) {   Frame F = launder(F0);
            pg8::StaticOrder S; S.init(NP, D, F.G, F.bid);
            const bool early = (F.bid >> 3) & 1;
            if (early) { { mini::EpiGate<0> E{F_GM, F_T}; mini::gemm<8, 1>(F, F_CACT, (F_wc + l * F_wstr), DC, E); } { mini::EpiGate<1> E{F_GM, F_T}; mini::gemm<8, 1>(F, F_O, (F_wn + l * F_wstr), 512, E); } __syncthreads(); }
            { pg8::Gemm g{F_CACT, (F_wc + l * F_wstr), NP, D, DC}; pg8::EpiGate<0> E{F_GM, F_T}; pg8::gemm_phase<pg8::EpiGate<0>, pg8::StaticOrder, true, true>(F.lds, g, S, E, F.wave); }
            { pg8::Gemm g{F_O, (F_wn + l * F_wstr), NP, D, 512}; pg8::EpiGate<1> E{F_GM, F_T}; pg8::gemm_phase<pg8::EpiGate<1>, pg8::StaticOrder, true, true>(F.lds, g, S, E, F.wave); }
            if (!early) { { mini::EpiGate<0> E{F_GM, F_T}; mini::gemm<8, 1>(F, F_CACT, (F_wc + l * F_wstr), DC, E); } { mini::EpiGate<1> E{F_GM, F_T}; mini::gemm<8, 1>(F, F_O, (F_wn + l * F_wstr), 512, E); } }
        }
        SEAM(P + 3);
        if (IN(P + 4)) {   Frame F = launder(F0);
            pg8::Gemm g{F_T, (F_wo + l * F_wstr), NP, D, D}; pg8::StaticOrder S; S.init(NP, D, F.G, F.bid);
            const bool early = (F.bid >> 3) & 1;
            if (early) { mini::EpiRes E2{F_X, F_XB, (F_ss + (size_t)(2 * l + 1) * NT * 16), (l == 0 ? F.a->x_sample - (size_t)NP * D : (const float*)F_X), true}; mini::gemm<8, 1>(F, F_T, (F_wo + l * F_wstr), D, E2); __syncthreads(); }
            pg8::EpiRes E{F_X, F_XB, (F_ss + (size_t)(2 * l + 1) * NT * 16), (l == 0 ? F.a->x_prompt : (const float*)F_X), true}; pg8::gemm_phase<pg8::EpiRes, pg8::StaticOrder, true, true>(F.lds, g, S, E, F.wave);
            if (!early) { mini::EpiRes E2{F_X, F_XB, (F_ss + (size_t)(2 * l + 1) * NT * 16), (l == 0 ? F.a->x_sample - (size_t)NP * D : (const float*)F_X), true}; mini::gemm<8, 1>(F, F_T, (F_wo + l * F_wstr), D, E2); }
        }
        SEAM(P + 4);
        if (IN(P + 5)) {   Frame F = launder(F0);
            pg8::Gemm g{F_XB, (F_wup + l * F_wstr), NP, DFF, D}; pg8::StaticOrder S; S.init(NP, DFF, F.G, F.bid);
            const bool early = (F.bid >> 3) & 1;
            if (early) { mini::EpiRelu2 E2{(F_ss + (size_t)(2 * l + 1) * NT * 16), F_HID}; mini::gemm<2, 4>(F, F_XB, (F_wup + l * F_wstr), D, E2); __syncthreads(); }
            pg8::EpiRelu2 E{(F_ss + (size_t)(2 * l + 1) * NT * 16), F_HID, (LAS float*)(F.lds + RING_BYTES)}; pg8::gemm_phase<pg8::EpiRelu2, pg8::StaticOrder, true, true>(F.lds, g, S, E, F.wave);
            if (!early) { mini::EpiRelu2 E2{(F_ss + (size_t)(2 * l + 1) * NT * 16), F_HID}; mini::gemm<2, 4>(F, F_XB, (F_wup + l * F_wstr), D, E2); }
        }
        SEAM(P + 5);
        if (IN(P + 6)) {   Frame F = launder(F0);
            pg8::Gemm g{F_HID, (F_wdn + l * F_wstr), NP, D, DFF}; pg8::StaticOrder S; S.init(NP, D, F.G, F.bid);
            const bool early = (F.bid >> 3) & 1;
            if (early) { mini::EpiRes E2{F_X, F_XB, (F_ss + (size_t)(2 * l + 2) * NT * 16), (const float*)F_X, l == 0}; mini::gemm<8, 1>(F, F_HID, (F_wdn + l * F_wstr), DFF, E2); __syncthreads(); }
            pg8::EpiRes E{F_X, F_XB, (F_ss + (size_t)(2 * l + 2) * NT * 16), (const float*)F_X, l == 0}; pg8::gemm_phase<pg8::EpiRes, pg8::StaticOrder, true, true>(F.lds, g, S, E, F.wave);
            if (!early) { mini::EpiRes E2{F_X, F_XB, (F_ss + (size_t)(2 * l + 2) * NT * 16), (const float*)F_X, l == 0}; mini::gemm<8, 1>(F, F_HID, (F_wdn + l * F_wstr), DFF, E2); }
        }
        SEAM(P + 6);
}
__global__ void __launch_bounds__(NTHREADS, 2) mk_fwd(Args args) {
    extern __shared__ __attribute__((aligned(16))) unsigned char lds[];
    Frame F0; F0.a = (const __attribute__((address_space(4))) Args*)__builtin_amdgcn_kernarg_segment_ptr(); (void)args;
    F0.lds = (LAS unsigned char*)lds; F0.tid = threadIdx.x; F0.lane = F0.tid & 63; F0.wave = __builtin_amdgcn_readfirstlane(F0.tid >> 6); F0.G = gridDim.x; F0.bid = blockIdx.x;
    for (int u = F0.tid; u < (LDS_BYTES - LDSCTL_OFF) / 4; u += NTHREADS) ((LAS unsigned*)(F0.lds + LDSCTL_OFF))[u] = 0u;
    __syncthreads();
    const int lo = args.ph_lo, hi = args.ph_hi;
    int xcc = 0;
    if (hi - lo > 1) { XcdBarrier b0 = xcd_barrier_post((unsigned*)(args.ws + WS_CTL) + CW_BAR, (volatile LAS unsigned*)(F0.lds + LDSCTL_OFF + 64), F0.tid == 0); xcc = __builtin_amdgcn_readfirstlane((int)b0.x); }
    if (IN(0)) { Frame F = launder(F0); p0_prologue(F); }
#ifdef DUP_PRO
    if (IN(0)) { __syncthreads(); Frame F = launder(F0); p0_prologue(F); }
#endif
    SEAM(0);
    run_layer<0>(F0, xcc, lo, hi);
    run_layer<1>(F0, xcc, lo, hi);
#ifdef DBG_STOP
    if (IN(15)) { Frame F = launder(F0);
        if (DBG_STOP == 1) ph_dump(F, F_XB, D, F_XB + 512, D);
        if (DBG_STOP == 2) ph_dump(F, F_U, DC, F_Q, 512);
        if (DBG_STOP == 3) ph_dump(F, F_CACT, DC, F_SKV, 256);
        if (DBG_STOP == 4) ph_dump(F, F_O, 512, F_O, 512);
        if (DBG_STOP == 5) ph_dump(F, F_T, D, F_T + 512, D);
        if (DBG_STOP == 6) ph_dump(F, F_XB, D, F_XB + 512, D);
        if (DBG_STOP == 7) ph_dump(F, F_HID, DFF, F_HID + 2048, DFF);
        if (DBG_STOP == 8) ph_dump(F, F_XB, D, F_XB + 512, D); }
#else
    if (IN(15)) { Frame F = launder(F0); ph_final(F); }
#ifdef DUP_FIN
    if (IN(15)) { Frame F = launder(F0); ph_final(F); }
#endif
#endif
}

extern "C" void kernel_launch(void* const* d_in, const int* in_sizes, int n_in, void* d_out, int out_size, void* d_ws, size_t ws_size, hipStream_t stream) {
    (void)in_sizes; (void)n_in; (void)out_size;
    static int grid = 0;
    if (grid == 0) {
        if (ws_size < WM.end) { fprintf(stderr, "kernel_launch: workspace too small (%zu < %zu)\n", ws_size, (size_t)WM.end); grid = -1; return; }
        int dev = 0, cus = 0, per_cu = 0;
        if (hipGetDevice(&dev) != hipSuccess || hipDeviceGetAttribute(&cus, hipDeviceAttributeMultiprocessorCount, dev) != hipSuccess) { grid = -1; return; }
        if (hipFuncSetAttribute((const void*)mk_fwd, hipFuncAttributeMaxDynamicSharedMemorySize, LDS_BYTES) != hipSuccess) { fprintf(stderr, "kernel_launch: hipFuncSetAttribute failed\n"); grid = -1; return; }
        if (hipOccupancyMaxActiveBlocksPerMultiprocessor(&per_cu, (const void*)mk_fwd, NTHREADS, LDS_BYTES) != hipSuccess || per_cu < 1) { fprintf(stderr, "kernel_launch: occupancy query says %d\n", per_cu); }
        (void)hipGetLastError();
        grid = cus;
    }
    if (grid < 0) return;
    (void)hipMemsetAsync((char*)d_ws + WS_CTL, 0, CTL_ZERO_BYTES, stream);
    Args a{};
    a.x_prompt = (const float*)d_in[0]; a.x_sample = (const float*)d_in[1]; a.cache_cmp = (const float*)d_in[2]; a.cache_sel = (const float*)d_in[3];
    a.state_win = (const float*)d_in[4]; a.state_conv = (const float*)d_in[5]; a.page_table = (const int*)d_in[6];
    a.norm_mix_g = (const float*)d_in[7]; a.w_in = (const float*)d_in[8]; a.dw_w = (const float*)d_in[9]; a.dw_b = (const float*)d_in[10];
    a.ln_g = (const float*)d_in[11]; a.ln_b = (const float*)d_in[12]; a.w_conv_out = (const float*)d_in[13]; a.cmp_pos = (const float*)d_in[14];
    a.w_cmp = (const float*)d_in[15]; a.w_nsa_out = (const float*)d_in[16]; a.w_out = (const float*)d_in[17]; a.norm_mlp_g = (const float*)d_in[18];
    a.w_up = (const float*)d_in[19]; a.w_down = (const float*)d_in[20]; a.norm_final_g = (const float*)d_in[21];
    a.out = (float*)d_out; a.ws = (unsigned char*)d_ws;
#ifndef MK_PER_PHASE
    a.ph_lo = 0; a.ph_hi = 16;
    hipLaunchKernelGGL(mk_fwd, dim3(grid), dim3(NTHREADS), LDS_BYTES, stream, a);
#else
#ifdef DBG_STOP
    for (int ph = 0; ph < 16; ++ph) { if (ph >= DBG_STOP && ph != 15) continue; a.ph_lo = ph; a.ph_hi = ph + 1; hipLaunchKernelGGL(mk_fwd, dim3(grid), dim3(NTHREADS), LDS_BYTES, stream, a); }
    if (0)
#endif
    for (int ph = 0; ph < 16; ++ph) { a.ph_lo = ph; a.ph_hi = ph + 1; hipLaunchKernelGGL(mk_fwd, dim3(grid), dim3(NTHREADS), LDS_BYTES, stream, a); }
#endif
}
```
